# Optimizing an MI355X kernel written in HIP

```python
import jax
import jax.numpy as jnp
from jax import lax
import numpy as np

D_MODEL = 2048
BATCH = 8
SEQ = 4096
DEPTH = 1

GRID_W = 64
CTX_LEN = 256
D_LRU = 1024
LRU_HEADS = 4
LRU_HEAD_DIM = D_LRU // LRU_HEADS
LRU_C = 8.0
CONV_W = 4
CONV_LEFT = CONV_W // 2
CONV_RIGHT = CONV_W - 1 - CONV_LEFT
D_FOUR = D_MODEL - D_LRU
FOUR_GROUPS = 8
FOUR_GROUP_DIM = D_FOUR // FOUR_GROUPS
D_MIX = D_LRU + D_FOUR
D_IN = 2 * D_LRU + D_FOUR
N_EXPERTS = 64
N_EXPERT_GROUPS = 8
EXPERTS_PER_GROUP = N_EXPERTS // N_EXPERT_GROUPS
TOPK_GROUPS = 4
TOP_K = 8
D_EXPERT = 512
D_SHARED = 512
ROUTED_SCALE = 2.5
ALPHA = (2.0 * DEPTH) ** 0.25
BETA = (8.0 * DEPTH) ** -0.25
EPS = 1e-6
DIRECTIONS = (False, True)

kernel_name = "hybrid_rglru_fourier_moe_deepnorm_dit"


def normalize(x):
    xf = x.astype(jnp.float32)
    mu = xf.mean(-1, keepdims=True)
    var = jnp.mean(jnp.square(xf - mu), -1, keepdims=True)
    return ((xf - mu) * lax.rsqrt(var + EPS)).astype(x.dtype)


def layer_norm(x, g, b):
    return normalize(x) * g + b


def rms_norm(x, g):
    xf = x.astype(jnp.float32)
    y = xf * lax.rsqrt(jnp.mean(jnp.square(xf), -1, keepdims=True) + EPS)
    return y.astype(x.dtype) * g


def adaln(cvec, p):
    return jax.nn.silu(cvec) @ p["w_ada"] + p["b_ada"]


def modulate(h, shift, scale):
    return h * (1.0 + scale) + shift


def depthwise_conv_centred(u, w, b):
    n = u.shape[-2]
    pad = [(0, 0)] * (u.ndim - 2) + [(CONV_LEFT, CONV_RIGHT), (0, 0)]
    up = jnp.pad(u, pad)
    out = b
    for k in range(CONV_W):
        out = out + up[..., k:k + n, :] * w[k]
    return out


def short_conv(u, w, b, on_grid):
    if on_grid:
        bsz, n, ch = u.shape
        rows = n // GRID_W
        return depthwise_conv_centred(u.reshape(bsz, rows, GRID_W, ch), w, b).reshape(bsz, n, ch)
    return depthwise_conv_centred(u, w, b)


def rglru_coeffs(u, w_a, b_a, w_x, b_x, lam):
    uf = u.astype(jnp.float32)
    uh = uf.reshape(uf.shape[:-1] + (LRU_HEADS, LRU_HEAD_DIM))
    r = jax.nn.sigmoid(jnp.einsum("bnhi,hij->bnhj", uh, w_a.astype(jnp.float32)).reshape(uf.shape) + b_a)
    i = jax.nn.sigmoid(jnp.einsum("bnhi,hij->bnhj", uh, w_x.astype(jnp.float32)).reshape(uf.shape) + b_x)
    log_a = -LRU_C * r * jax.nn.softplus(-lam.astype(jnp.float32))
    a = jnp.exp(log_a)
    b = jnp.sqrt(-jnp.expm1(2.0 * log_a)) * (i * uf)
    return a, b


def linear_scan(a, b, h0, reverse, keep_outputs):
    def step(h, ab):
        h = ab[0] * h + ab[1]
        return h, (h if keep_outputs else None)
    h_last, hs = lax.scan(step, h0, (jnp.moveaxis(a, 1, 0), jnp.moveaxis(b, 1, 0)), reverse=reverse)
    return (jnp.moveaxis(hs, 0, 1) if keep_outputs else None), h_last


def rglru_direction(u, h0, p, d, reverse, keep_outputs):
    a, b = rglru_coeffs(u, p["lru_wa"][d], p["lru_ba"][d], p["lru_wx"][d], p["lru_bx"][d], p["lru_lambda"][d])
    return linear_scan(a, b, h0, reverse, keep_outputs)


def fourier_mix(v):
    bsz, n, _ = v.shape
    vg = v.astype(jnp.float32).reshape(bsz, n, FOUR_GROUPS, FOUR_GROUP_DIM)
    y = jnp.fft.fftn(vg, axes=(1, 3), norm="ortho").real
    return y.reshape(bsz, n, D_FOUR).astype(v.dtype)


def token_mixer(h, p, h0s, on_grid):
    proj = h @ p["w_in"]
    u, gate, v = jnp.split(proj, [D_LRU, 2 * D_LRU], axis=-1)
    u = short_conv(u, p["conv_w"], p["conv_b"], on_grid)
    hs_f, hf_last = rglru_direction(u, h0s[0], p, 0, DIRECTIONS[0], True)
    hs_b, hb_last = rglru_direction(u, h0s[1], p, 1, DIRECTIONS[1], True)
    y_lru = (hs_f + hs_b).astype(h.dtype) * jax.nn.gelu(gate)
    y_four = fourier_mix(v)
    y = jnp.concatenate([rms_norm(y_lru, p["norm_lru_g"]), rms_norm(y_four, p["norm_four_g"])], axis=-1)
    return y @ p["w_out"], (hf_last, hb_last)


def context_final_states(h_ctx, p):
    u = short_conv(h_ctx @ p["w_in"][:, :D_LRU], p["conv_w"], p["conv_b"], False)
    h0 = jnp.zeros((h_ctx.shape[0], D_LRU), jnp.float32)
    _, hf = rglru_direction(u, h0, p, 0, DIRECTIONS[0], False)
    _, hb = rglru_direction(u, h0, p, 1, DIRECTIONS[1], False)
    return (hf, hb)


def swiglu(t, w_gate, w_up, w_down):
    return (jax.nn.silu(t @ w_gate) * (t @ w_up)) @ w_down


def moe_ffn(h, p):
    shape = h.shape
    t = h.reshape(-1, shape[-1])
    n_tok = t.shape[0]
    scores = jax.nn.sigmoid((t @ p["w_router"]).astype(jnp.float32))
    sel = scores + p["router_bias"].astype(jnp.float32)
    grp_score = lax.top_k(sel.reshape(n_tok, N_EXPERT_GROUPS, EXPERTS_PER_GROUP), 2)[0].sum(-1)
    _, top_groups = lax.top_k(grp_score, TOPK_GROUPS)
    group_mask = jax.nn.one_hot(top_groups, N_EXPERT_GROUPS, dtype=jnp.float32).sum(1) > 0
    expert_mask = jnp.repeat(group_mask, EXPERTS_PER_GROUP, axis=-1)
    _, idx = lax.top_k(jnp.where(expert_mask, sel, -jnp.inf), TOP_K)
    w = jnp.take_along_axis(scores, idx, axis=-1)
    w = ROUTED_SCALE * w / (w.sum(-1, keepdims=True) + 1e-20)
    gates = jnp.zeros((n_tok, N_EXPERTS), jnp.float32).at[jnp.arange(n_tok)[:, None], idx].set(w)

    def add_expert(acc, expert):
        w_gate, w_up, w_down, g = expert
        return acc + g[:, None].astype(t.dtype) * swiglu(t, w_gate, w_up, w_down), None

    shared = swiglu(t, p["sh_w_gate"], p["sh_w_up"], p["sh_w_down"])
    out, _ = lax.scan(add_expert, shared, (p["exp_w_gate"], p["exp_w_up"], p["exp_w_down"], gates.T))
    return out.reshape(shape)


def setup_inputs(seed: int = 0) -> dict:
    key = jax.random.key(seed)
    ks = jax.random.split(key, 32)
    f32 = jnp.float32
    L, D = DEPTH, D_MODEL

    def nrm(k, shape, scale):
        return jax.random.normal(k, shape, f32) * scale

    u = jax.random.uniform(ks[10], (L, 2, D_LRU), f32, 0.9, 0.999)
    a = u ** (1.0 / LRU_C)
    lam = jnp.log(a) - jnp.log1p(-a)
    return {
        "x": nrm(ks[0], (BATCH, SEQ, D), 1.0),
        "c": nrm(ks[1], (BATCH, D), 1.0),
        "ctx": nrm(ks[2], (BATCH, CTX_LEN, D), 1.0),
        "c_ctx": nrm(ks[3], (D,), 1.0),
        "w_ada": nrm(ks[4], (L, D, 6 * D), 0.5 * D ** -0.5),
        "b_ada": nrm(ks[5], (L, 6 * D), 0.02),
        "w_in": nrm(ks[6], (L, D, D_IN), D ** -0.5),
        "conv_w": nrm(ks[7], (L, CONV_W, D_LRU), CONV_W ** -0.5),
        "conv_b": nrm(ks[8], (L, D_LRU), 0.02),
        "lru_wa": nrm(ks[9], (L, 2, LRU_HEADS, LRU_HEAD_DIM, LRU_HEAD_DIM), LRU_HEAD_DIM ** -0.5),
        "lru_ba": nrm(ks[11], (L, 2, D_LRU), 0.02),
        "lru_wx": nrm(ks[12], (L, 2, LRU_HEADS, LRU_HEAD_DIM, LRU_HEAD_DIM), LRU_HEAD_DIM ** -0.5),
        "lru_bx": nrm(ks[13], (L, 2, D_LRU), 0.02),
        "lru_lambda": lam,
        "norm_lru_g": 1.0 + nrm(ks[14], (L, D_LRU), 0.02),
        "norm_four_g": 1.0 + nrm(ks[15], (L, D_FOUR), 0.02),
        "w_out": nrm(ks[16], (L, D_MIX, D), BETA * D_MIX ** -0.5),
        "ln1_g": 1.0 + nrm(ks[17], (L, D), 0.02),
        "ln1_b": nrm(ks[18], (L, D), 0.02),
        "w_router": nrm(ks[19], (L, D, N_EXPERTS), D ** -0.5),
        "router_bias": nrm(ks[20], (L, N_EXPERTS), 0.01),
        "exp_w_gate": nrm(ks[21], (L, N_EXPERTS, D, D_EXPERT), D ** -0.5),
        "exp_w_up": nrm(ks[22], (L, N_EXPERTS, D, D_EXPERT), D ** -0.5),
        "exp_w_down": nrm(ks[23], (L, N_EXPERTS, D_EXPERT, D), BETA * D_EXPERT ** -0.5),
        "sh_w_gate": nrm(ks[24], (L, D, D_SHARED), D ** -0.5),
        "sh_w_up": nrm(ks[25], (L, D, D_SHARED), D ** -0.5),
        "sh_w_down": nrm(ks[26], (L, D_SHARED, D), BETA * D_SHARED ** -0.5),
        "ln2_g": 1.0 + nrm(ks[27], (L, D), 0.02),
        "ln2_b": nrm(ks[28], (L, D), 0.02),
    }


def reference(x, c, ctx, c_ctx, w_ada, b_ada, w_in, conv_w, conv_b, lru_wa, lru_ba, lru_wx, lru_bx,
              lru_lambda, norm_lru_g, norm_four_g, w_out, ln1_g, ln1_b, w_router, router_bias,
              exp_w_gate, exp_w_up, exp_w_down, sh_w_gate, sh_w_up, sh_w_down, ln2_g, ln2_b):
    x_ctx = ctx
    for l in range(DEPTH):
        p = {
            "w_ada": w_ada[l], "b_ada": b_ada[l], "w_in": w_in[l], "conv_w": conv_w[l], "conv_b": conv_b[l],
            "lru_wa": lru_wa[l], "lru_ba": lru_ba[l], "lru_wx": lru_wx[l], "lru_bx": lru_bx[l],
            "lru_lambda": lru_lambda[l], "norm_lru_g": norm_lru_g[l], "norm_four_g": norm_four_g[l],
            "w_out": w_out[l], "w_router": w_router[l], "router_bias": router_bias[l],
            "exp_w_gate": exp_w_gate[l], "exp_w_up": exp_w_up[l], "exp_w_down": exp_w_down[l],
            "sh_w_gate": sh_w_gate[l], "sh_w_up": sh_w_up[l], "sh_w_down": sh_w_down[l],
        }
        sh1, sc1, g1, sh2, sc2, g2 = jnp.split(adaln(c, p)[:, None, :], 6, axis=-1)
        csh1, csc1, cg1, csh2, csc2, cg2 = jnp.split(adaln(c_ctx, p), 6, axis=-1)
        h = modulate(normalize(x), sh1, sc1)
        h_ctx = modulate(normalize(x_ctx), csh1, csc1)
        if l + 1 < DEPTH:
            h0 = jnp.zeros((x_ctx.shape[0], D_LRU), jnp.float32)
            mix_ctx, ctx_states = token_mixer(h_ctx, p, (h0, h0), False)
            x_ctx = layer_norm(ALPHA * x_ctx + cg1 * mix_ctx, ln1_g[l], ln1_b[l])
            ffn_ctx = moe_ffn(modulate(normalize(x_ctx), csh2, csc2), p)
            x_ctx = layer_norm(ALPHA * x_ctx + cg2 * ffn_ctx, ln2_g[l], ln2_b[l])
        else:
            ctx_states = context_final_states(h_ctx, p)
        mix, _ = token_mixer(h, p, ctx_states, True)
        x = layer_norm(ALPHA * x + g1 * mix, ln1_g[l], ln1_b[l])
        ffn = moe_ffn(modulate(normalize(x), sh2, sc2), p)
        x = layer_norm(ALPHA * x + g2 * ffn, ln2_g[l], ln2_b[l])
    return x
```

```cpp
#include <hip/hip_runtime.h>
#include <cstdio>
#include <cstdint>
#define MK_SPLIT 0
#define GAS __attribute__((address_space(1)))
#define LAS __attribute__((address_space(3)))
namespace mk {
constexpr int D = 2048, NB = 8, SEQ = 4096, T = NB * SEQ, CTX = 256, TC = NB * CTX, TT = T + TC;
constexpr int DL = 1024, DF = 1024, DIN = 3072, NE = 64, NEX = 65, DE = 512;
constexpr int MODW = 6 * D;
constexpr float ALPHA = 1.189207115002721f, EPS = 1e-6f, PI2 = 6.283185307179586f;
constexpr int NWAVES = 8, NTHR = 512;
constexpr int NSLICE = 1, TS = T / NSLICE;
constexpr int SLOT_ROWS = TS * 8 + NE * 256 + TS;

typedef unsigned short bf16;
typedef unsigned v4u __attribute__((ext_vector_type(4)));
typedef unsigned v2u __attribute__((ext_vector_type(2)));
typedef float f32x4 __attribute__((ext_vector_type(4)));
typedef float f32x2 __attribute__((ext_vector_type(2)));
typedef short bf16x8 __attribute__((ext_vector_type(8)));
typedef int v8i __attribute__((ext_vector_type(8)));
typedef int v4i __attribute__((ext_vector_type(4)));

constexpr size_t MiB = 1u << 20;
constexpr size_t WS_CTL = 0, CTL_ZERO_BYTES = 1 * MiB;
constexpr size_t WS_MOD = 1 * MiB;
constexpr size_t WS_MISC = 2 * MiB;
constexpr size_t WS_WIN = 10 * MiB;
constexpr size_t WS_WOUT = 22 * MiB;
constexpr size_t WS_WG4 = 30 * MiB;
constexpr size_t WS_WR = 32 * MiB;
constexpr size_t WS_CS = 34 * MiB;
constexpr size_t WS_WGU = 50 * MiB;
constexpr size_t WS_WD = 180 * MiB;
constexpr size_t WS_DYN = 245 * MiB;
constexpr size_t WS_H = WS_DYN;
constexpr size_t WS_PF = WS_DYN, WS_PB = WS_DYN + 64 * MiB;
constexpr size_t WS_MIX = WS_DYN;
constexpr size_t WS_U = WS_DYN + 136 * MiB;
constexpr size_t WS_GATE = WS_U + 68 * MiB;
constexpr size_t WS_FOUR = WS_GATE + 64 * MiB;
constexpr size_t WS_UC = WS_FOUR + 64 * MiB;
constexpr size_t WS_S = WS_UC + 68 * MiB;
constexpr size_t WS_UPART = WS_S;
constexpr size_t WS_YMIX = WS_S + 64 * MiB;
constexpr size_t WS_PQT = WS_YMIX + 128 * MiB;
constexpr size_t WS_AB = WS_PQT + 32 * MiB;
constexpr size_t WS_END_MIXER = WS_AB + 32 * MiB;
constexpr size_t WS_H2HI = WS_YMIX;
constexpr size_t WS_H2LO = WS_U;
constexpr size_t WS_OUTTOK = WS_DYN;
constexpr size_t OUTTOK_BYTES = (size_t)TS * 9 * D;
constexpr size_t WS_ACT = WS_OUTTOK + OUTTOK_BYTES;
constexpr size_t ACT_BYTES = (size_t)SLOT_ROWS * DE;
constexpr size_t WS_H2F8 = WS_OUTTOK + 736 * MiB;
constexpr size_t WS_ROUTE = WS_H2F8 + 64 * MiB;
constexpr size_t WS_END = WS_ROUTE + 24 * MiB;
static_assert(WS_H2F8 >= WS_END_MIXER, "H2F8 clear of the mixer buffers");
static_assert(WS_ACT + ACT_BYTES <= WS_H2F8, "MoE overlay map");
static_assert(WS_END <= 1150 * MiB, "workspace budget");
constexpr size_t RT_TOK = 0;
constexpr size_t RT_DST = RT_TOK + (size_t)NSLICE * NEX * TS * 4;
constexpr size_t RT_W = RT_DST + (size_t)NSLICE * NEX * TS * 4;
static_assert(RT_W + (size_t)T * 8 * 4 <= 24 * MiB, "routing tables");
constexpr int MS_SUMA = 0;
constexpr int NSUB = SEQ / 128;
constexpr int MS_SUMB = MS_SUMA + (TT / 128) * 2 * DL;
constexpr int MS_P64 = MS_SUMB + (TT / 128) * 2 * DL;
constexpr int P64_LD = 2112;
constexpr int MS_ALT = MS_P64 + NB * 8 * P64_LD;
constexpr int MS_NYQ = MS_ALT + NB * 32 * 512;
constexpr int MS_SP = MS_NYQ + NB * 8 * P64_LD;
constexpr int MS_GB = MS_SP + 2 * DL;
constexpr int MS_END = MS_GB + 4 * DL;
static_assert((size_t)MS_END * 4 <= 8 * MiB, "MISC region");
constexpr int CW_TMO = 0, CW_CODE = 1, CW_BAR = 4096, CW_CNT = 8192;

constexpr int RING_BYTES = 131072, LDSCTL_OFF = RING_BYTES, SCR_OFF = LDSCTL_OFF + 512, LDS_BYTES = 147456;

#define RLX_AGENT __ATOMIC_RELAXED, __HIP_MEMORY_SCOPE_AGENT
#define LDS_WAIT() asm volatile("s_waitcnt lgkmcnt(0)" ::: "memory")
#define VM_WAIT() asm volatile("s_waitcnt vmcnt(0)" ::: "memory")
__device__ __forceinline__ unsigned f2bf(float f) { unsigned u = __builtin_bit_cast(unsigned, f); return (u + 0x7fffu + ((u >> 16) & 1u)) >> 16; }
__device__ __forceinline__ unsigned pk2(float lo, float hi) { return f2bf(lo) | (f2bf(hi) << 16); }
__device__ __forceinline__ unsigned cvt_pk_bf16(float lo, float hi) { unsigned r; asm volatile("v_cvt_pk_bf16_f32 %0, %1, %2" : "=v"(r) : "v"(lo), "v"(hi)); return r; }
__device__ __forceinline__ unsigned pk4_fp8(float a, float b, float c, float d) {
    a = __builtin_amdgcn_fmed3f(a, -448.f, 448.f); b = __builtin_amdgcn_fmed3f(b, -448.f, 448.f); c = __builtin_amdgcn_fmed3f(c, -448.f, 448.f); d = __builtin_amdgcn_fmed3f(d, -448.f, 448.f);
    int r = __builtin_amdgcn_cvt_pk_fp8_f32(a, b, 0, false); r = __builtin_amdgcn_cvt_pk_fp8_f32(c, d, r, true); return (unsigned)r; }
__device__ __forceinline__ f32x4 fp8x4_to_f32(unsigned w) { const f32x2 lo = __builtin_amdgcn_cvt_pk_f32_fp8((int)w, false), hi = __builtin_amdgcn_cvt_pk_f32_fp8((int)w, true); return (f32x4){lo.x, lo.y, hi.x, hi.y}; }
__device__ __forceinline__ float bf_lo(unsigned w) { return __builtin_bit_cast(float, w << 16); }
__device__ __forceinline__ float bf_hi(unsigned w) { return __builtin_bit_cast(float, w & 0xffff0000u); }
__device__ __forceinline__ float bf2f(bf16 h) { return __builtin_bit_cast(float, (unsigned)h << 16); }
__device__ __forceinline__ float wave_sum(float v) {
#pragma unroll
    for (int o = 1; o < 64; o <<= 1) v += __shfl_xor(v, o);
    return v;
}
__device__ __forceinline__ float sigmoid_f(float x) { return __builtin_amdgcn_rcpf(1.0f + __expf(-x)); }
__device__ __forceinline__ float silu_f(float x) { return x * sigmoid_f(x); }
__device__ __forceinline__ float gelu_tanh_f(float x) { const float u = 0.7978845608028654f * (x + 0.044715f * x * x * x); const float e = __expf(2.0f * u); const float th = 1.0f - 2.0f * __builtin_amdgcn_rcpf(e + 1.0f); return 0.5f * x * (1.0f + th); }

#define XB_TMO      128
#define XB_XCNT(j)  (256  + 64 * (j))
#define XB_XSUB(j)  (1280 + 64 * (j))
#define XB_XGEN(j)  (2304 + 64 * (j))
#define XB_TOP      3328
#define XB_TOPGEN   3392
#define XCD_BAR_WORDS 3456
#define XB_SPIN_CAP (1u << 18)
__device__ __forceinline__ unsigned xb_ld(unsigned* p)              { return __hip_atomic_load(p, __ATOMIC_RELAXED, __HIP_MEMORY_SCOPE_AGENT); }
__device__ __forceinline__ unsigned xb_add(unsigned* p, unsigned v) { return __hip_atomic_fetch_add(p, v, __ATOMIC_RELAXED, __HIP_MEMORY_SCOPE_AGENT); }
__device__ __forceinline__ unsigned xb_xcc_id() { return (unsigned)__builtin_amdgcn_s_getreg((3 << 11) | 20) & 0xFu; }
#define XB_SPIN(cond, bar) do { unsigned _sp = 0; while (cond) { __builtin_amdgcn_s_sleep(1); \
    if ((++_sp & 255u) == 0u) { if (xb_ld(&(bar)[XB_TMO])) break; if (_sp > XB_SPIN_CAP) { atomicAdd(&(bar)[XB_TMO], 1u); break; } } } } while (0)
struct XcdBarrier { unsigned* bar; unsigned x; volatile LAS unsigned* st; };
__device__ __forceinline__ XcdBarrier xcd_barrier_post(unsigned* bar, volatile LAS unsigned* st) {
    XcdBarrier b; b.bar = bar; b.x = xb_xcc_id(); b.st = st;
    if (threadIdx.x == 0) (void)xb_add(&bar[XB_XCNT(b.x)], 1u);
    return b;
}
__device__ __forceinline__ void xcd_barrier_complete(unsigned* bar, unsigned x, unsigned& nloc, unsigned& nx) {
    const unsigned G = gridDim.x * gridDim.y * gridDim.z;
    unsigned sum, cnt, mine, sp = 0u;
    for (;;) {
        sum = 0u; cnt = 0u; mine = 0u;
#pragma unroll
        for (unsigned j = 0; j < 16; ++j) { const unsigned c = xb_ld(&bar[XB_XCNT(j)]); sum += c; cnt += (c > 0u) ? 1u : 0u; mine = (j == x) ? c : mine; }
        if (sum == G) break;
        __builtin_amdgcn_s_sleep(1);
        if ((++sp & 255u) == 0u) { if (xb_ld(&bar[XB_TMO])) break; if (sp > XB_SPIN_CAP) { atomicAdd(&bar[XB_TMO], 1u); break; } }
    }
    nloc = mine > 0u ? mine : 1u; nx = cnt > 0u ? cnt : 1u;
}
__device__ __forceinline__ void xcd_barrier(const XcdBarrier& b) {
    asm volatile("s_waitcnt vmcnt(0)" ::: "memory");
    __syncthreads();
    if (threadIdx.x == 0) {
        unsigned* bar = b.bar;
        __builtin_amdgcn_s_waitcnt(0);
        unsigned nloc = b.st[0], nx = b.st[1];
        if (nloc == 0u) { xcd_barrier_complete(bar, b.x, nloc, nx); b.st[0] = nloc; b.st[1] = nx; }
        const unsigned old = xb_add(&bar[XB_XSUB(b.x)], 1u);
        const unsigned gen = old / nloc;
        if (old + 1u == (gen + 1u) * nloc) {
            __builtin_amdgcn_fence(__ATOMIC_RELEASE, "agent");
            asm volatile("s_waitcnt vmcnt(0)" ::: "memory");
            const unsigned og = xb_add(&bar[XB_TOP], 1u);
            const unsigned tg = og / nx;
            if (og + 1u == (tg + 1u) * nx) xb_add(&bar[XB_TOPGEN], 1u);
            else XB_SPIN(xb_ld(&bar[XB_TOPGEN]) == tg, bar);
            __builtin_amdgcn_fence(__ATOMIC_ACQUIRE, "agent");
            xb_add(&bar[XB_XGEN(b.x)], 1u);
            asm volatile("s_waitcnt vmcnt(0)" ::: "memory");
        } else {
            XB_SPIN(xb_ld(&bar[XB_XGEN(b.x)]) == gen, bar);
            __builtin_amdgcn_fence(__ATOMIC_ACQUIRE, "agent");
            asm volatile("s_waitcnt vmcnt(0)" ::: "memory");
        }
    }
    __syncthreads();
}

namespace pg8 {
constexpr int BM = 256, BK = 64, HALF = 128, HTB = HALF * BK * 2, STAGE_BYTES = 8 * HTB;
__host__ __device__ __forceinline__ int lds_byte(int r, int c) { const int st = (r >> 4) * 2 + (c >> 5), rr = r & 15, cc = c & 31, ob = rr * 64 + cc * 2; return st * 1024 + (ob ^ (((ob >> 9) & 1) << 5)); }
__host__ __device__ __forceinline__ void stage_rc(int b, int& R, int& C) { const int st = b / 1024, sb = b % 1024, swz = sb ^ (((sb >> 9) & 1) << 5); R = (st >> 1) * 16 + swz / 64; C = (st & 1) * 32 + (swz % 64) / 2; }
__host__ __device__ __forceinline__ int perm_slot32(int c) { return 16 * ((c >> 2) & 1) + 4 * ((c >> 3) & 3) + (c & 3); }

__host__ __device__ __forceinline__ int perm_slot256(int c) { return 128 * ((c >> 3) & 1) + 32 * (c >> 6) + 16 * ((c >> 2) & 1) + 4 * ((c >> 4) & 3) + (c & 3); }
struct Unit { const char* a; const char* b; int pm, pn, aux0, aux1, nt; };

template <class Epi, class Sched, bool ALIGN_EPI, bool GATHER, bool F8 = false, int SCW = 0x7f7f7f7f>
__device__ __forceinline__ void gemm_phase(LAS unsigned char* lds, const int nt_, const unsigned lda_b, const unsigned ldb_b, Sched& S, const Epi& E) {
    int nt = nt_; asm volatile("" : "+s"(nt));
    int tid_ = threadIdx.x; asm volatile("" : "+v"(tid_));
    const int tid = tid_, wid = __builtin_amdgcn_readfirstlane(tid >> 6), lane = tid & 63, wr = wid >> 2, wc = wid & 3, fr = lane & 15, fq = lane >> 4;
    unsigned voffA[2][2], voffB[2][2], cbyte[2]; int Rr[2];
#pragma unroll
    for (int i = 0; i < 2; ++i) { int R, C; stage_rc(tid * 16 + i * 8192, R, C); Rr[i] = R; cbyte[i] = (unsigned)C * 2u;
#pragma unroll
        for (int h = 0; h < 2; ++h) { voffB[h][i] = (unsigned)(R + HALF * h) * ldb_b + (unsigned)C * 2u; voffA[h][i] = (unsigned)Epi::a_row(h, R) * lda_b + (unsigned)C * 2u; } }
    const unsigned ldsw = (unsigned)wid * 1024u;
    const int aoff = lds_byte(wr * 64 + fr, fq * 8), boff = lds_byte(wc * 32 + fr, fq * 8);
#define PG8_SA(b, h) (((b) * 2 + (h)) * HTB)
#define PG8_SB(b, h) ((4 + (b) * 2 + (h)) * HTB)
#define PG8_STAGE(bufoff, gbase, voff) do { _Pragma("unroll") for (int _i = 0; _i < 2; ++_i) \
        __builtin_amdgcn_global_load_lds((const unsigned*)((const char*)(gbase) + (voff)[_i]), (LAS unsigned*)(lds + (bufoff) + ldsw + _i * 8192), 16, 0, 0); } while (0)
#define PG8_LDA(dst, b, h) do { _Pragma("unroll") for (int m = 0; m < 4; ++m) _Pragma("unroll") for (int k = 0; k < 2; ++k) dst[m][k] = *(const LAS v4i*)(lds + PG8_SA(b, h) + aoff + m * 2048 + k * 1024); } while (0)
#define PG8_LDB(dst, b, h) do { _Pragma("unroll") for (int n = 0; n < 2; ++n) _Pragma("unroll") for (int k = 0; k < 2; ++k) dst[n][k] = *(const LAS v4i*)(lds + PG8_SB(b, h) + boff + n * 2048 + k * 1024); } while (0)
#define PG8_CAT(x) __builtin_shufflevector((x)[0], (x)[1], 0, 1, 2, 3, 4, 5, 6, 7)
#define PG8_MMA(ai, bj, At, Bt) do { __builtin_amdgcn_s_setprio(1); _Pragma("unroll") for (int m = 0; m < 4; ++m) _Pragma("unroll") for (int n = 0; n < 2; ++n) { \
        if constexpr (F8) { const v8i b8_ = PG8_CAT(Bt[n]), a8_ = PG8_CAT(At[m]);   \
            asm volatile("v_mfma_scale_f32_16x16x128_f8f6f4 %0, %1, %2, %0, %3, %4 op_sel_hi:[0,0,0]" : "+v"(acc[ai][bj][m][n]) : "v"(b8_), "v"(a8_), "v"(scw_), "v"(sca_)); } \
        else { _Pragma("unroll") for (int k = 0; k < 2; ++k) acc[ai][bj][m][n] = __builtin_amdgcn_mfma_f32_16x16x32_bf16(__builtin_bit_cast(bf16x8, Bt[n][k]), __builtin_bit_cast(bf16x8, At[m][k]), acc[ai][bj][m][n], 0, 0, 0); } } \
        __builtin_amdgcn_s_setprio(0); } while (0)
#define PG8_WAIT_V(n) asm volatile("s_waitcnt vmcnt(" #n ")" ::: "memory")
#define PG8_WAIT_L(n) asm volatile("s_waitcnt lgkmcnt(" #n ")" ::: "memory")
#define PG8_BAR __builtin_amdgcn_s_barrier()
#define PG8_SCHED __builtin_amdgcn_sched_barrier(0)
    int scw_ = SCW, sca_ = 0x7f7f7f7f; asm volatile("" : "+v"(scw_), "+v"(sca_));
    Unit cur, nxt; int ui = 0;
    if (!S.next(0, cur)) return;
    f32x4 acc[2][2][4][2];
#pragma unroll
    for (int a = 0; a < 2; ++a)
#pragma unroll
        for (int b = 0; b < 2; ++b)
#pragma unroll
            for (int m = 0; m < 4; ++m)
#pragma unroll
                for (int n = 0; n < 2; ++n) acc[a][b][m][n] = (f32x4){0.f, 0.f, 0.f, 0.f};
    v4i At[4][2], B0[2][2], B1[2][2];
    const char* cA = cur.a; const char* cB = cur.b;
    if constexpr (Sched::DSTPF) S.prefetch_dst(cur, 0, wid, lane);
    if constexpr (GATHER) {
#pragma unroll
        for (int h = 0; h < 2; ++h)
#pragma unroll
            for (int i = 0; i < 2; ++i) voffA[h][i] = S.row_off_global(cur, HALF * h + Rr[i]) + cbyte[i];
    }
    PG8_STAGE(PG8_SB(0, 0), cB, voffB[0]); PG8_STAGE(PG8_SB(0, 1), cB, voffB[1]); PG8_STAGE(PG8_SA(0, 0), cA, voffA[0]); PG8_STAGE(PG8_SA(0, 1), cA, voffA[1]);
    if (wr == 1) PG8_BAR;
    PG8_WAIT_V(2); PG8_BAR;
    PG8_STAGE(PG8_SB(1, 0), cB + 128, voffB[0]); PG8_STAGE(PG8_SA(1, 0), cA + 128, voffA[0]); PG8_STAGE(PG8_SB(1, 1), cB + 128, voffB[1]);
    PG8_WAIT_V(6); PG8_BAR;
    for (;;) {
        const bool has_next = S.next(ui + 1, nxt);
        const char* nA = has_next ? nxt.a : cA; const char* nB = has_next ? nxt.b : cB;
        if constexpr (GATHER) { if (has_next) S.prefetch_rows(nxt, ui + 1, lds, wid, lane); }
        if constexpr (Sched::DSTPF) { if (has_next) S.prefetch_dst(nxt, ui + 1, wid, lane); }
        const int ntu = (cur.nt > 0) ? cur.nt : nt;
        for (int t = 0; t < ntu; t += 2) {
            const bool last = (t == ntu - 2);
            const char* a1 = cA + (size_t)(t + 1) * 128;
            const char* a2 = last ? nA : cA + (size_t)(t + 2) * 128; const char* b2 = last ? nB : cB + (size_t)(t + 2) * 128;
            const char* a3 = a2 + 128; const char* b3 = b2 + 128;
            unsigned oa[2][2];
#pragma unroll
            for (int h = 0; h < 2; ++h)
#pragma unroll
                for (int i = 0; i < 2; ++i) oa[h][i] = voffA[h][i];
            if constexpr (GATHER) { if (last && has_next) {
#pragma unroll
                for (int h = 0; h < 2; ++h)
#pragma unroll
                    for (int i = 0; i < 2; ++i) oa[h][i] = S.row_off_lds(ui + 1, HALF * h + Rr[i], lds) + cbyte[i]; } }
            PG8_LDB(B0, 0, 0); PG8_LDB(B1, 0, 1); PG8_SCHED; PG8_LDA(At, 0, 0); PG8_STAGE(PG8_SA(1, 1), a1, voffA[1]);
            PG8_WAIT_V(8); PG8_WAIT_L(0); PG8_BAR; PG8_MMA(0, 0, At, B0); PG8_MMA(0, 1, At, B1); PG8_BAR; PG8_SCHED;
            PG8_LDA(At, 0, 1); PG8_STAGE(PG8_SB(0, 0), b2, voffB[0]); PG8_STAGE(PG8_SB(0, 1), b2, voffB[1]); PG8_STAGE(PG8_SA(0, 0), a2, oa[0]);
            PG8_WAIT_V(8); PG8_WAIT_L(0); PG8_BAR; PG8_MMA(1, 0, At, B0); PG8_MMA(1, 1, At, B1); PG8_BAR; PG8_SCHED;
            PG8_LDB(B0, 1, 0); PG8_LDB(B1, 1, 1); PG8_SCHED; PG8_LDA(At, 1, 0); PG8_STAGE(PG8_SA(0, 1), a2, oa[1]);
            PG8_WAIT_V(8); PG8_WAIT_L(0); PG8_BAR; PG8_MMA(0, 0, At, B0); PG8_MMA(0, 1, At, B1); PG8_BAR; PG8_SCHED;
            PG8_LDA(At, 1, 1); PG8_STAGE(PG8_SB(1, 0), b3, voffB[0]); PG8_STAGE(PG8_SB(1, 1), b3, voffB[1]); PG8_STAGE(PG8_SA(1, 0), a3, oa[0]);
            PG8_WAIT_V(8); PG8_WAIT_L(0); PG8_BAR; PG8_MMA(1, 0, At, B0); PG8_MMA(1, 1, At, B1); PG8_BAR; PG8_SCHED;
            if constexpr (GATHER) { if (last) {
#pragma unroll
                for (int h = 0; h < 2; ++h)
#pragma unroll
                    for (int i = 0; i < 2; ++i) voffA[h][i] = oa[h][i]; } }
        }
        if constexpr (ALIGN_EPI) { if (wr == 0) PG8_BAR; }
        if constexpr (F8) asm volatile("s_nop 15\n\ts_nop 15" ::: "memory");
        E(acc, cur, wr, wc, fr, fq, lds);
        if (!has_next) break;
#pragma unroll
        for (int a = 0; a < 2; ++a)
#pragma unroll
            for (int b = 0; b < 2; ++b)
#pragma unroll
                for (int m = 0; m < 4; ++m)
#pragma unroll
                    for (int n = 0; n < 2; ++n) acc[a][b][m][n] = (f32x4){0.f, 0.f, 0.f, 0.f};
        cur = nxt; cA = nA; cB = nB; ++ui;
        if constexpr (ALIGN_EPI) { if (wr == 1) PG8_BAR; }
    }
    PG8_WAIT_V(0);
    if constexpr (!ALIGN_EPI) { if (wr == 0) PG8_BAR; }
    PG8_BAR;
#undef PG8_SA
#undef PG8_SB
#undef PG8_STAGE
#undef PG8_LDA
#undef PG8_LDB
#undef PG8_MMA
#undef PG8_CAT
#undef PG8_WAIT_V
#undef PG8_WAIT_L
#undef PG8_BAR
#undef PG8_SCHED
}
}
}
namespace mk {
struct Args { const float* in[29]; float* out; unsigned char* ws; int ph_lo, ph_hi, li, pad; };
static_assert(sizeof(Args) == 31 * 8 + 16, "Args has no padding");

__device__ __forceinline__ void tile_order(int L, int nM, int nN, int& pm, int& pn) {
    const int nwg = nM * nN; int wgid = L;
    { const int q = nwg / 8, r = nwg % 8, xcd = wgid % 8, off = wgid / 8; wgid = (xcd < r ? xcd * (q + 1) : r * (q + 1) + (xcd - r) * q) + off; }
    const int nig = 8 * nN, gid = wgid / nig, fm = gid * 8, gsz = (nM - fm) < 8 ? (nM - fm) : 8;
    pm = fm + ((wgid % nig) % gsz); pn = (wgid % nig) / gsz;
}

__device__ __forceinline__ void p0_adaln(const Args& A, LAS unsigned char* lds, int tid, int G) {
    LAS float* st = (LAS float*)lds;
    const float* c = A.in[1]; const float* cc = A.in[3]; const float* w = A.in[4]; const float* bias = A.in[5];
    float* mod = (float*)(A.ws + WS_MOD);
    const int cg = tid % 12, kg = tid / 12;
    __syncthreads();
    for (int cb = blockIdx.x; cb < 256; cb += G) {
        for (int i = tid; i < 9 * D; i += NTHR) { const float v = (i < 8 * D) ? c[i] : cc[i - 8 * D]; st[i] = v / (1.0f + __expf(-v)); }
        __syncthreads();
        float acc[9][4];
#pragma unroll
        for (int r = 0; r < 9; ++r)
#pragma unroll
            for (int j = 0; j < 4; ++j) acc[r][j] = 0.f;
        const int col0 = cb * 48 + cg * 4;
        if (kg < 42) {
            for (int k = kg; k < D; k += 42) {
                const f32x4 wv = *(const f32x4*)(w + (size_t)k * MODW + col0);
#pragma unroll
                for (int r = 0; r < 9; ++r) { const float s = st[r * D + k];
#pragma unroll
                    for (int j = 0; j < 4; ++j) acc[r][j] += s * wv[j]; }
            }
        }
        __syncthreads();
        if (kg < 42) {
#pragma unroll
            for (int r = 0; r < 9; ++r)
#pragma unroll
                for (int j = 0; j < 4; ++j) st[(kg * 12 + cg) * 36 + r * 4 + j] = acc[r][j];
        }
        __syncthreads();
        if (tid < 432) { const int ocg = tid / 36, rj = tid % 36, r = rj >> 2, j = rj & 3; float s = 0.f;
            for (int q = 0; q < 42; ++q) s += st[(q * 12 + ocg) * 36 + rj];
            const int col = cb * 48 + ocg * 4 + j; mod[(size_t)r * MODW + col] = s + bias[col]; }
        __syncthreads();
    }
}

__device__ __forceinline__ void tr_item(const float* W, int ldw, int k0, int n0, bf16* WT, size_t dst_row0, int ldk, bool perm, LAS float* scr, int lane) {
#pragma unroll 8
    for (int i = 0; i < 32; ++i) { const int kk = 2 * i + (lane >> 5); scr[kk * 33 + (lane & 31)] = W[(size_t)(k0 + kk) * ldw + n0 + (lane & 31)]; }
    LDS_WAIT(); asm volatile("" ::: "memory");
    const int c = lane & 7;
#pragma unroll
    for (int j = 0; j < 4; ++j) { const int n = (lane >> 3) + 8 * j; const LAS float* s = scr + (8 * c) * 33 + n;
        v4u o; o.x = pk2(s[0 * 33], s[1 * 33]); o.y = pk2(s[2 * 33], s[3 * 33]); o.z = pk2(s[4 * 33], s[5 * 33]); o.w = pk2(s[6 * 33], s[7 * 33]);
        const int slot = perm ? pg8::perm_slot32(n) : n;
        *(GAS v4u*)(WT + (dst_row0 + slot) * (size_t)ldk + k0 + 8 * c) = o; }
    LDS_WAIT(); asm volatile("" ::: "memory");
}
__device__ __forceinline__ void tr_item_f8(const float* W, int ldw, int k0, int n0, unsigned char* WT, size_t dst_row0, int ldk, int mode256, LAS float* scr, int lane) {
#pragma unroll 8
    for (int i = 0; i < 32; ++i) { const int kk = 2 * i + (lane >> 5); scr[kk * 33 + (lane & 31)] = W[(size_t)(k0 + kk) * ldw + n0 + (lane & 31)]; }
    LDS_WAIT(); asm volatile("" ::: "memory");
    const int c = lane & 7;
#pragma unroll
    for (int j = 0; j < 4; ++j) { const int n = (lane >> 3) + 8 * j; const LAS float* s = scr + (8 * c) * 33 + n;
        v2u o; o.x = pk4_fp8(s[0 * 33] * 64.f, s[1 * 33] * 64.f, s[2 * 33] * 64.f, s[3 * 33] * 64.f); o.y = pk4_fp8(s[4 * 33] * 64.f, s[5 * 33] * 64.f, s[6 * 33] * 64.f, s[7 * 33] * 64.f);
        const int slot = mode256 ? pg8::perm_slot256((n0 & 255) + n) : pg8::perm_slot32(n);
        *(GAS v2u*)(WT + (dst_row0 + slot) * (size_t)ldk + k0 + 8 * c) = o; }
    LDS_WAIT(); asm volatile("" ::: "memory");
}
__device__ __forceinline__ void tr_item_hilo(const float* W, int ldw, int k0, int n0, bf16* WT, int ldk, LAS float* scr, int lane) {
#pragma unroll 8
    for (int i = 0; i < 32; ++i) { const int kk = 2 * i + (lane >> 5); scr[kk * 33 + (lane & 31)] = W[(size_t)(k0 + kk) * ldw + n0 + (lane & 31)]; }
    LDS_WAIT(); asm volatile("" ::: "memory");
    const int c = lane & 7;
#pragma unroll
    for (int j = 0; j < 4; ++j) { const int n = (lane >> 3) + 8 * j; const LAS float* s = scr + (8 * c) * 33 + n;
        float v[8]; unsigned hb[8], lb[8];
#pragma unroll
        for (int q = 0; q < 8; ++q) { v[q] = s[q * 33]; hb[q] = f2bf(v[q]); lb[q] = f2bf(v[q] - __builtin_bit_cast(float, hb[q] << 16)); }
        v4u oh, ol; oh.x = hb[0] | (hb[1] << 16); oh.y = hb[2] | (hb[3] << 16); oh.z = hb[4] | (hb[5] << 16); oh.w = hb[6] | (hb[7] << 16);
        ol.x = lb[0] | (lb[1] << 16); ol.y = lb[2] | (lb[3] << 16); ol.z = lb[4] | (lb[5] << 16); ol.w = lb[6] | (lb[7] << 16);
        *(GAS v4u*)(WT + (size_t)(n0 + n) * ldk + k0 + 8 * c) = oh;
        *(GAS v4u*)(WT + (size_t)(NE + n0 + n) * ldk + k0 + 8 * c) = ol; }
    LDS_WAIT(); asm volatile("" ::: "memory");
}

__device__ __forceinline__ void p0_weights(const Args& A, LAS unsigned char* lds, int tid, int lane, int wave, int vcu, int G) {
    LAS float* scr = (LAS float*)(lds + wave * 16384);
    const int gw = vcu * NWAVES + wave, NGW = G * NWAVES;
    bf16* WIN = (bf16*)(A.ws + WS_WIN); bf16* WOUT = (bf16*)(A.ws + WS_WOUT); unsigned char* WGU = A.ws + WS_WGU; unsigned char* WD = A.ws + WS_WD; bf16* WR = (bf16*)(A.ws + WS_WR);
    constexpr int I_IN = 32 * 64, I_OUT = 32 * 64, I_GU = 32 * 16, I_D = 8 * 64, I_R = 32 * 2;
    constexpr int NITEMS = I_IN + I_OUT + NEX * (2 * I_GU + I_D) + I_R;
    for (int it = gw; it < NITEMS; it += NGW) {
        int r = it;
        if (r < I_IN) { const int kb = r / 64, nb = r % 64; tr_item(A.in[6], DIN, 64 * kb, 32 * nb, WIN, (size_t)32 * nb, D, true, scr, lane); continue; } r -= I_IN;
        if (r < I_OUT) { const int kb = r / 64, nb = r % 64; tr_item(A.in[16], D, 64 * kb, 32 * nb, WOUT, (size_t)32 * nb, D, true, scr, lane); continue; } r -= I_OUT;
        if (r < NEX * 2 * I_GU) { const int e = r / (2 * I_GU); int q = r % (2 * I_GU); const int bj = q / I_GU; q %= I_GU; const int kb = q / 16, nb = q % 16;
            const float* W = (e < NE) ? A.in[bj ? 22 : 21] + (size_t)e * D * DE : A.in[bj ? 25 : 24];
            const int n0 = 32 * nb, ct = n0 >> 7, wcg = (n0 >> 5) & 3;
            tr_item_f8(W, DE, 64 * kb, n0, WGU, (size_t)e * 1024 + ct * 256 + bj * 128 + wcg * 32, D, 0, scr, lane); continue; } r -= NEX * 2 * I_GU;
        if (r < NEX * I_D) { const int e = r / I_D, q = r % I_D, kb = q / 64, nb = q % 64;
            const float* W = (e < NE) ? A.in[23] + (size_t)e * DE * D : A.in[26];
            tr_item_f8(W, D, 64 * kb, 32 * nb, WD, (size_t)e * D + ((32 * nb) & ~255), DE, 1, scr, lane); continue; } r -= NEX * I_D;
        { const int kb = r / 2, nb = r % 2; tr_item_hilo(A.in[19], NE, 64 * kb, 32 * nb, WR, D, scr, lane); }
    }
    { float* misc = (float*)(A.ws + WS_MISC); const int i = gw * 64 + lane;
      if (i < 2 * DL) { const float l = -A.in[13][i]; misc[MS_SP + i] = -8.0f * 1.4426950408889634f * ((l > 20.f) ? l : log1pf(expf(l)));
          const int d = i >> 10, ch = i & 1023; misc[MS_GB + d * 2 * DL + ch] = -1.4426950408889634f * A.in[10][i]; misc[MS_GB + d * 2 * DL + DL + ch] = -1.4426950408889634f * A.in[12][i]; } }
    {   bf16* WG4 = (bf16*)(A.ws + WS_WG4);
        for (int it = gw; it < 4 * 4 * 4 * 32; it += NGW) {
            const int k8 = it & 31, gt = (it >> 5) & 3, q = (it >> 7) & 3, h = it >> 9, cl = lane;
            const float* src = ((gt & 1) ? A.in[11] : A.in[9]) + ((size_t)(gt >> 1) * 4 + h) * 65536 + q * 64 + cl;
            float v[8];
#pragma unroll
            for (int j = 0; j < 8; ++j) v[j] = -1.4426950408889634f * src[(size_t)(k8 * 8 + j) * 256];
            const int rho = (gt >> 1) * 128 + (cl >> 4) * 32 + (gt & 1) * 16 + ((cl >> 2) & 3) * 4 + (cl & 3);
            v4u o; o.x = pk2(v[0], v[1]); o.y = pk2(v[2], v[3]); o.z = pk2(v[4], v[5]); o.w = pk2(v[6], v[7]);
            *(GAS v4u*)(WG4 + ((size_t)h * 1024 + q * 256 + rho) * 256 + k8 * 8) = o;
        }
    }
    {   bf16* CS = (bf16*)(A.ws + WS_CS);
        for (int it = gw; it < 2 * 2048 * 4; it += NGW) {
            const int nq = it & 3, k = (it >> 2) & 2047, ty = it >> 13, n0 = nq * 512 + lane * 8;
            float v[8];
#pragma unroll
            for (int j = 0; j < 8; ++j) { const float x = (float)((k * (n0 + j)) & 4095) * (1.0f / 4096.0f); v[j] = ty ? __builtin_amdgcn_sinf(x) : __builtin_amdgcn_cosf(x); }
            v4u o; o.x = pk2(v[0], v[1]); o.y = pk2(v[2], v[3]); o.z = pk2(v[4], v[5]); o.w = pk2(v[6], v[7]);
            *(GAS v4u*)(CS + ((size_t)ty * 2048 + k) * 2048 + n0) = o;
        }
    }
}
__device__ __forceinline__ void p0_fold(const Args& A, LAS unsigned char* lds, int tid, int G) {
    LAS float* wt = (LAS float*)lds;
    LAS float* tb = (LAS float*)(lds + 64 * 129 * 4);
    bf16* WIN = (bf16*)(A.ws + WS_WIN);
    const float scale = 1.0f / 724.0773439350247f;
    for (int it = blockIdx.x; it < 256; it += G) {
        const int kb = it >> 3, g = it & 7, k0 = kb * 64;
        __syncthreads();
        if (tid < 128) { tb[tid] = __builtin_amdgcn_cosf((float)tid * (1.0f / 128.0f)); tb[128 + tid] = __builtin_amdgcn_sinf((float)tid * (1.0f / 128.0f)); }
        for (int i = tid; i < 64 * 128; i += NTHR) { const int kk = i >> 7, c = i & 127; wt[kk * 129 + c] = A.in[6][(size_t)(k0 + kk) * DIN + 2 * DL + g * 128 + c]; }
        __syncthreads();
        const int j = tid & 127, kq = tid >> 7, jj = (j <= 64) ? j : j - 64; const bool isc = (j <= 64);
        float acc[16];
#pragma unroll
        for (int i = 0; i < 16; ++i) acc[i] = 0.f;
        for (int c = 0; c < 128; ++c) { const int ph = (c * jj) & 127; const float tv = isc ? tb[ph] : -tb[128 + ph];
#pragma unroll
            for (int i = 0; i < 16; ++i) acc[i] += wt[(kq * 16 + i) * 129 + c] * tv; }
        const int col = g * 128 + j, row = 2 * DL + (col & ~31) + pg8::perm_slot32(col & 31);
        v4u o0, o1; o0.x = pk2(acc[0] * scale, acc[1] * scale); o0.y = pk2(acc[2] * scale, acc[3] * scale); o0.z = pk2(acc[4] * scale, acc[5] * scale); o0.w = pk2(acc[6] * scale, acc[7] * scale);
        o1.x = pk2(acc[8] * scale, acc[9] * scale); o1.y = pk2(acc[10] * scale, acc[11] * scale); o1.z = pk2(acc[12] * scale, acc[13] * scale); o1.w = pk2(acc[14] * scale, acc[15] * scale);
        GAS v4u* dst = (GAS v4u*)(WIN + (size_t)row * D + k0 + kq * 16); dst[0] = o0; dst[1] = o1;
    }
    __syncthreads();
}

__device__ __forceinline__ void p1_hnorm(const Args& A, int lane, int wave, int vcu, int G) {
    const int gw = vcu * NWAVES + wave, NGW = G * NWAVES;
    const float* mod = (const float*)(A.ws + WS_MOD); bf16* H = (bf16*)(A.ws + WS_H);
    for (int r0 = gw; r0 < TT; r0 += 2 * NGW) {
        const int r1 = r0 + NGW; const bool has1 = r1 < TT; const int r1c = has1 ? r1 : r0;
        const float* x0 = (r0 < T) ? A.in[0] + (size_t)r0 * D : A.in[2] + (size_t)(r0 - T) * D; const float* x1 = (r1c < T) ? A.in[0] + (size_t)r1c * D : A.in[2] + (size_t)(r1c - T) * D;
        const int b0 = (r0 < T) ? r0 / SEQ : 8, b1 = (r1c < T) ? r1c / SEQ : 8;
        const GAS f32x4* xr0 = (const GAS f32x4*)x0 + lane; const GAS f32x4* xr1 = (const GAS f32x4*)x1 + lane;
        f32x4 v[8], u[8]; float s = 0.f, q = 0.f;
#pragma unroll
        for (int j = 0; j < 8; ++j) { v[j] = xr0[64 * j]; u[j] = xr1[64 * j]; }
#pragma unroll
        for (int j = 0; j < 8; ++j) { s += (v[j].x + v[j].y) + (v[j].z + v[j].w); q += (u[j].x + u[j].y) + (u[j].z + u[j].w); }
        const float mean0 = wave_sum(s) * (1.f / D), mean1 = wave_sum(q) * (1.f / D); float s2 = 0.f, q2 = 0.f;
#pragma unroll
        for (int j = 0; j < 8; ++j) { v[j] = v[j] - mean0; u[j] = u[j] - mean1; s2 += (v[j].x * v[j].x + v[j].y * v[j].y) + (v[j].z * v[j].z + v[j].w * v[j].w); q2 += (u[j].x * u[j].x + u[j].y * u[j].y) + (u[j].z * u[j].z + u[j].w * u[j].w); }
        const float rstd0 = 1.f / sqrtf(wave_sum(s2) * (1.f / D) + EPS), rstd1 = 1.f / sqrtf(wave_sum(q2) * (1.f / D) + EPS);
        { const GAS f32x4* sh = (const GAS f32x4*)(mod + (size_t)b0 * MODW) + lane; const GAS f32x4* sc = (const GAS f32x4*)(mod + (size_t)b0 * MODW + D) + lane; GAS v2u* o8 = (GAS v2u*)(H + (size_t)r0 * D) + lane;
#pragma unroll
          for (int j = 0; j < 8; ++j) { const f32x4 a = sh[64 * j], m = sc[64 * j]; const f32x4 y = v[j] * rstd0 * (m + 1.0f) + a; v2u o; o.x = pk2(y.x, y.y); o.y = pk2(y.z, y.w); o8[64 * j] = o; } }
        if (has1) { const GAS f32x4* sh = (const GAS f32x4*)(mod + (size_t)b1 * MODW) + lane; const GAS f32x4* sc = (const GAS f32x4*)(mod + (size_t)b1 * MODW + D) + lane; GAS v2u* o8 = (GAS v2u*)(H + (size_t)r1 * D) + lane;
#pragma unroll
          for (int j = 0; j < 8; ++j) { const f32x4 a = sh[64 * j], m = sc[64 * j]; const f32x4 y = u[j] * rstd1 * (m + 1.0f) + a; v2u o; o.x = pk2(y.x, y.y); o.y = pk2(y.z, y.w); o8[64 * j] = o; } }
    }
}

struct SchedInproj {
    static constexpr bool DSTPF = false;
    const char* H; const char* W; int G, c;
    __device__ __forceinline__ bool next(int i, pg8::Unit& u) {
        const int L = i * G + c; if (L >= 1536 + 256) return false;
        if (L < 1536) { int pm, pn; tile_order(L, 128, 12, pm, pn);
            u.pm = pm; u.pn = pn; u.aux0 = 0; u.aux1 = 0; u.nt = 0; u.a = H + (size_t)pm * 256 * (D * 2); u.b = W + (size_t)pn * 256 * (D * 2); }
        else {
            const int x = L - 1536, tile = x >> 3, ks = x & 7, pm = 128 + (tile >> 2), pn = tile & 3;
            u.pm = pm; u.pn = pn; u.aux0 = 1 + ks; u.aux1 = 0; u.nt = 4; u.a = H + (size_t)pm * 256 * (D * 2) + ks * 512; u.b = W + (size_t)pn * 256 * (D * 2) + ks * 512; }
        return true;
    }
};
struct EpiInproj {
    static __device__ __forceinline__ int a_row(int h, int R) { return 128 * h + R; }
    bf16* U; bf16* UPART;
    __device__ __forceinline__ void operator()(const f32x4 (&acc)[2][2][4][2], const pg8::Unit& u, int wr, int wc, int fr, int fq, LAS unsigned char*) const {
        const int arr = u.pn >> 2; const size_t aoff = (arr >= 1 ? (size_t)TT * DL : 0) + (arr >= 2 ? (size_t)T * DL : 0);
        bf16* base = U + aoff;
        int rowsub = 0; if (u.aux0 > 0) { base = UPART + (size_t)(u.aux0 - 1) * TC * DL; rowsub = T; }
        const int row0 = u.pm * 256 + wr * 64 + fr - rowsub, col0 = (u.pn & 3) * 256 + wc * 32 + 8 * fq;
#pragma unroll
        for (int ai = 0; ai < 2; ++ai)
#pragma unroll
            for (int m = 0; m < 4; ++m) { bf16* rowp = base + (size_t)(row0 + ai * 128 + m * 16) * DL + col0;
#pragma unroll
                for (int bj = 0; bj < 2; ++bj) { const f32x4 v0 = acc[ai][bj][m][0], v1 = acc[ai][bj][m][1];
                    v4u w; w.x = cvt_pk_bf16(v0[0], v0[1]); w.y = cvt_pk_bf16(v0[2], v0[3]); w.z = cvt_pk_bf16(v1[0], v1[1]); w.w = cvt_pk_bf16(v1[2], v1[3]);
                    *(v4u*)(rowp + bj * 128) = w; } }
    }
};
}
namespace mk {
__device__ __forceinline__ void p3_conv(const Args& A, int lane, int wave, int vcu, int G) {
    const int gw = vcu * NWAVES + wave, NGW = G * NWAVES;
    const bf16* U = (const bf16*)(A.ws + WS_U); const bf16* UPART = (const bf16*)(A.ws + WS_UPART); bf16* UC = (bf16*)(A.ws + WS_UC);
    const float* cw = A.in[7]; const float* cb = A.in[8];
    for (int it = gw; it < (TT / 64) * 4; it += NGW) {
        const int rb = it >> 2, cblk = it & 3, r0 = rb * 64, ch = cblk * 256 + lane * 4;
        int slo, shi; if (r0 < T) { slo = r0; shi = r0 + 64; } else { slo = T + ((r0 - T) & ~255); shi = slo + 256; }
        const f32x4 w0 = *(const f32x4*)(cw + ch), w1 = *(const f32x4*)(cw + DL + ch), w2 = *(const f32x4*)(cw + 2 * DL + ch), w3 = *(const f32x4*)(cw + 3 * DL + ch), bb = *(const f32x4*)(cb + ch);
        auto ld = [&](int r) -> f32x4 { if (r < slo || r >= shi) return (f32x4){0.f, 0.f, 0.f, 0.f};
            if (r < T) { const v2u q = *(const GAS v2u*)(U + (size_t)r * DL + ch); return (f32x4){bf_lo(q.x), bf_hi(q.x), bf_lo(q.y), bf_hi(q.y)}; }
            f32x4 a = (f32x4){0.f, 0.f, 0.f, 0.f};
#pragma unroll
            for (int ks = 0; ks < 8; ++ks) { const v2u q = *(const GAS v2u*)(UPART + ((size_t)ks * TC + (r - T)) * DL + ch); a = a + (f32x4){bf_lo(q.x), bf_hi(q.x), bf_lo(q.y), bf_hi(q.y)}; }
            return a; };
        f32x4 um2 = ld(r0 - 2), um1 = ld(r0 - 1), u0 = ld(r0);
#pragma unroll 8
        for (int p = 0; p < 64; ++p) {
            const f32x4 up1 = ld(r0 + p + 1);
            const f32x4 y = bb + w0 * um2 + w1 * um1 + w2 * u0 + w3 * up1;
            v2u o; o.x = pk2(y.x, y.y); o.y = pk2(y.z, y.w); *(GAS v2u*)(UC + (size_t)(r0 + p) * DL + ch) = o;
            um2 = um1; um1 = u0; u0 = up1;
        }
    }
}
__device__ __forceinline__ void p3_fold(const Args& A, LAS unsigned char* lds, int lane, int wave, int vcu, int G) {
    const int gw = vcu * NWAVES + wave, NGW = G * NWAVES;
    const bf16* FOUR = (const bf16*)(A.ws + WS_FOUR); bf16* PQT = (bf16*)(A.ws + WS_PQT); float* misc = (float*)(A.ws + WS_MISC);
    LAS bf16* scr = (LAS bf16*)(lds + wave * 16384);
    const int c8 = lane & 7, rr = lane >> 3;
    for (int it = gw; it < NB * 16 * 32; it += NGW) {
        const int nb = it & 31, cblk = (it >> 5) & 15, b = it >> 9, g = cblk >> 1, half = cblk & 1, n0 = nb * 64;
        const bf16* base = FOUR + (size_t)b * SEQ * DF + g * 128 + half * 64 + c8 * 8;
#pragma unroll
        for (int s = 0; s < 8; ++s) {
            const int nn = s * 8 + rr, n = n0 + nn;
            const v4u x = *(const GAS v4u*)(base + (size_t)n * DF);
            v4u xm = (v4u){0u, 0u, 0u, 0u}; if (n >= 1) xm = *(const GAS v4u*)(base + (size_t)(SEQ - n) * DF);
            float v[8], vm[8];
            v[0] = bf_lo(x.x); v[1] = bf_hi(x.x); v[2] = bf_lo(x.y); v[3] = bf_hi(x.y); v[4] = bf_lo(x.z); v[5] = bf_hi(x.z); v[6] = bf_lo(x.w); v[7] = bf_hi(x.w);
            vm[0] = bf_lo(xm.x); vm[1] = bf_hi(xm.x); vm[2] = bf_lo(xm.y); vm[3] = bf_hi(xm.y); vm[4] = bf_lo(xm.z); vm[5] = bf_hi(xm.z); vm[6] = bf_lo(xm.w); vm[7] = bf_hi(xm.w);
#pragma unroll
            for (int j = 0; j < 8; ++j) {
                float p;
                if (half == 0) p = v[j] + vm[j];
                else if (c8 == 0 && j == 0) { misc[MS_P64 + (b * 8 + g) * P64_LD + n] = v[0] + vm[0]; p = 0.f; }
                else p = (n >= 1) ? v[j] - vm[j] : 0.f;
                scr[(c8 * 8 + j) * 66 + nn] = (bf16)f2bf(p);
            }
        }
        LDS_WAIT(); asm volatile("" ::: "memory");
        bf16* dst = PQT + (((size_t)b * 2 + half) * 512 + g * 64) * 2048 + n0 + c8 * 8;
#pragma unroll
        for (int s = 0; s < 8; ++s) {
            const int jj = s * 8 + rr; const LAS bf16* q = scr + jj * 66 + c8 * 8;
            const unsigned a0 = q[0] | ((unsigned)q[1] << 16), a1 = q[2] | ((unsigned)q[3] << 16), a2 = q[4] | ((unsigned)q[5] << 16), a3 = q[6] | ((unsigned)q[7] << 16);
            *(GAS v4u*)(dst + (size_t)jj * 2048) = (v4u){a0, a1, a2, a3};
            if (half == 0) {
                float ps = (bf_lo(a0) - bf_hi(a0)) + (bf_lo(a1) - bf_hi(a1)) + (bf_lo(a2) - bf_hi(a2)) + (bf_lo(a3) - bf_hi(a3));
                ps += __shfl_xor(ps, 1); ps += __shfl_xor(ps, 2); ps += __shfl_xor(ps, 4);
                if (c8 == 0) misc[MS_ALT + (b * 32 + nb) * 512 + g * 64 + jj] = ps;
            }
        }
        LDS_WAIT(); asm volatile("" ::: "memory");
    }
    if (gw < NB * 8) { const int b = gw >> 3, g = gw & 7; if (lane == 0) misc[MS_P64 + (b * 8 + g) * P64_LD + 2048] = bf2f(FOUR[((size_t)b * SEQ + 2048) * DF + g * 128 + 64]); }
}

struct SchedDft {
    static constexpr bool DSTPF = false;
    const char* CS; const char* PQT; int G, c;
    __device__ __forceinline__ bool next(int i, pg8::Unit& u) {
        const int L = i * G + c; if (L >= 256) return false;
        const int b = L >> 5, kt = (L >> 2) & 7, ct = L & 3, type = ct >> 1;
        u.pm = kt; u.pn = ct; u.aux0 = b; u.aux1 = 0; u.nt = 0;
        u.a = CS + ((size_t)type * 2048 + kt * 256) * 4096; u.b = PQT + (((size_t)b * 2 + type) * 512 + (ct & 1) * 256) * 4096; return true;
    }
};
struct EpiDft {
    static __device__ __forceinline__ int a_row(int h, int R) { return 128 * h + R; }
    bf16* AB;
    __device__ __forceinline__ void operator()(f32x4 (&acc)[2][2][4][2], const pg8::Unit& u, int wr, int wc, int fr, int fq, LAS unsigned char*) const {
        const int row0 = u.pm * 256 + wr * 64 + fr, col0 = u.pn * 256 + wc * 32 + 4 * fq;
        bf16* base = AB + (size_t)u.aux0 * 2048 * 1024;
#pragma unroll
        for (int ai = 0; ai < 2; ++ai)
#pragma unroll
            for (int m = 0; m < 4; ++m) { bf16* rowp = base + (size_t)(row0 + ai * 128 + m * 16) * 1024 + col0;
#pragma unroll
                for (int bj = 0; bj < 2; ++bj)
#pragma unroll
                    for (int n = 0; n < 2; ++n) { const f32x4 v = acc[ai][bj][m][n]; v2u w; w.x = cvt_pk_bf16(v[0], v[1]); w.y = cvt_pk_bf16(v[2], v[3]); *(v2u*)(rowp + bj * 128 + n * 16) = w; } }
    }
};

struct SchedGates {
    static constexpr bool DSTPF = false;
    const char* UC; const char* WG4; int G, c;
    __device__ __forceinline__ bool next(int i, pg8::Unit& u) {
        const int L = i * G + c; if (L >= (TT / 256) * 16) return false;
        const int st = L >> 4, hq = L & 15;
        u.pm = st; u.pn = hq; u.aux0 = st; u.aux1 = hq; u.nt = 0;
        u.a = UC + (size_t)st * 256 * (DL * 2) + (hq >> 2) * 512; u.b = WG4 + (size_t)hq * 256 * 512; return true;
    }
};
template <int CTRL> __device__ __forceinline__ float dpp_f(float oldv, float src) {
    return __builtin_bit_cast(float, __builtin_amdgcn_update_dpp(__builtin_bit_cast(int, oldv), __builtin_bit_cast(int, src), CTRL, 0xF, 0xF, false));
}
template <int DIR, int DIST> __device__ __forceinline__ void scan_step(float& a, float& b) {
    const float ap = dpp_f<(DIR ? 0x100 : 0x110) + DIST>(1.0f, a), bp = dpp_f<(DIR ? 0x100 : 0x110) + DIST>(0.0f, b);
    b = a * bp + b; a = ap * a;
}
struct EpiLru {
    static __device__ __forceinline__ int a_row(int h, int R) { return 128 * (R >> 6) + 8 * (R & 15) + 4 * h + ((R >> 4) & 3); }
    const bf16* UC; const float* ba; const float* bx; bf16* S; bf16* PF; bf16* PB; float* misc;
    __device__ __forceinline__ void operator()(f32x4 (&acc)[2][2][4][2], const pg8::Unit& u, int wr, int wc, int fr, int fq, LAS unsigned char*) const {
        int tz = threadIdx.x; asm volatile("" : "+v"(tz));
        fr = tz & 15; fq = (tz >> 4) & 3;
        const int st = u.aux0, hq = u.aux1, ch0 = hq * 64 + wc * 16 + fq * 4;
        const int row0 = st * 256 + wr * 128 + fr * 8;
        v2u ucp[2][4];
#pragma unroll
        for (int ai = 0; ai < 2; ++ai)
#pragma unroll
            for (int m = 0; m < 4; ++m) ucp[ai][m] = *(const GAS v2u*)((const GAS char*)UC + ((unsigned)(row0 + 4 * ai + m) * DL + ch0) * 2u);
#pragma unroll
        for (int d = 0; d < 2; ++d) {
            const f32x4 bav = *(const f32x4*)(misc + MS_GB + d * 2 * DL + ch0), bxv = *(const f32x4*)(misc + MS_GB + d * 2 * DL + DL + ch0), spv = *(const f32x4*)(misc + MS_SP + d * DL + ch0);
            f32x4 c = (f32x4){1.f, 1.f, 1.f, 1.f}, h = (f32x4){0.f, 0.f, 0.f, 0.f};
#pragma unroll
            for (int ii = 0; ii < 8; ++ii) { const int i = d ? 7 - ii : ii, ai = i >> 2, m = i & 3;
                const f32x4 x = (f32x4){bf_lo(ucp[ai][m].x), bf_hi(ucp[ai][m].x), bf_lo(ucp[ai][m].y), bf_hi(ucp[ai][m].y)};
                const f32x4 p0 = acc[ai][d][m][0] + bav, p1 = acc[ai][d][m][1] + bxv;
                f32x4 a, b;
#pragma unroll
                for (int e = 0; e < 4; ++e) { const float r = __builtin_amdgcn_rcpf(1.0f + __builtin_amdgcn_exp2f(p0[e])), ig = __builtin_amdgcn_rcpf(1.0f + __builtin_amdgcn_exp2f(p1[e])); const float av = __builtin_amdgcn_exp2f(r * spv[e]); a[e] = av; b[e] = __builtin_amdgcn_sqrtf(fmaxf(1.0f - av * av, 0.f)) * ig; }
                h = a * h + b * x; c = c * a; acc[ai][d][m][0] = c; acc[ai][d][m][1] = h;
                if (ii & 1) __builtin_amdgcn_sched_barrier(0); }
            f32x4 cin, hin;
#pragma unroll
            for (int e = 0; e < 4; ++e) { float ta = c[e], tb = h[e];
                if (d == 0) { scan_step<0, 1>(ta, tb); scan_step<0, 2>(ta, tb); scan_step<0, 4>(ta, tb); scan_step<0, 8>(ta, tb); }
                else        { scan_step<1, 1>(ta, tb); scan_step<1, 2>(ta, tb); scan_step<1, 4>(ta, tb); scan_step<1, 8>(ta, tb); }
                cin[e] = d ? dpp_f<0x101>(1.0f, ta) : dpp_f<0x111>(1.0f, ta); hin[e] = d ? dpp_f<0x101>(0.0f, tb) : dpp_f<0x111>(0.0f, tb); }
#pragma unroll
            for (int i = 0; i < 8; ++i) { const int ai = i >> 2, m = i & 3; const f32x4 cl = acc[ai][d][m][0]; acc[ai][d][m][1] = acc[ai][d][m][1] + cl * hin; acc[ai][d][m][0] = cl * cin; }
            __builtin_amdgcn_sched_barrier(0);
        }
        const int sub = st * 2 + wr;
#pragma unroll
        for (int ai = 0; ai < 2; ++ai)
#pragma unroll
            for (int m = 0; m < 4; ++m) {
                const f32x4 pf = acc[ai][0][m][0], hf = acc[ai][0][m][1], pb = acc[ai][1][m][0], hb = acc[ai][1][m][1];
                const unsigned off = ((unsigned)(row0 + 4 * ai + m) * DL + ch0) * 2u;
                if (st < T / 256) {
                    v2u o; o.x = cvt_pk_bf16(hf[0] + hb[0], hf[1] + hb[1]); o.y = cvt_pk_bf16(hf[2] + hb[2], hf[3] + hb[3]); *(GAS v2u*)((GAS char*)S + off) = o;
                    o.x = cvt_pk_bf16(pf[0], pf[1]); o.y = cvt_pk_bf16(pf[2], pf[3]); *(GAS v2u*)((GAS char*)PF + off) = o;
                    o.x = cvt_pk_bf16(pb[0], pb[1]); o.y = cvt_pk_bf16(pb[2], pb[3]); *(GAS v2u*)((GAS char*)PB + off) = o;
                }
                if (ai == 1 && m == 3 && fr == 15) { *(f32x4*)(misc + MS_SUMA + ((size_t)sub * 2 + 0) * DL + ch0) = pf; *(f32x4*)(misc + MS_SUMB + ((size_t)sub * 2 + 0) * DL + ch0) = hf; }
                if (ai == 0 && m == 0 && fr == 0) { *(f32x4*)(misc + MS_SUMA + ((size_t)sub * 2 + 1) * DL + ch0) = pb; *(f32x4*)(misc + MS_SUMB + ((size_t)sub * 2 + 1) * DL + ch0) = hb; }
            }
    }
};

__device__ __forceinline__ void p5a_fix(const Args& A, LAS unsigned char* lds, int tid, int lane, int wave, int vcu, int G) {
    const int gw = vcu * NWAVES + wave, NGW = G * NWAVES;
    const float* misc = (const float*)(A.ws + WS_MISC);
    const bf16* Sb = (const bf16*)(A.ws + WS_S); const bf16* PF = (const bf16*)(A.ws + WS_PF); const bf16* PB = (const bf16*)(A.ws + WS_PB); const bf16* GATE = (const bf16*)(A.ws + WS_GATE);
    bf16* YMIX = (bf16*)(A.ws + WS_YMIX); const float* gl = A.in[14];
    {
        LAS float* ctab = (LAS float*)lds;
        LAS float* eo = (LAS float*)(lds + 16384 + wave * 8192);
        for (int i = tid; i < 4096; i += NTHR) ctab[i] = __builtin_amdgcn_cosf((float)i * (1.0f / 4096.0f));
        __syncthreads();
        float* nyq = (float*)(A.ws + WS_MISC) + MS_NYQ;
        for (int it = gw; it < 64 * 32; it += NGW) {
            const int bg = it >> 5, kb = it & 31, kp = kb * 64 + lane;
            const float* src = misc + MS_P64 + (size_t)bg * P64_LD;
#pragma unroll 4
            for (int i = lane; i < 1024; i += 64) { const float p = src[i], q = src[2048 - i]; eo[2 * i] = p + q; eo[2 * i + 1] = p - q; }
            const float pmid = src[1024];
            LDS_WAIT(); asm volatile("" ::: "memory");
            float s = 0.f; int j = 0; const int par = lane & 1;
#pragma unroll 8
            for (int n = 0; n < 1024; ++n) { s += eo[2 * n + par] * ctab[j]; j = (j + kp) & 4095; }
            s += pmid * ctab[j];
            nyq[(size_t)bg * P64_LD + kp] = s;
            if (kb == 0) { float a = 0.f;
#pragma unroll 1
                for (int n = lane; n < 1024; n += 64) a += (n & 1) ? -eo[2 * n] : eo[2 * n]; a = wave_sum(a) + pmid; if (lane == 0) nyq[(size_t)bg * P64_LD + 2048] = a; }
            LDS_WAIT(); asm volatile("" ::: "memory");
        }
    }
    for (int it = gw; it < T / 16; it += NGW) {
        const int t0 = it * 16, b = t0 / SEQ, c = (t0 % SEQ) / 128, ch = lane * 16;
        float cf[16], cbk[16];
        {
            const int cs0 = T / 128 + 2 * b;
            const float* f0b = misc + MS_SUMB + ((size_t)cs0 * 2 + 0) * DL + ch; const float* f1a = misc + MS_SUMA + ((size_t)(cs0 + 1) * 2 + 0) * DL + ch; const float* f1b = misc + MS_SUMB + ((size_t)(cs0 + 1) * 2 + 0) * DL + ch;
            const float* b1b = misc + MS_SUMB + ((size_t)(cs0 + 1) * 2 + 1) * DL + ch; const float* b0a = misc + MS_SUMA + ((size_t)cs0 * 2 + 1) * DL + ch; const float* b0b = misc + MS_SUMB + ((size_t)cs0 * 2 + 1) * DL + ch;
#pragma unroll
            for (int q = 0; q < 4; ++q) { const f32x4 v0 = *(const f32x4*)(f0b + 4 * q), a1 = *(const f32x4*)(f1a + 4 * q), v1 = *(const f32x4*)(f1b + 4 * q);
                const f32x4 w1 = *(const f32x4*)(b1b + 4 * q), a0 = *(const f32x4*)(b0a + 4 * q), w0 = *(const f32x4*)(b0b + 4 * q);
#pragma unroll
                for (int e = 0; e < 4; ++e) { cf[4 * q + e] = a1[e] * v0[e] + v1[e]; cbk[4 * q + e] = a0[e] * w1[e] + w0[e]; } }
            for (int cc = 0; cc < c; ++cc) { const float* pa = misc + MS_SUMA + ((size_t)(b * NSUB + cc) * 2 + 0) * DL + ch; const float* pb = misc + MS_SUMB + ((size_t)(b * NSUB + cc) * 2 + 0) * DL + ch;
#pragma unroll
                for (int q = 0; q < 4; ++q) { const f32x4 va = *(const f32x4*)(pa + 4 * q), vb = *(const f32x4*)(pb + 4 * q);
#pragma unroll
                    for (int e = 0; e < 4; ++e) cf[4 * q + e] = va[e] * cf[4 * q + e] + vb[e]; } }
            for (int cc = NSUB - 1; cc > c; --cc) { const float* pa = misc + MS_SUMA + ((size_t)(b * NSUB + cc) * 2 + 1) * DL + ch; const float* pb = misc + MS_SUMB + ((size_t)(b * NSUB + cc) * 2 + 1) * DL + ch;
#pragma unroll
                for (int q = 0; q < 4; ++q) { const f32x4 va = *(const f32x4*)(pa + 4 * q), vb = *(const f32x4*)(pb + 4 * q);
#pragma unroll
                    for (int e = 0; e < 4; ++e) cbk[4 * q + e] = va[e] * cbk[4 * q + e] + vb[e]; } }
        }
        v4u nx[2][4];
        { const size_t off = (size_t)t0 * DL + ch;
#pragma unroll
          for (int hh = 0; hh < 2; ++hh) { nx[hh][0] = *(const GAS v4u*)(Sb + off + 8 * hh); nx[hh][1] = *(const GAS v4u*)(PF + off + 8 * hh); nx[hh][2] = *(const GAS v4u*)(PB + off + 8 * hh); nx[hh][3] = *(const GAS v4u*)(GATE + off + 8 * hh); } }
        for (int tt = 0; tt < 16; ++tt) {
            v4u cu[2][4];
#pragma unroll
            for (int hh = 0; hh < 2; ++hh)
#pragma unroll
                for (int a4 = 0; a4 < 4; ++a4) cu[hh][a4] = nx[hh][a4];
            if (tt < 15) { const size_t off = (size_t)(t0 + tt + 1) * DL + ch;
#pragma unroll
                for (int hh = 0; hh < 2; ++hh) { nx[hh][0] = *(const GAS v4u*)(Sb + off + 8 * hh); nx[hh][1] = *(const GAS v4u*)(PF + off + 8 * hh); nx[hh][2] = *(const GAS v4u*)(PB + off + 8 * hh); nx[hh][3] = *(const GAS v4u*)(GATE + off + 8 * hh); } }
            float y[16]; float ss = 0.f;
#pragma unroll
            for (int hh = 0; hh < 2; ++hh) {
                const v4u s4 = cu[hh][0], f4 = cu[hh][1], b4 = cu[hh][2], g4 = cu[hh][3];
                const unsigned sw[4] = {s4.x, s4.y, s4.z, s4.w}, fw[4] = {f4.x, f4.y, f4.z, f4.w}, bw[4] = {b4.x, b4.y, b4.z, b4.w}, gw4[4] = {g4.x, g4.y, g4.z, g4.w};
#pragma unroll
                for (int q = 0; q < 4; ++q) { const int i0 = 8 * hh + 2 * q;
                    const float v0 = (bf_lo(sw[q]) + bf_lo(fw[q]) * cf[i0] + bf_lo(bw[q]) * cbk[i0]) * gelu_tanh_f(bf_lo(gw4[q]));
                    const float v1 = (bf_hi(sw[q]) + bf_hi(fw[q]) * cf[i0 + 1] + bf_hi(bw[q]) * cbk[i0 + 1]) * gelu_tanh_f(bf_hi(gw4[q]));
                    y[i0] = v0; y[i0 + 1] = v1; ss += v0 * v0 + v1 * v1; }
            }
            const float r = 1.0f / sqrtf(wave_sum(ss) * (1.0f / DL) + EPS);
            float gn[16];
#pragma unroll
            for (int q = 0; q < 4; ++q) { const f32x4 v = *(const f32x4*)(gl + ch + 4 * q);
#pragma unroll
                for (int e = 0; e < 4; ++e) gn[4 * q + e] = v[e]; }
            v4u o0, o1;
            o0.x = pk2(y[0] * r * gn[0], y[1] * r * gn[1]); o0.y = pk2(y[2] * r * gn[2], y[3] * r * gn[3]); o0.z = pk2(y[4] * r * gn[4], y[5] * r * gn[5]); o0.w = pk2(y[6] * r * gn[6], y[7] * r * gn[7]);
            o1.x = pk2(y[8] * r * gn[8], y[9] * r * gn[9]); o1.y = pk2(y[10] * r * gn[10], y[11] * r * gn[11]); o1.z = pk2(y[12] * r * gn[12], y[13] * r * gn[13]); o1.w = pk2(y[14] * r * gn[14], y[15] * r * gn[15]);
            GAS v4u* dst = (GAS v4u*)(YMIX + (size_t)(t0 + tt) * D + ch); dst[0] = o0; dst[1] = o1;
        }
    }
}

__device__ __forceinline__ void p5b_four(const Args& A, LAS unsigned char* lds, int lane, int wave, int vcu, int G) {
    const int gw = vcu * NWAVES + wave, NGW = G * NWAVES;
    const float* misc = (const float*)(A.ws + WS_MISC); const bf16* AB = (const bf16*)(A.ws + WS_AB); const bf16* FOUR = (const bf16*)(A.ws + WS_FOUR);
    bf16* YMIX = (bf16*)(A.ws + WS_YMIX); const float* gf = A.in[15];
    LAS bf16* rowbuf = (LAS bf16*)(lds + wave * 4096);
    const int g = lane >> 3, jl = lane & 7;
    for (int t = gw; t < T; t += NGW) {
        const int b = t / SEQ, k = t % SEQ, kp = (k <= 2048) ? k : SEQ - k; const float sg = (k <= 2048) ? 1.0f : -1.0f;
        float av[8], bv[8];
        if (kp < 2048) {
            const bf16* row = AB + ((size_t)b * 2048 + kp) * 1024 + g * 64 + jl * 8;
            const v4u a4 = *(const GAS v4u*)row, b4 = *(const GAS v4u*)(row + 512);
            const v4u w4 = *(const GAS v4u*)(FOUR + ((size_t)b * SEQ + 2048) * DF + g * 128 + jl * 8);
            const float sk = (kp & 1) ? -1.0f : 1.0f;
            av[0] = bf_lo(a4.x) + sk * bf_lo(w4.x); av[1] = bf_hi(a4.x) + sk * bf_hi(w4.x); av[2] = bf_lo(a4.y) + sk * bf_lo(w4.y); av[3] = bf_hi(a4.y) + sk * bf_hi(w4.y);
            av[4] = bf_lo(a4.z) + sk * bf_lo(w4.z); av[5] = bf_hi(a4.z) + sk * bf_hi(w4.z); av[6] = bf_lo(a4.w) + sk * bf_lo(w4.w); av[7] = bf_hi(a4.w) + sk * bf_hi(w4.w);
            bv[0] = bf_lo(b4.x); bv[1] = bf_hi(b4.x); bv[2] = bf_lo(b4.y); bv[3] = bf_hi(b4.y); bv[4] = bf_lo(b4.z); bv[5] = bf_hi(b4.z); bv[6] = bf_lo(b4.w); bv[7] = bf_hi(b4.w);
        } else {
            const v4u w4 = *(const GAS v4u*)(FOUR + ((size_t)b * SEQ + 2048) * DF + g * 128 + jl * 8);
            av[0] = bf_lo(w4.x); av[1] = bf_hi(w4.x); av[2] = bf_lo(w4.y); av[3] = bf_hi(w4.y); av[4] = bf_lo(w4.z); av[5] = bf_hi(w4.z); av[6] = bf_lo(w4.w); av[7] = bf_hi(w4.w);
            for (int nb = 0; nb < 32; ++nb) { const float* p = misc + MS_ALT + ((size_t)b * 32 + nb) * 512 + g * 64 + jl * 8; const f32x4 p0 = *(const f32x4*)p, p1 = *(const f32x4*)(p + 4);
                av[0] += p0[0]; av[1] += p0[1]; av[2] += p0[2]; av[3] += p0[3]; av[4] += p1[0]; av[5] += p1[1]; av[6] += p1[2]; av[7] += p1[3]; }
#pragma unroll
            for (int i = 0; i < 8; ++i) bv[i] = 0.f;
        }
        float y0[8], y1[8]; float ss = 0.f;
#pragma unroll
        for (int i = 0; i < 8; ++i) { y0[i] = av[i] + sg * bv[i]; y1[i] = av[i] - sg * bv[i]; }
        if (jl == 0) { y0[0] = av[0]; y1[0] = misc[MS_NYQ + (size_t)(b * 8 + g) * P64_LD + kp]; }
#pragma unroll
        for (int i = 0; i < 8; ++i) ss += y0[i] * y0[i] + y1[i] * y1[i];
        const float r = 1.0f / sqrtf(wave_sum(ss) * (1.0f / DF) + EPS);
#pragma unroll
        for (int i = 0; i < 8; ++i) { const int mp = jl * 8 + i, m0 = mp, m1 = (mp == 0) ? 64 : 128 - mp;
            rowbuf[g * 128 + m0] = (bf16)f2bf(y0[i] * r * gf[g * 128 + m0]); rowbuf[g * 128 + m1] = (bf16)f2bf(y1[i] * r * gf[g * 128 + m1]); }
        LDS_WAIT(); asm volatile("" ::: "memory");
        { const v4u q0 = *(const LAS v4u*)(rowbuf + lane * 16), q1 = *(const LAS v4u*)(rowbuf + lane * 16 + 8);
          GAS v4u* dst = (GAS v4u*)(YMIX + (size_t)t * D + DL + lane * 16); dst[0] = q0; dst[1] = q1; }
        LDS_WAIT(); asm volatile("" ::: "memory");
    }
}
}
namespace mk {
struct SchedTiles {      static constexpr bool DSTPF = false;
    const char* Abase; const char* Bbase; int nM, nN, G, c; unsigned lda_b, ldb_b;
    __device__ __forceinline__ bool next(int i, pg8::Unit& u) {
        const int L = i * G + c; if (L >= nM * nN) return false;
        int pm, pn; tile_order(L, nM, nN, pm, pn);
        u.pm = pm; u.pn = pn; u.aux0 = 0; u.aux1 = 0; u.nt = 0; u.a = Abase + (size_t)pm * 256 * lda_b; u.b = Bbase + (size_t)pn * 256 * ldb_b; return true;
    }
};
struct EpiBf16 {
    static __device__ __forceinline__ int a_row(int h, int R) { return 128 * h + R; }
    bf16* O; int ldc;
    __device__ __forceinline__ void operator()(f32x4 (&acc)[2][2][4][2], const pg8::Unit& u, int wr, int wc, int fr, int fq, LAS unsigned char*) const {
        const int row0 = u.pm * 256 + wr * 64 + fr, col0 = u.pn * 256 + wc * 32 + 8 * fq;
#pragma unroll
        for (int ai = 0; ai < 2; ++ai)
#pragma unroll
            for (int m = 0; m < 4; ++m) { const unsigned off = ((unsigned)(row0 + ai * 128 + m * 16) * (unsigned)ldc + col0) * 2u;
#pragma unroll
                for (int bj = 0; bj < 2; ++bj) { const f32x4 v0 = acc[ai][bj][m][0], v1 = acc[ai][bj][m][1];
                    v4u w; w.x = cvt_pk_bf16(v0[0], v0[1]); w.y = cvt_pk_bf16(v0[2], v0[3]); w.z = cvt_pk_bf16(v1[0], v1[1]); w.w = cvt_pk_bf16(v1[2], v1[3]);
                    *(GAS v4u*)((GAS char*)O + off + bj * 256) = w; } }
    }
};

constexpr int P8_BPITCH = 264;
__device__ __forceinline__ void p8_ln_router(const Args& A, LAS unsigned char* lds, int tid, int lane, int wave, int vcu, int G) {
    const float* mod = (const float*)(A.ws + WS_MOD); const bf16* MIX = (const bf16*)(A.ws + WS_MIX);
    bf16* H2HI = (bf16*)(A.ws + WS_H2HI); bf16* H2LO = (bf16*)(A.ws + WS_H2LO); unsigned* H2F8 = (unsigned*)(A.ws + WS_H2F8); const bf16* WR = (const bf16*)(A.ws + WS_WR);
    int* cnt = (int*)(A.ws + WS_CTL) + CW_CNT; int* rt_tok = (int*)(A.ws + WS_ROUTE + RT_TOK); int* rt_dst = (int*)(A.ws + WS_ROUTE + RT_DST); float* rt_w = (float*)(A.ws + WS_ROUTE + RT_W);
    LAS bf16* bl = (LAS bf16*)lds;
    LAS float* lg = (LAS float*)(lds + 2 * 64 * P8_BPITCH * 2) + wave * (16 * 65);
    { const int gw = vcu * NWAVES + wave, NGW = G * NWAVES;
      for (int i = gw * 64 + lane; i < T; i += NGW * 64) { const int s = i / TS, tl = i % TS; rt_tok[((size_t)s * NEX + NE) * TS + tl] = tl; rt_dst[((size_t)s * NEX + NE) * TS + tl] = tl * 9 + 8; } }
    for (int tb = vcu; tb < T / 128; tb += G) {
        const int t0 = tb * 128 + wave * 16;
        LAS f32x4* pv = (LAS f32x4*)lds;
        {   const int b = (tb * 128) / SEQ; __syncthreads();
            const f32x4* s0 = (const f32x4*)(mod + (size_t)b * MODW + 2 * D); const f32x4* s1 = (const f32x4*)A.in[17]; const f32x4* s2 = (const f32x4*)A.in[18];
            const f32x4* s3 = (const f32x4*)(mod + (size_t)b * MODW + 3 * D); const f32x4* s4 = (const f32x4*)(mod + (size_t)b * MODW + 4 * D);
            pv[tid] = s0[tid]; pv[512 + tid] = s1[tid]; pv[1024 + tid] = s2[tid]; pv[1536 + tid] = s3[tid]; pv[2048 + tid] = s4[tid];
            __syncthreads(); }
#ifndef P8_REP
#define P8_REP 1
#endif
        f32x4 lacc[4]; const int arow = lane & 15, akq = lane >> 4;
        for (int rep8 = 0; rep8 < P8_REP; ++rep8) {
        for (int i = 0; i < 16; i += 2) {
            asm volatile("" ::: "memory");
            const int t = t0 + i;
            const GAS f32x4* xr = (const GAS f32x4*)(A.in[0] + (size_t)t * D) + lane; const GAS v2u* mr = (const GAS v2u*)(MIX + (size_t)t * D) + lane;
            const LAS f32x4* g1 = pv + lane;
            f32x4 v[8], u[8]; float s = 0.f, q = 0.f;
#pragma unroll
            for (int j = 0; j < 8; ++j) { const f32x4 xv = xr[64 * j], xw = xr[64 * j + 512], gv = g1[64 * j]; const v2u mv = mr[64 * j], mw = mr[64 * j + 512];
                v[j] = xv * ALPHA + gv * (f32x4){bf_lo(mv.x), bf_hi(mv.x), bf_lo(mv.y), bf_hi(mv.y)}; s += (v[j].x + v[j].y) + (v[j].z + v[j].w);
                u[j] = xw * ALPHA + gv * (f32x4){bf_lo(mw.x), bf_hi(mw.x), bf_lo(mw.y), bf_hi(mw.y)}; q += (u[j].x + u[j].y) + (u[j].z + u[j].w); }
            float mean = wave_sum(s) * (1.f / D), meanu = wave_sum(q) * (1.f / D), s2 = 0.f, q2 = 0.f;
#pragma unroll
            for (int j = 0; j < 8; ++j) { v[j] = v[j] - mean; u[j] = u[j] - meanu; s2 += (v[j].x * v[j].x + v[j].y * v[j].y) + (v[j].z * v[j].z + v[j].w * v[j].w); q2 += (u[j].x * u[j].x + u[j].y * u[j].y) + (u[j].z * u[j].z + u[j].w * u[j].w); }
            float rstd = 1.f / sqrtf(wave_sum(s2) * (1.f / D) + EPS), rstdu = 1.f / sqrtf(wave_sum(q2) * (1.f / D) + EPS);
            const LAS f32x4* lg1 = pv + 512 + lane; const LAS f32x4* lb1 = pv + 1024 + lane; GAS f32x4* xo = (GAS f32x4*)(A.out + (size_t)t * D) + lane;
            s = 0.f; q = 0.f;
#pragma unroll
            for (int j = 0; j < 8; ++j) { const f32x4 lg = lg1[64 * j], lb = lb1[64 * j]; v[j] = v[j] * rstd * lg + lb; u[j] = u[j] * rstdu * lg + lb; xo[64 * j] = v[j]; xo[64 * j + 512] = u[j];
                s += (v[j].x + v[j].y) + (v[j].z + v[j].w); q += (u[j].x + u[j].y) + (u[j].z + u[j].w); }
            mean = wave_sum(s) * (1.f / D); meanu = wave_sum(q) * (1.f / D); s2 = 0.f; q2 = 0.f;
#pragma unroll
            for (int j = 0; j < 8; ++j) { v[j] = v[j] - mean; u[j] = u[j] - meanu; s2 += (v[j].x * v[j].x + v[j].y * v[j].y) + (v[j].z * v[j].z + v[j].w * v[j].w); q2 += (u[j].x * u[j].x + u[j].y * u[j].y) + (u[j].z * u[j].z + u[j].w * u[j].w); }
            rstd = 1.f / sqrtf(wave_sum(s2) * (1.f / D) + EPS); rstdu = 1.f / sqrtf(wave_sum(q2) * (1.f / D) + EPS);
            const LAS f32x4* sh2 = pv + 1536 + lane; const LAS f32x4* sc2 = pv + 2048 + lane;
#pragma unroll
            for (int tt = 0; tt < 2; ++tt) {
                GAS v2u* oh = (GAS v2u*)(H2HI + (size_t)(t + tt) * D) + lane; GAS v2u* ol = (GAS v2u*)(H2LO + (size_t)(t + tt) * D) + lane; GAS unsigned* o8 = (GAS unsigned*)(H2F8 + (size_t)(t + tt) * (D / 4)) + lane;
#pragma unroll
                for (int j = 0; j < 8; ++j) { const f32x4 y = (tt ? u[j] * rstdu : v[j] * rstd) * (sc2[64 * j] + 1.0f) + sh2[64 * j];
                    const unsigned h0 = f2bf(y.x), h1 = f2bf(y.y), h2_ = f2bf(y.z), h3 = f2bf(y.w);
                    v2u o; o.x = h0 | (h1 << 16); o.y = h2_ | (h3 << 16); oh[64 * j] = o; o8[64 * j] = pk4_fp8(y.x, y.y, y.z, y.w);
                    o.x = pk2(y.x - __builtin_bit_cast(float, h0 << 16), y.y - __builtin_bit_cast(float, h1 << 16)); o.y = pk2(y.z - __builtin_bit_cast(float, h2_ << 16), y.w - __builtin_bit_cast(float, h3 << 16)); ol[64 * j] = o; }
            }
        }
        VM_WAIT();
#pragma unroll
        for (int n = 0; n < 4; ++n) lacc[n] = (f32x4){0.f, 0.f, 0.f, 0.f};
        for (int kc = 0; kc < 8; ++kc) {
            __syncthreads();
#pragma unroll
            for (int q = 0; q < 8; ++q) { const int p = q * NTHR + tid, rowi = p >> 5, piece = p & 31;
                const v4u w = *(const GAS v4u*)(WR + (size_t)rowi * D + kc * 256 + piece * 8);
                *(LAS v4u*)(bl + rowi * P8_BPITCH + piece * 8) = w; }
            __syncthreads();
#pragma unroll 2
            for (int ks = 0; ks < 8; ++ks) {
                const size_t aoff = (size_t)(t0 + arow) * D + kc * 256 + ks * 32 + akq * 8;
                const bf16x8 ah = *(const GAS bf16x8*)(H2HI + aoff), al = *(const GAS bf16x8*)(H2LO + aoff);
#pragma unroll
                for (int n = 0; n < 4; ++n) {
                    const bf16x8 bh = *(const LAS bf16x8*)(bl + (n * 16 + arow) * P8_BPITCH + ks * 32 + akq * 8);
                    const bf16x8 blo = *(const LAS bf16x8*)(bl + (64 + n * 16 + arow) * P8_BPITCH + ks * 32 + akq * 8);
                    lacc[n] = __builtin_amdgcn_mfma_f32_16x16x32_bf16(ah, bh, lacc[n], 0, 0, 0);
                    lacc[n] = __builtin_amdgcn_mfma_f32_16x16x32_bf16(al, bh, lacc[n], 0, 0, 0);
                    lacc[n] = __builtin_amdgcn_mfma_f32_16x16x32_bf16(ah, blo, lacc[n], 0, 0, 0);
                }
            }
        }
        }
#pragma unroll
        for (int n = 0; n < 4; ++n)
#pragma unroll
            for (int r = 0; r < 4; ++r) lg[(4 * akq + r) * 65 + 16 * n + arow] = lacc[n][r];
        LDS_WAIT(); asm volatile("" ::: "memory");
        const float rb = A.in[20][lane];
        for (int i = 0; i < 16; ++i) {
            const int t = t0 + i, sl = t / TS, tl = t % TS;
            const float z = lg[i * 65 + lane]; const float sc = 1.0f / (1.0f + expf(-z)); const float sel = sc + rb;
            float m1 = sel; m1 = fmaxf(m1, __shfl_xor(m1, 1)); m1 = fmaxf(m1, __shfl_xor(m1, 2)); m1 = fmaxf(m1, __shfl_xor(m1, 4));
            const unsigned long long eq = __ballot(sel == m1); const unsigned grp = (unsigned)(eq >> (lane & ~7)) & 0xffu; const int first = __builtin_ctz(grp | 0x100u);
            float m2 = ((lane & 7) == first) ? -1e30f : sel; m2 = fmaxf(m2, __shfl_xor(m2, 1)); m2 = fmaxf(m2, __shfl_xor(m2, 2)); m2 = fmaxf(m2, __shfl_xor(m2, 4));
            const float gs = m1 + m2; const int g = lane >> 3;
            int grank = 0;
#pragma unroll
            for (int q = 0; q < 8; ++q) { const float o = __shfl(gs, q * 8); grank += (o > gs || (o == gs && q < g)) ? 1 : 0; }
            const bool allowed = grank < 4;
            const float msel = allowed ? sel : -1e30f;
            int rank = 0;
            for (int q = 0; q < 64; ++q) { const float o = __shfl(msel, q); rank += (o > msel || (o == msel && q < lane)) ? 1 : 0; }
            const bool chosen = allowed && rank < 8;
            const unsigned long long cm = __ballot(chosen);
            const float wsum = wave_sum(chosen ? sc : 0.f);
            if (chosen) {
                const int j = __builtin_popcountll(cm & ((1ull << lane) - 1ull));
                const int pos = atomicAdd(&cnt[sl * 64 + lane], 1);
                rt_tok[((size_t)sl * NEX + lane) * TS + pos] = tl; rt_dst[((size_t)sl * NEX + lane) * TS + pos] = tl * 9 + j;
                rt_w[(size_t)t * 8 + j] = 2.5f * sc / (wsum + 1e-20f);
            }
        }
    }
}

struct MoeTab { LAS int* ucum; LAS int* segoff; LAS int* cnt; LAS int* idbuf; LAS int* myexp; };
__device__ __forceinline__ MoeTab moe_tab(LAS unsigned char* lds) { MoeTab m; m.ucum = (LAS int*)(lds + SCR_OFF); m.segoff = m.ucum + 72; m.cnt = m.segoff + 72; m.idbuf = m.cnt + 72; m.myexp = m.idbuf + 768; return m; }
__device__ __forceinline__ void moe_tables(const Args& A, LAS unsigned char* lds, int s, int ctiles, int tid, int G, int c) {
    MoeTab m = moe_tab(lds); const int* cnt = (const int*)(A.ws + WS_CTL) + CW_CNT + s * 64;
    __syncthreads();
    if (tid < 64) m.cnt[tid] = __hip_atomic_load(cnt + tid, RLX_AGENT);
    if (tid == 64) m.cnt[64] = TS;
    __syncthreads();
    if (tid == 0) { int u = 0, r = 0; for (int e = 0; e < NEX; ++e) { m.ucum[e] = u; m.segoff[e] = r; const int tl = (m.cnt[e] + 255) >> 8; u += tl * ctiles; r += tl * 256; } m.ucum[NEX] = u; }
    __syncthreads();
    if (tid < 256) { const int L = tid * G + c; int e = -1; if (L < m.ucum[NEX]) { e = 0; for (int q = 1; q < NEX; ++q) e += (m.ucum[q] <= L) ? 1 : 0; } m.myexp[tid] = e; }
    __syncthreads();
}
template <bool DSTPF_> struct SchedMoe {
    static constexpr bool DSTPF = DSTPF_;
    const int* dsts;
    MoeTab tb; const char* Abase; const char* Bbase; const int* lists; int G, c, ctiles; unsigned a_pitch, bexp_bytes, btile_bytes; bool gather;
    __device__ __forceinline__ bool next(int i, pg8::Unit& u) {
        if (i >= 256) return false; const int e = tb.myexp[i]; if (e < 0) return false; const int L = i * G + c;
        const int r = L - tb.ucum[e], rt = r / ctiles, ct = r % ctiles;
        u.pm = rt; u.pn = ct | ((i % 3) << 8); u.aux0 = e; u.aux1 = tb.segoff[e] + rt * 256; u.nt = 0;
        u.a = gather ? Abase : Abase + (size_t)u.aux1 * a_pitch; u.b = Bbase + (size_t)e * bexp_bytes + (size_t)ct * btile_bytes; return true;
    }
    __device__ __forceinline__ unsigned row_off_global(const pg8::Unit& u, int row) const {
        const int n = tb.cnt[u.aux0]; int idx = u.pm * 256 + row; idx = idx < n ? idx : n - 1;
        return (unsigned)lists[(size_t)u.aux0 * TS + idx] * a_pitch;
    }
    __device__ __forceinline__ void prefetch_rows(const pg8::Unit& u, int ui, LAS unsigned char* lds, int wid, int lane) const {
        if (wid < 4) { const int n = tb.cnt[u.aux0]; int idx = u.pm * 256 + wid * 64 + lane; idx = idx < n ? idx : n - 1;
            __builtin_amdgcn_global_load_lds((const unsigned*)(lists + (size_t)u.aux0 * TS + idx), (LAS unsigned*)(tb.idbuf + (ui & 1) * 256 + wid * 64), 4, 0, 0); }
    }
    __device__ __forceinline__ void prefetch_dst(const pg8::Unit& u, int ui, int wid, int lane) const {
        if (wid < 4) { const int n = tb.cnt[u.aux0]; int idx = u.pm * 256 + wid * 64 + lane; idx = idx < n ? idx : n - 1;
            __builtin_amdgcn_global_load_lds((const unsigned*)(dsts + (size_t)u.aux0 * TS + idx), (LAS unsigned*)(tb.idbuf + (ui % 3) * 256 + wid * 64), 4, 0, 0); }
    }
    __device__ __forceinline__ unsigned row_off_lds(int ui, int row, LAS unsigned char*) const { return (unsigned)tb.idbuf[(ui & 1) * 256 + row] * a_pitch; }
};
struct EpiGU {
    static __device__ __forceinline__ int a_row(int h, int R) { return 128 * h + R; }
    unsigned char* ACT; bool dry;
    __device__ __forceinline__ void operator()(f32x4 (&acc)[2][2][4][2], const pg8::Unit& u, int wr, int wc, int fr, int fq, LAS unsigned char*) const {
        if (dry) { float s = 0.f;
#pragma unroll
            for (int ai = 0; ai < 2; ++ai)
#pragma unroll
                for (int bj = 0; bj < 2; ++bj)
#pragma unroll
                    for (int m = 0; m < 4; ++m)
#pragma unroll
                        for (int n2 = 0; n2 < 2; ++n2) s += acc[ai][bj][m][n2][0] + acc[ai][bj][m][n2][1] + acc[ai][bj][m][n2][2] + acc[ai][bj][m][n2][3];
            if (s == 1.2345e-30f) ACT[0] = 0; return; }
        const int row0 = u.aux1 + wr * 64 + fr, col0 = (u.pn & 255) * 128 + wc * 32 + 8 * fq;
#pragma unroll
        for (int ai = 0; ai < 2; ++ai)
#pragma unroll
            for (int m = 0; m < 4; ++m) { const unsigned off = (unsigned)(row0 + ai * 128 + m * 16) * DE + col0;
                f32x4 a0, a1;
#pragma unroll
                for (int e = 0; e < 4; ++e) { a0[e] = silu_f(acc[ai][0][m][0][e]) * acc[ai][1][m][0][e]; a1[e] = silu_f(acc[ai][0][m][1][e]) * acc[ai][1][m][1][e]; }
                v2u w; w.x = pk4_fp8(a0[0], a0[1], a0[2], a0[3]); w.y = pk4_fp8(a1[0], a1[1], a1[2], a1[3]);
                *(GAS v2u*)((GAS char*)ACT + off) = w; }
    }
};
struct EpiDN {
    static __device__ __forceinline__ int a_row(int h, int R) { return 128 * h + R; }
    unsigned char* OUTTOK; LAS int* idbuf; LAS int* cnt; bool dry;
    __device__ __forceinline__ void operator()(f32x4 (&acc)[2][2][4][2], const pg8::Unit& u, int wr, int wc, int fr, int fq, LAS unsigned char*) const {
        if (dry) { float s = 0.f;
#pragma unroll
            for (int ai = 0; ai < 2; ++ai)
#pragma unroll
                for (int bj = 0; bj < 2; ++bj)
#pragma unroll
                    for (int m = 0; m < 4; ++m)
#pragma unroll
                        for (int n2 = 0; n2 < 2; ++n2) s += acc[ai][bj][m][n2][0] + acc[ai][bj][m][n2][1] + acc[ai][bj][m][n2][2] + acc[ai][bj][m][n2][3];
            if (s == 1.2345e-30f) OUTTOK[0] = 0; return; }
        int tz = threadIdx.x; asm volatile("" : "+v"(tz)); fr = tz & 15; fq = (tz >> 4) & 3;
        const int n = cnt[u.aux0], rl0 = u.pm * 256 + wr * 64 + fr, col0 = (u.pn & 255) * 256 + wc * 64 + 16 * fq;
        const LAS int* dl = idbuf + (u.pn >> 8) * 256 - u.pm * 256;
#pragma unroll
        for (int ai = 0; ai < 2; ++ai)
#pragma unroll
            for (int m = 0; m < 4; ++m) { const int rl = rl0 + ai * 128 + m * 16;
                if (rl < n) { const unsigned off = (unsigned)dl[rl] * D + col0;
                    const f32x4 v0 = acc[ai][0][m][0] * 16.f, v1 = acc[ai][0][m][1] * 16.f, v2 = acc[ai][1][m][0] * 16.f, v3 = acc[ai][1][m][1] * 16.f;
                    v4u w; w.x = pk4_fp8(v0[0], v0[1], v0[2], v0[3]); w.y = pk4_fp8(v1[0], v1[1], v1[2], v1[3]); w.z = pk4_fp8(v2[0], v2[1], v2[2], v2[3]); w.w = pk4_fp8(v3[0], v3[1], v3[2], v3[3]);
                    *(GAS v4u*)((GAS char*)OUTTOK + off) = w; } }
    }
};
__device__ __forceinline__ void moe_combine(const Args& A, LAS unsigned char* lds, int s, int tid, int lane, int wave, int vcu, int G, float* wout) {
    const int gw = vcu * NWAVES + wave, NGW = G * NWAVES;
    const float* mod = (const float*)(A.ws + WS_MOD); const unsigned char* OT = A.ws + WS_OUTTOK; const float* rt_w = (const float*)(A.ws + WS_ROUTE + RT_W);
    LAS f32x4* pv = (LAS f32x4*)lds;
    for (int tb = vcu; tb < TS / 128; tb += G) {
      { const int b = (s * TS + tb * 128) / SEQ; __syncthreads();
        pv[tid] = ((const f32x4*)(mod + (size_t)b * MODW + 5 * D))[tid]; pv[512 + tid] = ((const f32x4*)A.in[27])[tid]; pv[1024 + tid] = ((const f32x4*)A.in[28])[tid];
        __syncthreads(); }
      for (int i = 0; i < 16; ++i) {
        asm volatile("" ::: "memory");
        const int tl = tb * 128 + wave * 16 + i, t = s * TS + tl;
        const GAS f32x4* xo = (const GAS f32x4*)(A.out + (size_t)t * D) + 4 * lane; GAS f32x4* yo = (GAS f32x4*)(wout + (size_t)t * D) + 4 * lane;
        const LAS f32x4* g2 = pv + 4 * lane;
        const GAS v4u* rows = (const GAS v4u*)(OT + (size_t)tl * 9 * D) + lane;
        float w[8];
        { const f32x4 w0 = *(const GAS f32x4*)(rt_w + (size_t)t * 8), w1 = *(const GAS f32x4*)(rt_w + (size_t)t * 8 + 4); w[0] = w0[0]; w[1] = w0[1]; w[2] = w0[2]; w[3] = w0[3]; w[4] = w1[0]; w[5] = w1[1]; w[6] = w1[2]; w[7] = w1[3]; }
        v4u q[9][2];
#pragma unroll
        for (int k = 0; k < 9; ++k)
#pragma unroll
            for (int j = 0; j < 2; ++j) q[k][j] = rows[k * 128 + 64 * j];
        f32x4 f[8]; float sm = 0.f;
#pragma unroll
        for (int j = 0; j < 2; ++j) {
            f32x4 a[4];
            a[0] = fp8x4_to_f32(q[8][j].x); a[1] = fp8x4_to_f32(q[8][j].y); a[2] = fp8x4_to_f32(q[8][j].z); a[3] = fp8x4_to_f32(q[8][j].w);
#pragma unroll
            for (int k = 0; k < 8; ++k) { a[0] = a[0] + w[k] * fp8x4_to_f32(q[k][j].x); a[1] = a[1] + w[k] * fp8x4_to_f32(q[k][j].y); a[2] = a[2] + w[k] * fp8x4_to_f32(q[k][j].z); a[3] = a[3] + w[k] * fp8x4_to_f32(q[k][j].w); }
#pragma unroll
            for (int i = 0; i < 4; ++i) { const f32x4 y = xo[256 * j + i] * ALPHA + g2[256 * j + i] * (a[i] * 0.0625f); f[4 * j + i] = y; sm += (y.x + y.y) + (y.z + y.w); }
        }
        const float mean = wave_sum(sm) * (1.f / D); float s2 = 0.f;
#pragma unroll
        for (int j = 0; j < 8; ++j) { f[j] = f[j] - mean; s2 += (f[j].x * f[j].x + f[j].y * f[j].y) + (f[j].z * f[j].z + f[j].w * f[j].w); }
        const float rstd = 1.f / sqrtf(wave_sum(s2) * (1.f / D) + EPS);
        const LAS f32x4* lg2 = pv + 512 + 4 * lane; const LAS f32x4* lb2 = pv + 1024 + 4 * lane;
#pragma unroll
        for (int j = 0; j < 2; ++j)
#pragma unroll
            for (int i = 0; i < 4; ++i) yo[256 * j + i] = f[4 * j + i] * rstd * lg2[256 * j + i] + lb2[256 * j + i];
      }
    }
}
}
namespace mk {
#ifndef GU_DRY
#define GU_DRY 0
#endif
#ifndef DN_DRY
#define DN_DRY 0
#endif
#ifndef DBL_MASK
#define DBL_MASK 0
#endif
#define REPS(k) for (int rep_ = 0; rep_ < (((DBL_MASK) >> (k)) & 1) + 1; ++rep_)
#ifndef MK_LAST_PHASE
#define MK_LAST_PHASE 2
#endif
__global__ void __launch_bounds__(NTHR, 2) mk_fwd(Args args) {
    extern __shared__ __attribute__((aligned(16))) unsigned char lds_raw[];
    LAS unsigned char* lds = (LAS unsigned char*)lds_raw;
    volatile LAS unsigned* MISC = (volatile LAS unsigned*)(lds + LDSCTL_OFF);
    const int tid = threadIdx.x, lane = tid & 63, wave = __builtin_amdgcn_readfirstlane(tid >> 6);
    const int G = gridDim.x; const int bx = blockIdx.x; const int vcu = (G % 8 == 0) ? (bx % 8) * (G / 8) + bx / 8 : bx;
    unsigned* ctl = (unsigned*)(args.ws + WS_CTL);
    for (int u = tid; u < (LDS_BYTES - LDSCTL_OFF) / 4; u += NTHR) ((LAS unsigned*)(lds + LDSCTL_OFF))[u] = 0u;
    __syncthreads();
    XcdBarrier bar = xcd_barrier_post(ctl + CW_BAR + args.li * XCD_BAR_WORDS, MISC + 8);
    const int lo = args.ph_lo, hi = args.ph_hi;
#define IN(k) (lo <= (k) && (k) < hi)
#define BOTH(k) (IN(k) && IN((k) + 1))
#define GRID_BAR() xcd_barrier(bar)
#define OPQ() int tq = threadIdx.x; asm volatile("" : "+v"(tq)); const int tidq = tq, laneq = tq & 63

    if (IN(0)) { REPS(0) { OPQ(); p0_adaln(args, lds, tidq, G); p0_fold(args, lds, tidq, G); p0_weights(args, lds, tidq, laneq, wave, vcu, G); } if (BOTH(0)) GRID_BAR(); }
    if (IN(1)) { REPS(1) { OPQ(); p1_hnorm(args, laneq, wave, vcu, G); } if (BOTH(1)) GRID_BAR(); }
    if (IN(2)) { REPS(2) {
        SchedInproj S{(const char*)(args.ws + WS_H), (const char*)(args.ws + WS_WIN), G, bx};
        static_assert(WS_GATE == WS_U + (size_t)TT * DL * 2 && WS_FOUR == WS_GATE + (size_t)T * DL * 2, "U|GATE|FOUR contiguous");
        EpiInproj E{(bf16*)(args.ws + WS_U), (bf16*)(args.ws + WS_UPART)};
        pg8::gemm_phase<EpiInproj, SchedInproj, true, false>(lds, D / 64, D * 2, D * 2, S, E); }
        if (BOTH(2)) GRID_BAR();
    }
#ifndef SKIP_P3
    if (IN(3)) { REPS(3) { OPQ(); p3_conv(args, laneq, wave, vcu, G); p3_fold(args, lds, laneq, wave, vcu, G); } if (BOTH(3)) GRID_BAR(); }
#endif
    if (IN(4)) { REPS(4) {
#ifndef SKIP_DFT
        { SchedDft S{(const char*)(args.ws + WS_CS), (const char*)(args.ws + WS_PQT), G, vcu}; EpiDft E{(bf16*)(args.ws + WS_AB)};
          pg8::gemm_phase<EpiDft, SchedDft, true, false>(lds, 2048 / 64, 4096, 4096, S, E); }
#endif
#ifndef SKIP_LRU
        { SchedGates S{(const char*)(args.ws + WS_UC), (const char*)(args.ws + WS_WG4), G, vcu};
          EpiLru E{(const bf16*)(args.ws + WS_UC), args.in[10], args.in[12], (bf16*)(args.ws + WS_S), (bf16*)(args.ws + WS_PF), (bf16*)(args.ws + WS_PB), (float*)(args.ws + WS_MISC)};
          pg8::gemm_phase<EpiLru, SchedGates, false, false>(lds, 256 / 64, DL * 2, 512, S, E); }
#endif
        }
        if (BOTH(4)) GRID_BAR();
    }
#ifndef SKIP_P5
    if (IN(5)) { REPS(5) { OPQ(); p5a_fix(args, lds, tidq, laneq, wave, vcu, G); } if (BOTH(5)) GRID_BAR(); }
    if (IN(6)) { REPS(6) { OPQ(); p5b_four(args, lds, laneq, wave, vcu, G); } if (BOTH(6)) GRID_BAR(); }
#endif
#ifndef SKIP_P7
    if (IN(7)) { REPS(7) {
        SchedTiles S{(const char*)(args.ws + WS_YMIX), (const char*)(args.ws + WS_WOUT), T / 256, D / 256, G, bx, D * 2, D * 2};
        EpiBf16 E{(bf16*)(args.ws + WS_MIX), D};
        pg8::gemm_phase<EpiBf16, SchedTiles, true, false>(lds, D / 64, D * 2, D * 2, S, E); }
        if (BOTH(7)) GRID_BAR();
    }
#endif
#ifndef SKIP_P8
    if (IN(8)) { OPQ(); p8_ln_router(args, lds, tidq, laneq, wave, vcu, G); if (BOTH(8)) GRID_BAR(); }
#endif
#pragma unroll
    for (int s = 0; s < NSLICE; ++s) {
        const int p0 = 9 + 3 * s;
#ifndef SKIP_GU
        if (IN(p0)) { REPS(9) {
            { OPQ(); moe_tables(args, lds, s, 4, tidq, G, vcu); }
            SchedMoe<false> S{nullptr, moe_tab(lds), (const char*)(args.ws + WS_H2F8) + (size_t)s * TS * D, (const char*)(args.ws + WS_WGU), (const int*)(args.ws + WS_ROUTE + RT_TOK) + (size_t)s * NEX * TS, G, vcu, 4, (unsigned)D, 1024u * D, 256u * D, true};
            EpiGU E{args.ws + WS_ACT, (GU_DRY) && rep_ == 0};
            pg8::gemm_phase<EpiGU, SchedMoe<false>, true, true, true, 0x79797979>(lds, D / 128, D, D, S, E); }
            if (BOTH(p0)) GRID_BAR();
        }
#endif
#ifndef SKIP_DN
        if (IN(p0 + 1)) { REPS(10) {
            { OPQ(); moe_tables(args, lds, s, 8, tidq, G, vcu); }
            SchedMoe<true> S{(const int*)(args.ws + WS_ROUTE + RT_DST) + (size_t)s * NEX * TS, moe_tab(lds), (const char*)(args.ws + WS_ACT), (const char*)(args.ws + WS_WD), nullptr, G, vcu, 8, (unsigned)DE, 2048u * DE, 256u * DE, false};
            EpiDN E{args.ws + WS_OUTTOK, moe_tab(lds).idbuf, moe_tab(lds).cnt, (DN_DRY) && rep_ == 0};
            pg8::gemm_phase<EpiDN, SchedMoe<true>, true, false, true, 0x79797979>(lds, DE / 128, DE, DE, S, E); }
            if (BOTH(p0 + 1)) GRID_BAR();
        }
#endif
#ifndef SKIP_CB
        if (IN(p0 + 2)) { REPS(11) { OPQ(); moe_combine(args, lds, s, tidq, laneq, wave, vcu, G, (((DBL_MASK >> 11) & 1) && rep_ == 0) ? (float*)(args.ws + WS_UC) - (size_t)s * TS * D : args.out); } if (BOTH(p0 + 2)) GRID_BAR(); }
#endif
    }
#undef IN
#undef BOTH
}
}
static int g_grid = 0;
static void mk_launch(void* const* d_in, void* d_out, void* d_ws, hipStream_t stream, int lo, int hi, int li) {
    if (g_grid == 0) {
        int dev = 0, cus = 0; hipGetDevice(&dev); hipDeviceGetAttribute(&cus, hipDeviceAttributeMultiprocessorCount, dev);
        if (hipFuncSetAttribute((const void*)mk::mk_fwd, hipFuncAttributeMaxDynamicSharedMemorySize, mk::LDS_BYTES) != hipSuccess) { fprintf(stderr, "hipFuncSetAttribute failed\n"); g_grid = -1; return; }
        int per_cu = 0; (void)hipOccupancyMaxActiveBlocksPerMultiprocessor(&per_cu, (const void*)mk::mk_fwd, mk::NTHR, mk::LDS_BYTES); (void)hipGetLastError();
        if (per_cu < 1) fprintf(stderr, "occupancy query says %d\n", per_cu);
        g_grid = cus > 0 ? cus : 256;
    }
    if (g_grid < 0) return;
    mk::Args a{}; for (int i = 0; i < 29; ++i) a.in[i] = (const float*)d_in[i];
    a.out = (float*)d_out; a.ws = (unsigned char*)d_ws; a.ph_lo = lo; a.ph_hi = hi; a.li = li; a.pad = 0;
    hipLaunchKernelGGL(mk::mk_fwd, dim3(g_grid), dim3(mk::NTHR), mk::LDS_BYTES, stream, a);
}
extern "C" void kernel_launch(void* const* d_in, const int* in_sizes, int n_in, void* d_out, int out_size, void* d_ws, size_t ws_size, hipStream_t stream) {
    if (ws_size < mk::WS_END) { fprintf(stderr, "workspace too small\n"); return; }
    (void)hipMemsetAsync((unsigned char*)d_ws + mk::WS_CTL, 0, mk::CTL_ZERO_BYTES, stream);
    constexpr int NPH = 9 + 3 * mk::NSLICE;
#if MK_SPLIT
    for (int p = 0; p < NPH; ++p) mk_launch(d_in, d_out, d_ws, stream, p, p + 1, 0);
#else
    mk_launch(d_in, d_out, d_ws, stream, 0, NPH, 0);
#endif
}
```

```cpp
#include <hip/hip_runtime.h>
#include <cstdio>
#include <cstdint>
#define MK_SPLIT 0
#define GAS __attribute__((address_space(1)))
#define LAS __attribute__((address_space(3)))
namespace mk {
constexpr int D = 2048, NB = 8, SEQ = 4096, T = NB * SEQ, CTX = 256, TC = NB * CTX, TT = T + TC;
constexpr int DL = 1024, DF = 1024, DIN = 3072, NE = 64, NEX = 65, DE = 512;
constexpr int MODW = 6 * D;
constexpr float ALPHA = 1.189207115002721f, EPS = 1e-6f, PI2 = 6.283185307179586f;
constexpr int NWAVES = 8, NTHR = 512;
constexpr int NSLICE = 1, TS = T / NSLICE;
constexpr int SLOT_ROWS = TS * 8 + NE * 256 + TS;

typedef unsigned short bf16;
typedef unsigned v4u __attribute__((ext_vector_type(4)));
typedef unsigned v2u __attribute__((ext_vector_type(2)));
typedef float f32x4 __attribute__((ext_vector_type(4)));
typedef float f32x2 __attribute__((ext_vector_type(2)));
typedef short bf16x8 __attribute__((ext_vector_type(8)));
typedef int v8i __attribute__((ext_vector_type(8)));
typedef int v4i __attribute__((ext_vector_type(4)));

constexpr size_t MiB = 1u << 20;
constexpr size_t WS_CTL = 0, CTL_ZERO_BYTES = 1 * MiB;
constexpr size_t WS_MOD = 1 * MiB;
constexpr size_t WS_MISC = 2 * MiB;
constexpr size_t WS_WIN = 10 * MiB;
constexpr size_t WS_WOUT = 22 * MiB;
constexpr size_t WS_WG4 = 30 * MiB;
constexpr size_t WS_WR = 32 * MiB;
constexpr size_t WS_CS = 34 * MiB;
constexpr size_t WS_WGU = 50 * MiB;
constexpr size_t WS_WD = 180 * MiB;
constexpr size_t WS_DYN = 245 * MiB;
constexpr size_t WS_H = WS_DYN;
constexpr size_t WS_PF = WS_DYN, WS_PB = WS_DYN + 64 * MiB;
constexpr size_t WS_MIX = WS_DYN;
constexpr size_t WS_U = WS_DYN + 136 * MiB;
constexpr size_t WS_GATE = WS_U + 68 * MiB;
constexpr size_t WS_FOUR = WS_GATE + 64 * MiB;
constexpr size_t WS_UC = WS_FOUR + 64 * MiB;
constexpr size_t WS_S = WS_UC + 68 * MiB;
constexpr size_t WS_UPART = WS_S;
constexpr size_t WS_YMIX = WS_S + 64 * MiB;
constexpr size_t WS_PQT = WS_YMIX + 128 * MiB;
constexpr size_t WS_AB = WS_PQT + 32 * MiB;
constexpr size_t WS_END_MIXER = WS_AB + 32 * MiB;
constexpr size_t WS_H2HI = WS_YMIX;
constexpr size_t WS_H2LO = WS_U;
constexpr size_t WS_OUTTOK = WS_DYN;
constexpr size_t OUTTOK_BYTES = (size_t)TS * 9 * D;
constexpr size_t WS_ACT = WS_OUTTOK + OUTTOK_BYTES;
constexpr size_t ACT_BYTES = (size_t)SLOT_ROWS * DE;
constexpr size_t WS_H2F8 = WS_OUTTOK + 736 * MiB;
constexpr size_t WS_ROUTE = WS_H2F8 + 64 * MiB;
constexpr size_t WS_END = WS_ROUTE + 24 * MiB;
static_assert(WS_H2F8 >= WS_END_MIXER, "H2F8 clear of the mixer buffers");
static_assert(WS_ACT + ACT_BYTES <= WS_H2F8, "MoE overlay map");
static_assert(WS_END <= 1150 * MiB, "workspace budget");
constexpr size_t RT_TOK = 0;
constexpr size_t RT_DST = RT_TOK + (size_t)NSLICE * NEX * TS * 4;
constexpr size_t RT_W = RT_DST + (size_t)NSLICE * NEX * TS * 4;
static_assert(RT_W + (size_t)T * 8 * 4 <= 24 * MiB, "routing tables");
constexpr int MS_SUMA = 0;
constexpr int NSUB = SEQ / 128;
constexpr int MS_SUMB = MS_SUMA + (TT / 128) * 2 * DL;
constexpr int MS_P64 = MS_SUMB + (TT / 128) * 2 * DL;
constexpr int P64_LD = 2112;
constexpr int MS_ALT = MS_P64 + NB * 8 * P64_LD;
constexpr int MS_NYQ = MS_ALT + NB * 32 * 512;
constexpr int MS_SP = MS_NYQ + NB * 8 * P64_LD;
constexpr int MS_GB = MS_SP + 2 * DL;
constexpr int MS_END = MS_GB + 4 * DL;
static_assert((size_t)MS_END * 4 <= 8 * MiB, "MISC region");
constexpr int CW_TMO = 0, CW_CODE = 1, CW_BAR = 4096, CW_CNT = 8192;

constexpr int RING_BYTES = 131072, LDSCTL_OFF = RING_BYTES, SCR_OFF = LDSCTL_OFF + 512, LDS_BYTES = 147456;

#define RLX_AGENT __ATOMIC_RELAXED, __HIP_MEMORY_SCOPE_AGENT
#define LDS_WAIT() asm volatile("s_waitcnt lgkmcnt(0)" ::: "memory")
#define VM_WAIT() asm volatile("s_waitcnt vmcnt(0)" ::: "memory")
__device__ __forceinline__ unsigned f2bf(float f) { unsigned u = __builtin_bit_cast(unsigned, f); return (u + 0x7fffu + ((u >> 16) & 1u)) >> 16; }
__device__ __forceinline__ unsigned pk2(float lo, float hi) { return f2bf(lo) | (f2bf(hi) << 16); }
__device__ __forceinline__ unsigned cvt_pk_bf16(float lo, float hi) { unsigned r; asm volatile("v_cvt_pk_bf16_f32 %0, %1, %2" : "=v"(r) : "v"(lo), "v"(hi)); return r; }
__device__ __forceinline__ unsigned pk4_fp8(float a, float b, float c, float d) {
    a = __builtin_amdgcn_fmed3f(a, -448.f, 448.f); b = __builtin_amdgcn_fmed3f(b, -448.f, 448.f); c = __builtin_amdgcn_fmed3f(c, -448.f, 448.f); d = __builtin_amdgcn_fmed3f(d, -448.f, 448.f);
    int r = __builtin_amdgcn_cvt_pk_fp8_f32(a, b, 0, false); r = __builtin_amdgcn_cvt_pk_fp8_f32(c, d, r, true); return (unsigned)r; }
__device__ __forceinline__ f32x4 fp8x4_to_f32(unsigned w) { const f32x2 lo = __builtin_amdgcn_cvt_pk_f32_fp8((int)w, false), hi = __builtin_amdgcn_cvt_pk_f32_fp8((int)w, true); return (f32x4){lo.x, lo.y, hi.x, hi.y}; }
__device__ __forceinline__ float bf_lo(unsigned w) { return __builtin_bit_cast(float, w << 16); }
__device__ __forceinline__ float bf_hi(unsigned w) { return __builtin_bit_cast(float, w & 0xffff0000u); }
__device__ __forceinline__ float bf2f(bf16 h) { return __builtin_bit_cast(float, (unsigned)h << 16); }
__device__ __forceinline__ float wave_sum(float v) {
#pragma unroll
    for (int o = 1; o < 64; o <<= 1) v += __shfl_xor(v, o);
    return v;
}
__device__ __forceinline__ float sigmoid_f(float x) { return __builtin_amdgcn_rcpf(1.0f + __expf(-x)); }
__device__ __forceinline__ float silu_f(float x) { return x * sigmoid_f(x); }
__device__ __forceinline__ float gelu_tanh_f(float x) { const float u = 0.7978845608028654f * (x + 0.044715f * x * x * x); const float e = __expf(2.0f * u); const float th = 1.0f - 2.0f * __builtin_amdgcn_rcpf(e + 1.0f); return 0.5f * x * (1.0f + th); }

#define XB_TMO      128
#define XB_XCNT(j)  (256  + 64 * (j))
#define XB_XSUB(j)  (1280 + 64 * (j))
#define XB_XGEN(j)  (2304 + 64 * (j))
#define XB_TOP      3328
#define XB_TOPGEN   3392
#define XCD_BAR_WORDS 3456
#define XB_SPIN_CAP (1u << 18)
__device__ __forceinline__ unsigned xb_ld(unsigned* p)              { return __hip_atomic_load(p, __ATOMIC_RELAXED, __HIP_MEMORY_SCOPE_AGENT); }
__device__ __forceinline__ unsigned xb_add(unsigned* p, unsigned v) { return __hip_atomic_fetch_add(p, v, __ATOMIC_RELAXED, __HIP_MEMORY_SCOPE_AGENT); }
__device__ __forceinline__ unsigned xb_xcc_id() { return (unsigned)__builtin_amdgcn_s_getreg((3 << 11) | 20) & 0xFu; }
#define XB_SPIN(cond, bar) do { unsigned _sp = 0; while (cond) { __builtin_amdgcn_s_sleep(1); \
    if ((++_sp & 255u) == 0u) { if (xb_ld(&(bar)[XB_TMO])) break; if (_sp > XB_SPIN_CAP) { atomicAdd(&(bar)[XB_TMO], 1u); break; } } } } while (0)
struct XcdBarrier { unsigned* bar; unsigned x; volatile LAS unsigned* st; };
__device__ __forceinline__ XcdBarrier xcd_barrier_post(unsigned* bar, volatile LAS unsigned* st) {
    XcdBarrier b; b.bar = bar; b.x = xb_xcc_id(); b.st = st;
    if (threadIdx.x == 0) (void)xb_add(&bar[XB_XCNT(b.x)], 1u);
    return b;
}
__device__ __forceinline__ void xcd_barrier_complete(unsigned* bar, unsigned x, unsigned& nloc, unsigned& nx) {
    const unsigned G = gridDim.x * gridDim.y * gridDim.z;
    unsigned sum, cnt, mine, sp = 0u;
    for (;;) {
        sum = 0u; cnt = 0u; mine = 0u;
#pragma unroll
        for (unsigned j = 0; j < 16; ++j) { const unsigned c = xb_ld(&bar[XB_XCNT(j)]); sum += c; cnt += (c > 0u) ? 1u : 0u; mine = (j == x) ? c : mine; }
        if (sum == G) break;
        __builtin_amdgcn_s_sleep(1);
        if ((++sp & 255u) == 0u) { if (xb_ld(&bar[XB_TMO])) break; if (sp > XB_SPIN_CAP) { atomicAdd(&bar[XB_TMO], 1u); break; } }
    }
    nloc = mine > 0u ? mine : 1u; nx = cnt > 0u ? cnt : 1u;
}
__device__ __forceinline__ void xcd_barrier(const XcdBarrier& b) {
    asm volatile("s_waitcnt vmcnt(0)" ::: "memory");
    __syncthreads();
    if (threadIdx.x == 0) {
        unsigned* bar = b.bar;
        __builtin_amdgcn_s_waitcnt(0);
        unsigned nloc = b.st[0], nx = b.st[1];
        if (nloc == 0u) { xcd_barrier_complete(bar, b.x, nloc, nx); b.st[0] = nloc; b.st[1] = nx; }
        const unsigned old = xb_add(&bar[XB_XSUB(b.x)], 1u);
        const unsigned gen = old / nloc;
        if (old + 1u == (gen + 1u) * nloc) {
            __builtin_amdgcn_fence(__ATOMIC_RELEASE, "agent");
            asm volatile("s_waitcnt vmcnt(0)" ::: "memory");
            const unsigned og = xb_add(&bar[XB_TOP], 1u);
            const unsigned tg = og / nx;
            if (og + 1u == (tg + 1u) * nx) xb_add(&bar[XB_TOPGEN], 1u);
            else XB_SPIN(xb_ld(&bar[XB_TOPGEN]) == tg, bar);
            __builtin_amdgcn_fence(__ATOMIC_ACQUIRE, "agent");
            xb_add(&bar[XB_XGEN(b.x)], 1u);
            asm volatile("s_waitcnt vmcnt(0)" ::: "memory");
        } else {
            XB_SPIN(xb_ld(&bar[XB_XGEN(b.x)]) == gen, bar);
            __builtin_amdgcn_fence(__ATOMIC_ACQUIRE, "agent");
            asm volatile("s_waitcnt vmcnt(0)" ::: "memory");
        }
    }
    __syncthreads();
}

namespace pg8 {
constexpr int BM = 256, BK = 64, HALF = 128, HTB = HALF * BK * 2, STAGE_BYTES = 8 * HTB;
__host__ __device__ __forceinline__ int lds_byte(int r, int c) { const int st = (r >> 4) * 2 + (c >> 5), rr = r & 15, cc = c & 31, ob = rr * 64 + cc * 2; return st * 1024 + (ob ^ (((ob >> 9) & 1) << 5)); }
__host__ __device__ __forceinline__ void stage_rc(int b, int& R, int& C) { const int st = b / 1024, sb = b % 1024, swz = sb ^ (((sb >> 9) & 1) << 5); R = (st >> 1) * 16 + swz / 64; C = (st & 1) * 32 + (swz % 64) / 2; }
__host__ __device__ __forceinline__ int perm_slot32(int c) { return 16 * ((c >> 2) & 1) + 4 * ((c >> 3) & 3) + (c & 3); }

__host__ __device__ __forceinline__ int perm_slot256(int c) { return 128 * ((c >> 3) & 1) + 32 * (c >> 6) + 16 * ((c >> 2) & 1) + 4 * ((c >> 4) & 3) + (c & 3); }
struct Unit { const char* a; const char* b; int pm, pn, aux0, aux1, nt; };

template <class Epi, class Sched, bool ALIGN_EPI, bool GATHER, bool F8 = false, int SCW = 0x7f7f7f7f>
__device__ __forceinline__ void gemm_phase(LAS unsigned char* lds, const int nt_, const unsigned lda_b, const unsigned ldb_b, Sched& S, const Epi& E) {
    int nt = nt_; asm volatile("" : "+s"(nt));
    int tid_ = threadIdx.x; asm volatile("" : "+v"(tid_));
    const int tid = tid_, wid = __builtin_amdgcn_readfirstlane(tid >> 6), lane = tid & 63, wr = wid >> 2, wc = wid & 3, fr = lane & 15, fq = lane >> 4;
    unsigned voffA[2][2], voffB[2][2], cbyte[2]; int Rr[2];
#pragma unroll
    for (int i = 0; i < 2; ++i) { int R, C; stage_rc(tid * 16 + i * 8192, R, C); Rr[i] = R; cbyte[i] = (unsigned)C * 2u;
#pragma unroll
        for (int h = 0; h < 2; ++h) { voffB[h][i] = (unsigned)(R + HALF * h) * ldb_b + (unsigned)C * 2u; voffA[h][i] = (unsigned)Epi::a_row(h, R) * lda_b + (unsigned)C * 2u; } }
    const unsigned ldsw = (unsigned)wid * 1024u;
    const int aoff = lds_byte(wr * 64 + fr, fq * 8), boff = lds_byte(wc * 32 + fr, fq * 8);
#define PG8_SA(b, h) (((b) * 2 + (h)) * HTB)
#define PG8_SB(b, h) ((4 + (b) * 2 + (h)) * HTB)
#define PG8_STAGE(bufoff, gbase, voff) do { _Pragma("unroll") for (int _i = 0; _i < 2; ++_i) \
        __builtin_amdgcn_global_load_lds((const unsigned*)((const char*)(gbase) + (voff)[_i]), (LAS unsigned*)(lds + (bufoff) + ldsw + _i * 8192), 16, 0, 0); } while (0)
#define PG8_LDA(dst, b, h) do { _Pragma("unroll") for (int m = 0; m < 4; ++m) _Pragma("unroll") for (int k = 0; k < 2; ++k) dst[m][k] = *(const LAS v4i*)(lds + PG8_SA(b, h) + aoff + m * 2048 + k * 1024); } while (0)
#define PG8_LDB(dst, b, h) do { _Pragma("unroll") for (int n = 0; n < 2; ++n) _Pragma("unroll") for (int k = 0; k < 2; ++k) dst[n][k] = *(const LAS v4i*)(lds + PG8_SB(b, h) + boff + n * 2048 + k * 1024); } while (0)
#define PG8_CAT(x) __builtin_shufflevector((x)[0], (x)[1], 0, 1, 2, 3, 4, 5, 6, 7)
#define PG8_MMA(ai, bj, At, Bt) do { __builtin_amdgcn_s_setprio(1); _Pragma("unroll") for (int m = 0; m < 4; ++m) _Pragma("unroll") for (int n = 0; n < 2; ++n) { \
        if constexpr (F8) { const v8i b8_ = PG8_CAT(Bt[n]), a8_ = PG8_CAT(At[m]);   \
            asm volatile("v_mfma_scale_f32_16x16x128_f8f6f4 %0, %1, %2, %0, %3, %4 op_sel_hi:[0,0,0]" : "+v"(acc[ai][bj][m][n]) : "v"(b8_), "v"(a8_), "v"(scw_), "v"(sca_)); } \
        else { _Pragma("unroll") for (int k = 0; k < 2; ++k) acc[ai][bj][m][n] = __builtin_amdgcn_mfma_f32_16x16x32_bf16(__builtin_bit_cast(bf16x8, Bt[n][k]), __builtin_bit_cast(bf16x8, At[m][k]), acc[ai][bj][m][n], 0, 0, 0); } } \
        __builtin_amdgcn_s_setprio(0); } while (0)
#define PG8_WAIT_V(n) asm volatile("s_waitcnt vmcnt(" #n ")" ::: "memory")
#define PG8_WAIT_L(n) asm volatile("s_waitcnt lgkmcnt(" #n ")" ::: "memory")
#define PG8_BAR __builtin_amdgcn_s_barrier()
#define PG8_SCHED __builtin_amdgcn_sched_barrier(0)
    int scw_ = SCW, sca_ = 0x7f7f7f7f; asm volatile("" : "+v"(scw_), "+v"(sca_));
    Unit cur, nxt; int ui = 0;
    if (!S.next(0, cur)) return;
    f32x4 acc[2][2][4][2];
#pragma unroll
    for (int a = 0; a < 2; ++a)
#pragma unroll
        for (int b = 0; b < 2; ++b)
#pragma unroll
            for (int m = 0; m < 4; ++m)
#pragma unroll
                for (int n = 0; n < 2; ++n) acc[a][b][m][n] = (f32x4){0.f, 0.f, 0.f, 0.f};
    v4i At[4][2], B0[2][2], B1[2][2];
    const char* cA = cur.a; const char* cB = cur.b;
    if constexpr (Sched::DSTPF) S.prefetch_dst(cur, 0, wid, lane);
    if constexpr (GATHER) {
#pragma unroll
        for (int h = 0; h < 2; ++h)
#pragma unroll
            for (int i = 0; i < 2; ++i) voffA[h][i] = S.row_off_global(cur, HALF * h + Rr[i]) + cbyte[i];
    }
    PG8_STAGE(PG8_SB(0, 0), cB, voffB[0]); PG8_STAGE(PG8_SB(0, 1), cB, voffB[1]); PG8_STAGE(PG8_SA(0, 0), cA, voffA[0]); PG8_STAGE(PG8_SA(0, 1), cA, voffA[1]);
    if (wr == 1) PG8_BAR;
    PG8_WAIT_V(2); PG8_BAR;
    PG8_STAGE(PG8_SB(1, 0), cB + 128, voffB[0]); PG8_STAGE(PG8_SA(1, 0), cA + 128, voffA[0]); PG8_STAGE(PG8_SB(1, 1), cB + 128, voffB[1]);
    PG8_WAIT_V(6); PG8_BAR;
    for (;;) {
        const bool has_next = S.next(ui + 1, nxt);
        const char* nA = has_next ? nxt.a : cA; const char* nB = has_next ? nxt.b : cB;
        if constexpr (GATHER) { if (has_next) S.prefetch_rows(nxt, ui + 1, lds, wid, lane); }
        if constexpr (Sched::DSTPF) { if (has_next) S.prefetch_dst(nxt, ui + 1, wid, lane); }
        const int ntu = (cur.nt > 0) ? cur.nt : nt;
        for (int t = 0; t < ntu; t += 2) {
            const bool last = (t == ntu - 2);
            const char* a1 = cA + (size_t)(t + 1) * 128;
            const char* a2 = last ? nA : cA + (size_t)(t + 2) * 128; const char* b2 = last ? nB : cB + (size_t)(t + 2) * 128;
            const char* a3 = a2 + 128; const char* b3 = b2 + 128;
            unsigned oa[2][2];
#pragma unroll
            for (int h = 0; h < 2; ++h)
#pragma unroll
                for (int i = 0; i < 2; ++i) oa[h][i] = voffA[h][i];
            if constexpr (GATHER) { if (last && has_next) {
#pragma unroll
                for (int h = 0; h < 2; ++h)
#pragma unroll
                    for (int i = 0; i < 2; ++i) oa[h][i] = S.row_off_lds(ui + 1, HALF * h + Rr[i], lds) + cbyte[i]; } }
            PG8_LDB(B0, 0, 0); PG8_LDB(B1, 0, 1); PG8_SCHED; PG8_LDA(At, 0, 0); PG8_STAGE(PG8_SA(1, 1), a1, voffA[1]);
            PG8_WAIT_V(8); PG8_WAIT_L(0); PG8_BAR; PG8_MMA(0, 0, At, B0); PG8_MMA(0, 1, At, B1); PG8_BAR; PG8_SCHED;
            PG8_LDA(At, 0, 1); PG8_STAGE(PG8_SB(0, 0), b2, voffB[0]); PG8_STAGE(PG8_SB(0, 1), b2, voffB[1]); PG8_STAGE(PG8_SA(0, 0), a2, oa[0]);
            PG8_WAIT_V(8); PG8_WAIT_L(0); PG8_BAR; PG8_MMA(1, 0, At, B0); PG8_MMA(1, 1, At, B1); PG8_BAR; PG8_SCHED;
            PG8_LDB(B0, 1, 0); PG8_LDB(B1, 1, 1); PG8_SCHED; PG8_LDA(At, 1, 0); PG8_STAGE(PG8_SA(0, 1), a2, oa[1]);
            PG8_WAIT_V(8); PG8_WAIT_L(0); PG8_BAR; PG8_MMA(0, 0, At, B0); PG8_MMA(0, 1, At, B1); PG8_BAR; PG8_SCHED;
            PG8_LDA(At, 1, 1); PG8_STAGE(PG8_SB(1, 0), b3, voffB[0]); PG8_STAGE(PG8_SB(1, 1), b3, voffB[1]); PG8_STAGE(PG8_SA(1, 0), a3, oa[0]);
            PG8_WAIT_V(8); PG8_WAIT_L(0); PG8_BAR; PG8_MMA(1, 0, At, B0); PG8_MMA(1, 1, At, B1); PG8_BAR; PG8_SCHED;
            if constexpr (GATHER) { if (last) {
#pragma unroll
                for (int h = 0; h < 2; ++h)
#pragma unroll
                    for (int i = 0; i < 2; ++i) voffA[h][i] = oa[h][i]; } }
        }
        if constexpr (ALIGN_EPI) { if (wr == 0) PG8_BAR; }
        if constexpr (F8) asm volatile("s_nop 15\n\ts_nop 15" ::: "memory");
        E(acc, cur, wr, wc, fr, fq, lds);
        if (!has_next) break;
#pragma unroll
        for (int a = 0; a < 2; ++a)
#pragma unroll
            for (int b = 0; b < 2; ++b)
#pragma unroll
                for (int m = 0; m < 4; ++m)
#pragma unroll
                    for (int n = 0; n < 2; ++n) acc[a][b][m][n] = (f32x4){0.f, 0.f, 0.f, 0.f};
        cur = nxt; cA = nA; cB = nB; ++ui;
        if constexpr (ALIGN_EPI) { if (wr == 1) PG8_BAR; }
    }
    PG8_WAIT_V(0);
    if constexpr (!ALIGN_EPI) { if (wr == 0) PG8_BAR; }
    PG8_BAR;
#undef PG8_SA
#undef PG8_SB
#undef PG8_STAGE
#undef PG8_LDA
#undef PG8_LDB
#undef PG8_MMA
#undef PG8_CAT
#undef PG8_WAIT_V
#undef PG8_WAIT_L
#undef PG8_BAR
#undef PG8_SCHED
}
}
}
namespace mk {
struct Args { const float* in[29]; float* out; unsigned char* ws; int ph_lo, ph_hi, li, pad; };
static_assert(sizeof(Args) == 31 * 8 + 16, "Args has no padding");

__device__ __forceinline__ void tile_order(int L, int nM, int nN, int& pm, int& pn) {
    const int nwg = nM * nN; int wgid = L;
    { const int q = nwg / 8, r = nwg % 8, xcd = wgid % 8, off = wgid / 8; wgid = (xcd < r ? xcd * (q + 1) : r * (q + 1) + (xcd - r) * q) + off; }
    const int nig = 8 * nN, gid = wgid / nig, fm = gid * 8, gsz = (nM - fm) < 8 ? (nM - fm) : 8;
    pm = fm + ((wgid % nig) % gsz); pn = (wgid % nig) / gsz;
}

__device__ __forceinline__ void p0_adaln(const Args& A, LAS unsigned char* lds, int tid, int G) {
    LAS float* st = (LAS float*)lds;
    const float* c = A.in[1]; const float* cc = A.in[3]; const float* w = A.in[4]; const float* bias = A.in[5];
    float* mod = (float*)(A.ws + WS_MOD);
    const int cg = tid % 12, kg = tid / 12;
    __syncthreads();
    for (int cb = blockIdx.x; cb < 256; cb += G) {
        for (int i = tid; i < 9 * D; i += NTHR) { const float v = (i < 8 * D) ? c[i] : cc[i - 8 * D]; st[i] = v / (1.0f + __expf(-v)); }
        __syncthreads();
        float acc[9][4];
#pragma unroll
        for (int r = 0; r < 9; ++r)
#pragma unroll
            for (int j = 0; j < 4; ++j) acc[r][j] = 0.f;
        const int col0 = cb * 48 + cg * 4;
        if (kg < 42) {
            for (int k = kg; k < D; k += 42) {
                const f32x4 wv = *(const f32x4*)(w + (size_t)k * MODW + col0);
#pragma unroll
                for (int r = 0; r < 9; ++r) { const float s = st[r * D + k];
#pragma unroll
                    for (int j = 0; j < 4; ++j) acc[r][j] += s * wv[j]; }
            }
        }
        __syncthreads();
        if (kg < 42) {
#pragma unroll
            for (int r = 0; r < 9; ++r)
#pragma unroll
                for (int j = 0; j < 4; ++j) st[(kg * 12 + cg) * 36 + r * 4 + j] = acc[r][j];
        }
        __syncthreads();
        if (tid < 432) { const int ocg = tid / 36, rj = tid % 36, r = rj >> 2, j = rj & 3; float s = 0.f;
            for (int q = 0; q < 42; ++q) s += st[(q * 12 + ocg) * 36 + rj];
            const int col = cb * 48 + ocg * 4 + j; mod[(size_t)r * MODW + col] = s + bias[col]; }
        __syncthreads();
    }
}

__device__ __forceinline__ void tr_item(const float* W, int ldw, int k0, int n0, bf16* WT, size_t dst_row0, int ldk, bool perm, LAS float* scr, int lane) {
#pragma unroll 8
    for (int i = 0; i < 32; ++i) { const int kk = 2 * i + (lane >> 5); scr[kk * 33 + (lane & 31)] = W[(size_t)(k0 + kk) * ldw + n0 + (lane & 31)]; }
    LDS_WAIT(); asm volatile("" ::: "memory");
    const int c = lane & 7;
#pragma unroll
    for (int j = 0; j < 4; ++j) { const int n = (lane >> 3) + 8 * j; const LAS float* s = scr + (8 * c) * 33 + n;
        v4u o; o.x = pk2(s[0 * 33], s[1 * 33]); o.y = pk2(s[2 * 33], s[3 * 33]); o.z = pk2(s[4 * 33], s[5 * 33]); o.w = pk2(s[6 * 33], s[7 * 33]);
        const int slot = perm ? pg8::perm_slot32(n) : n;
        *(GAS v4u*)(WT + (dst_row0 + slot) * (size_t)ldk + k0 + 8 * c) = o; }
    LDS_WAIT(); asm volatile("" ::: "memory");
}
__device__ __forceinline__ void tr_item_f8(const float* W, int ldw, int k0, int n0, unsigned char* WT, size_t dst_row0, int ldk, int mode256, LAS float* scr, int lane) {
#pragma unroll 8
    for (int i = 0; i < 32; ++i) { const int kk = 2 * i + (lane >> 5); scr[kk * 33 + (lane & 31)] = __builtin_nontemporal_load(W + (size_t)(k0 + kk) * ldw + n0 + (lane & 31)); }
    LDS_WAIT(); asm volatile("" ::: "memory");
    const int c = lane & 7;
#pragma unroll
    for (int j = 0; j < 4; ++j) { const int n = (lane >> 3) + 8 * j; const LAS float* s = scr + (8 * c) * 33 + n;
        v2u o; o.x = pk4_fp8(s[0 * 33] * 64.f, s[1 * 33] * 64.f, s[2 * 33] * 64.f, s[3 * 33] * 64.f); o.y = pk4_fp8(s[4 * 33] * 64.f, s[5 * 33] * 64.f, s[6 * 33] * 64.f, s[7 * 33] * 64.f);
        const int slot = mode256 ? pg8::perm_slot256((n0 & 255) + n) : pg8::perm_slot32(n);
        *(GAS v2u*)(WT + (dst_row0 + slot) * (size_t)ldk + k0 + 8 * c) = o; }
    LDS_WAIT(); asm volatile("" ::: "memory");
}
__device__ __forceinline__ void tr_item_hilo(const float* W, int ldw, int k0, int n0, bf16* WT, int ldk, LAS float* scr, int lane) {
#pragma unroll 8
    for (int i = 0; i < 32; ++i) { const int kk = 2 * i + (lane >> 5); scr[kk * 33 + (lane & 31)] = W[(size_t)(k0 + kk) * ldw + n0 + (lane & 31)]; }
    LDS_WAIT(); asm volatile("" ::: "memory");
    const int c = lane & 7;
#pragma unroll
    for (int j = 0; j < 4; ++j) { const int n = (lane >> 3) + 8 * j; const LAS float* s = scr + (8 * c) * 33 + n;
        float v[8]; unsigned hb[8], lb[8];
#pragma unroll
        for (int q = 0; q < 8; ++q) { v[q] = s[q * 33]; hb[q] = f2bf(v[q]); lb[q] = f2bf(v[q] - __builtin_bit_cast(float, hb[q] << 16)); }
        v4u oh, ol; oh.x = hb[0] | (hb[1] << 16); oh.y = hb[2] | (hb[3] << 16); oh.z = hb[4] | (hb[5] << 16); oh.w = hb[6] | (hb[7] << 16);
        ol.x = lb[0] | (lb[1] << 16); ol.y = lb[2] | (lb[3] << 16); ol.z = lb[4] | (lb[5] << 16); ol.w = lb[6] | (lb[7] << 16);
        *(GAS v4u*)(WT + (size_t)(n0 + n) * ldk + k0 + 8 * c) = oh;
        *(GAS v4u*)(WT + (size_t)(NE + n0 + n) * ldk + k0 + 8 * c) = ol; }
    LDS_WAIT(); asm volatile("" ::: "memory");
}

__device__ __forceinline__ void p0_weights(const Args& A, LAS unsigned char* lds, int tid, int lane, int wave, int vcu, int G) {
    LAS float* scr = (LAS float*)(lds + wave * 16384);
    const int gw = vcu * NWAVES + wave, NGW = G * NWAVES;
    bf16* WIN = (bf16*)(A.ws + WS_WIN); bf16* WOUT = (bf16*)(A.ws + WS_WOUT); unsigned char* WGU = A.ws + WS_WGU; unsigned char* WD = A.ws + WS_WD; bf16* WR = (bf16*)(A.ws + WS_WR);
    constexpr int I_IN = 32 * 64, I_OUT = 32 * 64, I_GU = 32 * 16, I_D = 8 * 64, I_R = 32 * 2;
    constexpr int NITEMS = I_IN + I_OUT + NEX * (2 * I_GU + I_D) + I_R;
    for (int it = gw; it < NITEMS; it += NGW) {
        int r = it;
        if (r < I_IN) { const int kb = r / 64, nb = r % 64; tr_item(A.in[6], DIN, 64 * kb, 32 * nb, WIN, (size_t)32 * nb, D, true, scr, lane); continue; } r -= I_IN;
        if (r < I_OUT) { const int kb = r / 64, nb = r % 64; tr_item(A.in[16], D, 64 * kb, 32 * nb, WOUT, (size_t)32 * nb, D, true, scr, lane); continue; } r -= I_OUT;
        if (r < NEX * 2 * I_GU) { const int e = r / (2 * I_GU); int q = r % (2 * I_GU); const int bj = q / I_GU; q %= I_GU; const int kb = q / 16, nb = q % 16;
            const float* W = (e < NE) ? A.in[bj ? 22 : 21] + (size_t)e * D * DE : A.in[bj ? 25 : 24];
            const int n0 = 32 * nb, ct = n0 >> 7, wcg = (n0 >> 5) & 3;
            tr_item_f8(W, DE, 64 * kb, n0, WGU, (size_t)e * 1024 + ct * 256 + bj * 128 + wcg * 32, D, 0, scr, lane); continue; } r -= NEX * 2 * I_GU;
        if (r < NEX * I_D) { const int e = r / I_D, q = r % I_D, kb = q / 64, nb = q % 64;
            const float* W = (e < NE) ? A.in[23] + (size_t)e * DE * D : A.in[26];
            tr_item_f8(W, D, 64 * kb, 32 * nb, WD, (size_t)e * D + ((32 * nb) & ~255), DE, 1, scr, lane); continue; } r -= NEX * I_D;
        { const int kb = r / 2, nb = r % 2; tr_item_hilo(A.in[19], NE, 64 * kb, 32 * nb, WR, D, scr, lane); }
    }
    { float* misc = (float*)(A.ws + WS_MISC); const int i = gw * 64 + lane;
      if (i < 2 * DL) { const float l = -A.in[13][i]; misc[MS_SP + i] = -8.0f * 1.4426950408889634f * ((l > 20.f) ? l : log1pf(expf(l)));
          const int d = i >> 10, ch = i & 1023; misc[MS_GB + d * 2 * DL + ch] = -1.4426950408889634f * A.in[10][i]; misc[MS_GB + d * 2 * DL + DL + ch] = -1.4426950408889634f * A.in[12][i]; } }
    {   bf16* WG4 = (bf16*)(A.ws + WS_WG4);
        for (int it = gw; it < 4 * 4 * 4 * 32; it += NGW) {
            const int k8 = it & 31, gt = (it >> 5) & 3, q = (it >> 7) & 3, h = it >> 9, cl = lane;
            const float* src = ((gt & 1) ? A.in[11] : A.in[9]) + ((size_t)(gt >> 1) * 4 + h) * 65536 + q * 64 + cl;
            float v[8];
#pragma unroll
            for (int j = 0; j < 8; ++j) v[j] = -1.4426950408889634f * src[(size_t)(k8 * 8 + j) * 256];
            const int rho = (gt >> 1) * 128 + (cl >> 4) * 32 + (gt & 1) * 16 + ((cl >> 2) & 3) * 4 + (cl & 3);
            v4u o; o.x = pk2(v[0], v[1]); o.y = pk2(v[2], v[3]); o.z = pk2(v[4], v[5]); o.w = pk2(v[6], v[7]);
            *(GAS v4u*)(WG4 + ((size_t)h * 1024 + q * 256 + rho) * 256 + k8 * 8) = o;
        }
    }
    {   bf16* CS = (bf16*)(A.ws + WS_CS);
        for (int it = gw; it < 2 * 2048 * 4; it += NGW) {
            const int nq = it & 3, k = (it >> 2) & 2047, ty = it >> 13, n0 = nq * 512 + lane * 8;
            float v[8];
#pragma unroll
            for (int j = 0; j < 8; ++j) { const float x = (float)((k * (n0 + j)) & 4095) * (1.0f / 4096.0f); v[j] = ty ? __builtin_amdgcn_sinf(x) : __builtin_amdgcn_cosf(x); }
            v4u o; o.x = pk2(v[0], v[1]); o.y = pk2(v[2], v[3]); o.z = pk2(v[4], v[5]); o.w = pk2(v[6], v[7]);
            *(GAS v4u*)(CS + ((size_t)ty * 2048 + k) * 2048 + n0) = o;
        }
    }
}
__device__ __forceinline__ void p0_fold(const Args& A, LAS unsigned char* lds, int tid, int G) {
    LAS float* wt = (LAS float*)lds;
    LAS float* tb = (LAS float*)(lds + 64 * 129 * 4);
    bf16* WIN = (bf16*)(A.ws + WS_WIN);
    const float scale = 1.0f / 724.0773439350247f;
    for (int it = blockIdx.x; it < 256; it += G) {
        const int kb = it >> 3, g = it & 7, k0 = kb * 64;
        __syncthreads();
        if (tid < 128) { tb[tid] = __builtin_amdgcn_cosf((float)tid * (1.0f / 128.0f)); tb[128 + tid] = __builtin_amdgcn_sinf((float)tid * (1.0f / 128.0f)); }
        for (int i = tid; i < 64 * 128; i += NTHR) { const int kk = i >> 7, c = i & 127; wt[kk * 129 + c] = A.in[6][(size_t)(k0 + kk) * DIN + 2 * DL + g * 128 + c]; }
        __syncthreads();
        const int j = tid & 127, kq = tid >> 7, jj = (j <= 64) ? j : j - 64; const bool isc = (j <= 64);
        float acc[16];
#pragma unroll
        for (int i = 0; i < 16; ++i) acc[i] = 0.f;
        for (int c = 0; c < 128; ++c) { const int ph = (c * jj) & 127; const float tv = isc ? tb[ph] : -tb[128 + ph];
#pragma unroll
            for (int i = 0; i < 16; ++i) acc[i] += wt[(kq * 16 + i) * 129 + c] * tv; }
        const int col = g * 128 + j, row = 2 * DL + (col & ~31) + pg8::perm_slot32(col & 31);
        v4u o0, o1; o0.x = pk2(acc[0] * scale, acc[1] * scale); o0.y = pk2(acc[2] * scale, acc[3] * scale); o0.z = pk2(acc[4] * scale, acc[5] * scale); o0.w = pk2(acc[6] * scale, acc[7] * scale);
        o1.x = pk2(acc[8] * scale, acc[9] * scale); o1.y = pk2(acc[10] * scale, acc[11] * scale); o1.z = pk2(acc[12] * scale, acc[13] * scale); o1.w = pk2(acc[14] * scale, acc[15] * scale);
        GAS v4u* dst = (GAS v4u*)(WIN + (size_t)row * D + k0 + kq * 16); dst[0] = o0; dst[1] = o1;
    }
    __syncthreads();
}

__device__ __forceinline__ void p1_hnorm(const Args& A, int lane, int wave, int vcu, int G) {
    const int gw = vcu * NWAVES + wave, NGW = G * NWAVES;
    const float* mod = (const float*)(A.ws + WS_MOD); bf16* H = (bf16*)(A.ws + WS_H);
    for (int r0 = gw; r0 < TT; r0 += 2 * NGW) {
        const int r1 = r0 + NGW; const bool has1 = r1 < TT; const int r1c = has1 ? r1 : r0;
        const float* x0 = (r0 < T) ? A.in[0] + (size_t)r0 * D : A.in[2] + (size_t)(r0 - T) * D; const float* x1 = (r1c < T) ? A.in[0] + (size_t)r1c * D : A.in[2] + (size_t)(r1c - T) * D;
        const int b0 = (r0 < T) ? r0 / SEQ : 8, b1 = (r1c < T) ? r1c / SEQ : 8;
        const GAS f32x4* xr0 = (const GAS f32x4*)x0 + lane; const GAS f32x4* xr1 = (const GAS f32x4*)x1 + lane;
        f32x4 v[8], u[8]; float s = 0.f, q = 0.f;
#pragma unroll
        for (int j = 0; j < 8; ++j) { v[j] = __builtin_nontemporal_load(xr0 + 64 * j); u[j] = __builtin_nontemporal_load(xr1 + 64 * j); }
#pragma unroll
        for (int j = 0; j < 8; ++j) { s += (v[j].x + v[j].y) + (v[j].z + v[j].w); q += (u[j].x + u[j].y) + (u[j].z + u[j].w); }
        const float mean0 = wave_sum(s) * (1.f / D), mean1 = wave_sum(q) * (1.f / D); float s2 = 0.f, q2 = 0.f;
#pragma unroll
        for (int j = 0; j < 8; ++j) { v[j] = v[j] - mean0; u[j] = u[j] - mean1; s2 += (v[j].x * v[j].x + v[j].y * v[j].y) + (v[j].z * v[j].z + v[j].w * v[j].w); q2 += (u[j].x * u[j].x + u[j].y * u[j].y) + (u[j].z * u[j].z + u[j].w * u[j].w); }
        const float rstd0 = 1.f / sqrtf(wave_sum(s2) * (1.f / D) + EPS), rstd1 = 1.f / sqrtf(wave_sum(q2) * (1.f / D) + EPS);
        { const GAS f32x4* sh = (const GAS f32x4*)(mod + (size_t)b0 * MODW) + lane; const GAS f32x4* sc = (const GAS f32x4*)(mod + (size_t)b0 * MODW + D) + lane; GAS v2u* o8 = (GAS v2u*)(H + (size_t)r0 * D) + lane;
#pragma unroll
          for (int j = 0; j < 8; ++j) { const f32x4 a = sh[64 * j], m = sc[64 * j]; const f32x4 y = v[j] * rstd0 * (m + 1.0f) + a; v2u o; o.x = pk2(y.x, y.y); o.y = pk2(y.z, y.w); o8[64 * j] = o; } }
        if (has1) { const GAS f32x4* sh = (const GAS f32x4*)(mod + (size_t)b1 * MODW) + lane; const GAS f32x4* sc = (const GAS f32x4*)(mod + (size_t)b1 * MODW + D) + lane; GAS v2u* o8 = (GAS v2u*)(H + (size_t)r1 * D) + lane;
#pragma unroll
          for (int j = 0; j < 8; ++j) { const f32x4 a = sh[64 * j], m = sc[64 * j]; const f32x4 y = u[j] * rstd1 * (m + 1.0f) + a; v2u o; o.x = pk2(y.x, y.y); o.y = pk2(y.z, y.w); o8[64 * j] = o; } }
    }
}

struct SchedInproj {
    static constexpr bool DSTPF = false;
    const char* H; const char* W; int G, c;
    __device__ __forceinline__ bool next(int i, pg8::Unit& u) {
        const int L = i * G + c; if (L >= 1536 + 256) return false;
        if (L < 1536) { int pm, pn; tile_order(L, 128, 12, pm, pn);
            u.pm = pm; u.pn = pn; u.aux0 = 0; u.aux1 = 0; u.nt = 0; u.a = H + (size_t)pm * 256 * (D * 2); u.b = W + (size_t)pn * 256 * (D * 2); }
        else {
            const int x = L - 1536, tile = x >> 3, ks = x & 7, pm = 128 + (tile >> 2), pn = tile & 3;
            u.pm = pm; u.pn = pn; u.aux0 = 1 + ks; u.aux1 = 0; u.nt = 4; u.a = H + (size_t)pm * 256 * (D * 2) + ks * 512; u.b = W + (size_t)pn * 256 * (D * 2) + ks * 512; }
        return true;
    }
};
struct EpiInproj {
    static __device__ __forceinline__ int a_row(int h, int R) { return 128 * h + R; }
    bf16* U; bf16* UPART;
    __device__ __forceinline__ void operator()(const f32x4 (&acc)[2][2][4][2], const pg8::Unit& u, int wr, int wc, int fr, int fq, LAS unsigned char*) const {
        const int arr = u.pn >> 2; const size_t aoff = (arr >= 1 ? (size_t)TT * DL : 0) + (arr >= 2 ? (size_t)T * DL : 0);
        bf16* base = U + aoff;
        int rowsub = 0; if (u.aux0 > 0) { base = UPART + (size_t)(u.aux0 - 1) * TC * DL; rowsub = T; }
        const int row0 = u.pm * 256 + wr * 64 + fr - rowsub, col0 = (u.pn & 3) * 256 + wc * 32 + 8 * fq;
#pragma unroll
        for (int ai = 0; ai < 2; ++ai)
#pragma unroll
            for (int m = 0; m < 4; ++m) { bf16* rowp = base + (size_t)(row0 + ai * 128 + m * 16) * DL + col0;
#pragma unroll
                for (int bj = 0; bj < 2; ++bj) { const f32x4 v0 = acc[ai][bj][m][0], v1 = acc[ai][bj][m][1];
                    v4u w; w.x = cvt_pk_bf16(v0[0], v0[1]); w.y = cvt_pk_bf16(v0[2], v0[3]); w.z = cvt_pk_bf16(v1[0], v1[1]); w.w = cvt_pk_bf16(v1[2], v1[3]);
                    *(v4u*)(rowp + bj * 128) = w; } }
    }
};
}
namespace mk {
__device__ __forceinline__ void p3_conv(const Args& A, int lane, int wave, int vcu, int G) {
    const int gw = vcu * NWAVES + wave, NGW = G * NWAVES;
    const bf16* U = (const bf16*)(A.ws + WS_U); const bf16* UPART = (const bf16*)(A.ws + WS_UPART); bf16* UC = (bf16*)(A.ws + WS_UC);
    const float* cw = A.in[7]; const float* cb = A.in[8];
    for (int it = gw; it < (TT / 64) * 4; it += NGW) {
        const int rb = it >> 2, cblk = it & 3, r0 = rb * 64, ch = cblk * 256 + lane * 4;
        int slo, shi; if (r0 < T) { slo = r0; shi = r0 + 64; } else { slo = T + ((r0 - T) & ~255); shi = slo + 256; }
        const f32x4 w0 = *(const f32x4*)(cw + ch), w1 = *(const f32x4*)(cw + DL + ch), w2 = *(const f32x4*)(cw + 2 * DL + ch), w3 = *(const f32x4*)(cw + 3 * DL + ch), bb = *(const f32x4*)(cb + ch);
        auto ld = [&](int r) -> f32x4 { if (r < slo || r >= shi) return (f32x4){0.f, 0.f, 0.f, 0.f};
            if (r < T) { const v2u q = *(const GAS v2u*)(U + (size_t)r * DL + ch); return (f32x4){bf_lo(q.x), bf_hi(q.x), bf_lo(q.y), bf_hi(q.y)}; }
            f32x4 a = (f32x4){0.f, 0.f, 0.f, 0.f};
#pragma unroll
            for (int ks = 0; ks < 8; ++ks) { const v2u q = *(const GAS v2u*)(UPART + ((size_t)ks * TC + (r - T)) * DL + ch); a = a + (f32x4){bf_lo(q.x), bf_hi(q.x), bf_lo(q.y), bf_hi(q.y)}; }
            return a; };
        f32x4 um2 = ld(r0 - 2), um1 = ld(r0 - 1), u0 = ld(r0);
#pragma unroll 8
        for (int p = 0; p < 64; ++p) {
            const f32x4 up1 = ld(r0 + p + 1);
            const f32x4 y = bb + w0 * um2 + w1 * um1 + w2 * u0 + w3 * up1;
            v2u o; o.x = pk2(y.x, y.y); o.y = pk2(y.z, y.w); *(GAS v2u*)(UC + (size_t)(r0 + p) * DL + ch) = o;
            um2 = um1; um1 = u0; u0 = up1;
        }
    }
}
__device__ __forceinline__ void p3_fold(const Args& A, LAS unsigned char* lds, int lane, int wave, int vcu, int G) {
    const int gw = vcu * NWAVES + wave, NGW = G * NWAVES;
    const bf16* FOUR = (const bf16*)(A.ws + WS_FOUR); bf16* PQT = (bf16*)(A.ws + WS_PQT); float* misc = (float*)(A.ws + WS_MISC);
    LAS bf16* scr = (LAS bf16*)(lds + wave * 16384);
    const int c8 = lane & 7, rr = lane >> 3;
    for (int it = gw; it < NB * 16 * 32; it += NGW) {
        const int nb = it & 31, cblk = (it >> 5) & 15, b = it >> 9, g = cblk >> 1, half = cblk & 1, n0 = nb * 64;
        const bf16* base = FOUR + (size_t)b * SEQ * DF + g * 128 + half * 64 + c8 * 8;
#pragma unroll
        for (int s = 0; s < 8; ++s) {
            const int nn = s * 8 + rr, n = n0 + nn;
            const v4u x = *(const GAS v4u*)(base + (size_t)n * DF);
            v4u xm = (v4u){0u, 0u, 0u, 0u}; if (n >= 1) xm = *(const GAS v4u*)(base + (size_t)(SEQ - n) * DF);
            float v[8], vm[8];
            v[0] = bf_lo(x.x); v[1] = bf_hi(x.x); v[2] = bf_lo(x.y); v[3] = bf_hi(x.y); v[4] = bf_lo(x.z); v[5] = bf_hi(x.z); v[6] = bf_lo(x.w); v[7] = bf_hi(x.w);
            vm[0] = bf_lo(xm.x); vm[1] = bf_hi(xm.x); vm[2] = bf_lo(xm.y); vm[3] = bf_hi(xm.y); vm[4] = bf_lo(xm.z); vm[5] = bf_hi(xm.z); vm[6] = bf_lo(xm.w); vm[7] = bf_hi(xm.w);
#pragma unroll
            for (int j = 0; j < 8; ++j) {
                float p;
                if (half == 0) p = v[j] + vm[j];
                else if (c8 == 0 && j == 0) { misc[MS_P64 + (b * 8 + g) * P64_LD + n] = v[0] + vm[0]; p = 0.f; }
                else p = (n >= 1) ? v[j] - vm[j] : 0.f;
                scr[(c8 * 8 + j) * 66 + nn] = (bf16)f2bf(p);
            }
        }
        LDS_WAIT(); asm volatile("" ::: "memory");
        bf16* dst = PQT + (((size_t)b * 2 + half) * 512 + g * 64) * 2048 + n0 + c8 * 8;
#pragma unroll
        for (int s = 0; s < 8; ++s) {
            const int jj = s * 8 + rr; const LAS bf16* q = scr + jj * 66 + c8 * 8;
            const unsigned a0 = q[0] | ((unsigned)q[1] << 16), a1 = q[2] | ((unsigned)q[3] << 16), a2 = q[4] | ((unsigned)q[5] << 16), a3 = q[6] | ((unsigned)q[7] << 16);
            *(GAS v4u*)(dst + (size_t)jj * 2048) = (v4u){a0, a1, a2, a3};
            if (half == 0) {
                float ps = (bf_lo(a0) - bf_hi(a0)) + (bf_lo(a1) - bf_hi(a1)) + (bf_lo(a2) - bf_hi(a2)) + (bf_lo(a3) - bf_hi(a3));
                ps += __shfl_xor(ps, 1); ps += __shfl_xor(ps, 2); ps += __shfl_xor(ps, 4);
                if (c8 == 0) misc[MS_ALT + (b * 32 + nb) * 512 + g * 64 + jj] = ps;
            }
        }
        LDS_WAIT(); asm volatile("" ::: "memory");
    }
    if (gw < NB * 8) { const int b = gw >> 3, g = gw & 7; if (lane == 0) misc[MS_P64 + (b * 8 + g) * P64_LD + 2048] = bf2f(FOUR[((size_t)b * SEQ + 2048) * DF + g * 128 + 64]); }
}

struct SchedDft {
    static constexpr bool DSTPF = false;
    const char* CS; const char* PQT; int G, c;
    __device__ __forceinline__ bool next(int i, pg8::Unit& u) {
        const int L = i * G + c; if (L >= 256) return false;
        const int b = L >> 5, kt = (L >> 2) & 7, ct = L & 3, type = ct >> 1;
        u.pm = kt; u.pn = ct; u.aux0 = b; u.aux1 = 0; u.nt = 0;
        u.a = CS + ((size_t)type * 2048 + kt * 256) * 4096; u.b = PQT + (((size_t)b * 2 + type) * 512 + (ct & 1) * 256) * 4096; return true;
    }
};
struct EpiDft {
    static __device__ __forceinline__ int a_row(int h, int R) { return 128 * h + R; }
    bf16* AB;
    __device__ __forceinline__ void operator()(f32x4 (&acc)[2][2][4][2], const pg8::Unit& u, int wr, int wc, int fr, int fq, LAS unsigned char*) const {
        const int row0 = u.pm * 256 + wr * 64 + fr, col0 = u.pn * 256 + wc * 32 + 4 * fq;
        bf16* base = AB + (size_t)u.aux0 * 2048 * 1024;
#pragma unroll
        for (int ai = 0; ai < 2; ++ai)
#pragma unroll
            for (int m = 0; m < 4; ++m) { bf16* rowp = base + (size_t)(row0 + ai * 128 + m * 16) * 1024 + col0;
#pragma unroll
                for (int bj = 0; bj < 2; ++bj)
#pragma unroll
                    for (int n = 0; n < 2; ++n) { const f32x4 v = acc[ai][bj][m][n]; v2u w; w.x = cvt_pk_bf16(v[0], v[1]); w.y = cvt_pk_bf16(v[2], v[3]); *(v2u*)(rowp + bj * 128 + n * 16) = w; } }
    }
};

struct SchedGates {
    static constexpr bool DSTPF = false;
    const char* UC; const char* WG4; int G, c;
    __device__ __forceinline__ bool next(int i, pg8::Unit& u) {
        const int L = i * G + c; if (L >= (TT / 256) * 16) return false;
        const int st = L >> 4, hq = L & 15;
        u.pm = st; u.pn = hq; u.aux0 = st; u.aux1 = hq; u.nt = 0;
        u.a = UC + (size_t)st * 256 * (DL * 2) + (hq >> 2) * 512; u.b = WG4 + (size_t)hq * 256 * 512; return true;
    }
};
template <int CTRL> __device__ __forceinline__ float dpp_f(float oldv, float src) {
    return __builtin_bit_cast(float, __builtin_amdgcn_update_dpp(__builtin_bit_cast(int, oldv), __builtin_bit_cast(int, src), CTRL, 0xF, 0xF, false));
}
template <int DIR, int DIST> __device__ __forceinline__ void scan_step(float& a, float& b) {
    const float ap = dpp_f<(DIR ? 0x100 : 0x110) + DIST>(1.0f, a), bp = dpp_f<(DIR ? 0x100 : 0x110) + DIST>(0.0f, b);
    b = a * bp + b; a = ap * a;
}
struct EpiLru {
    static __device__ __forceinline__ int a_row(int h, int R) { return 128 * (R >> 6) + 8 * (R & 15) + 4 * h + ((R >> 4) & 3); }
    const bf16* UC; const float* ba; const float* bx; bf16* S; bf16* PF; bf16* PB; float* misc;
    __device__ __forceinline__ void operator()(f32x4 (&acc)[2][2][4][2], const pg8::Unit& u, int wr, int wc, int fr, int fq, LAS unsigned char*) const {
        int tz = threadIdx.x; asm volatile("" : "+v"(tz));
        fr = tz & 15; fq = (tz >> 4) & 3;
        const int st = u.aux0, hq = u.aux1, ch0 = hq * 64 + wc * 16 + fq * 4;
        const int row0 = st * 256 + wr * 128 + fr * 8;
        v2u ucp[2][4];
#pragma unroll
        for (int ai = 0; ai < 2; ++ai)
#pragma unroll
            for (int m = 0; m < 4; ++m) ucp[ai][m] = *(const GAS v2u*)((const GAS char*)UC + ((unsigned)(row0 + 4 * ai + m) * DL + ch0) * 2u);
#pragma unroll
        for (int d = 0; d < 2; ++d) {
            const f32x4 bav = *(const f32x4*)(misc + MS_GB + d * 2 * DL + ch0), bxv = *(const f32x4*)(misc + MS_GB + d * 2 * DL + DL + ch0), spv = *(const f32x4*)(misc + MS_SP + d * DL + ch0);
            f32x4 c = (f32x4){1.f, 1.f, 1.f, 1.f}, h = (f32x4){0.f, 0.f, 0.f, 0.f};
#pragma unroll
            for (int ii = 0; ii < 8; ++ii) { const int i = d ? 7 - ii : ii, ai = i >> 2, m = i & 3;
                const f32x4 x = (f32x4){bf_lo(ucp[ai][m].x), bf_hi(ucp[ai][m].x), bf_lo(ucp[ai][m].y), bf_hi(ucp[ai][m].y)};
                const f32x4 p0 = acc[ai][d][m][0] + bav, p1 = acc[ai][d][m][1] + bxv;
                f32x4 a, b;
#pragma unroll
                for (int e = 0; e < 4; ++e) { const float r = __builtin_amdgcn_rcpf(1.0f + __builtin_amdgcn_exp2f(p0[e])), ig = __builtin_amdgcn_rcpf(1.0f + __builtin_amdgcn_exp2f(p1[e])); const float av = __builtin_amdgcn_exp2f(r * spv[e]); a[e] = av; b[e] = __builtin_amdgcn_sqrtf(fmaxf(1.0f - av * av, 0.f)) * ig; }
                h = a * h + b * x; c = c * a; acc[ai][d][m][0] = c; acc[ai][d][m][1] = h;
                if (ii & 1) __builtin_amdgcn_sched_barrier(0); }
            f32x4 cin, hin;
#pragma unroll
            for (int e = 0; e < 4; ++e) { float ta = c[e], tb = h[e];
                if (d == 0) { scan_step<0, 1>(ta, tb); scan_step<0, 2>(ta, tb); scan_step<0, 4>(ta, tb); scan_step<0, 8>(ta, tb); }
                else        { scan_step<1, 1>(ta, tb); scan_step<1, 2>(ta, tb); scan_step<1, 4>(ta, tb); scan_step<1, 8>(ta, tb); }
                cin[e] = d ? dpp_f<0x101>(1.0f, ta) : dpp_f<0x111>(1.0f, ta); hin[e] = d ? dpp_f<0x101>(0.0f, tb) : dpp_f<0x111>(0.0f, tb); }
#pragma unroll
            for (int i = 0; i < 8; ++i) { const int ai = i >> 2, m = i & 3; const f32x4 cl = acc[ai][d][m][0]; acc[ai][d][m][1] = acc[ai][d][m][1] + cl * hin; acc[ai][d][m][0] = cl * cin; }
            __builtin_amdgcn_sched_barrier(0);
        }
        const int sub = st * 2 + wr;
#pragma unroll
        for (int ai = 0; ai < 2; ++ai)
#pragma unroll
            for (int m = 0; m < 4; ++m) {
                const f32x4 pf = acc[ai][0][m][0], hf = acc[ai][0][m][1], pb = acc[ai][1][m][0], hb = acc[ai][1][m][1];
                const unsigned off = ((unsigned)(row0 + 4 * ai + m) * DL + ch0) * 2u;
                if (st < T / 256) {
                    v2u o; o.x = cvt_pk_bf16(hf[0] + hb[0], hf[1] + hb[1]); o.y = cvt_pk_bf16(hf[2] + hb[2], hf[3] + hb[3]); *(GAS v2u*)((GAS char*)S + off) = o;
                    o.x = cvt_pk_bf16(pf[0], pf[1]); o.y = cvt_pk_bf16(pf[2], pf[3]); *(GAS v2u*)((GAS char*)PF + off) = o;
                    o.x = cvt_pk_bf16(pb[0], pb[1]); o.y = cvt_pk_bf16(pb[2], pb[3]); *(GAS v2u*)((GAS char*)PB + off) = o;
                }
                if (ai == 1 && m == 3 && fr == 15) { *(f32x4*)(misc + MS_SUMA + ((size_t)sub * 2 + 0) * DL + ch0) = pf; *(f32x4*)(misc + MS_SUMB + ((size_t)sub * 2 + 0) * DL + ch0) = hf; }
                if (ai == 0 && m == 0 && fr == 0) { *(f32x4*)(misc + MS_SUMA + ((size_t)sub * 2 + 1) * DL + ch0) = pb; *(f32x4*)(misc + MS_SUMB + ((size_t)sub * 2 + 1) * DL + ch0) = hb; }
            }
    }
};

__device__ __forceinline__ void p5a_fix(const Args& A, LAS unsigned char* lds, int tid, int lane, int wave, int vcu, int G) {
    const int gw = vcu * NWAVES + wave, NGW = G * NWAVES;
    const float* misc = (const float*)(A.ws + WS_MISC);
    const bf16* Sb = (const bf16*)(A.ws + WS_S); const bf16* PF = (const bf16*)(A.ws + WS_PF); const bf16* PB = (const bf16*)(A.ws + WS_PB); const bf16* GATE = (const bf16*)(A.ws + WS_GATE);
    bf16* YMIX = (bf16*)(A.ws + WS_YMIX); const float* gl = A.in[14];
    {
        LAS float* ctab = (LAS float*)lds;
        LAS float* eo = (LAS float*)(lds + 16384 + wave * 8192);
        for (int i = tid; i < 4096; i += NTHR) ctab[i] = __builtin_amdgcn_cosf((float)i * (1.0f / 4096.0f));
        __syncthreads();
        float* nyq = (float*)(A.ws + WS_MISC) + MS_NYQ;
        for (int it = gw; it < 64 * 32; it += NGW) {
            const int bg = it >> 5, kb = it & 31, kp = kb * 64 + lane;
            const float* src = misc + MS_P64 + (size_t)bg * P64_LD;
#pragma unroll 4
            for (int i = lane; i < 1024; i += 64) { const float p = src[i], q = src[2048 - i]; eo[2 * i] = p + q; eo[2 * i + 1] = p - q; }
            const float pmid = src[1024];
            LDS_WAIT(); asm volatile("" ::: "memory");
            float s = 0.f; int j = 0; const int par = lane & 1;
#pragma unroll 8
            for (int n = 0; n < 1024; ++n) { s += eo[2 * n + par] * ctab[j]; j = (j + kp) & 4095; }
            s += pmid * ctab[j];
            nyq[(size_t)bg * P64_LD + kp] = s;
            if (kb == 0) { float a = 0.f;
#pragma unroll 1
                for (int n = lane; n < 1024; n += 64) a += (n & 1) ? -eo[2 * n] : eo[2 * n]; a = wave_sum(a) + pmid; if (lane == 0) nyq[(size_t)bg * P64_LD + 2048] = a; }
            LDS_WAIT(); asm volatile("" ::: "memory");
        }
    }
    for (int it = gw; it < T / 16; it += NGW) {
        const int t0 = it * 16, b = t0 / SEQ, c = (t0 % SEQ) / 128, ch = lane * 16;
        float cf[16], cbk[16];
        {
            const int cs0 = T / 128 + 2 * b;
            const float* f0b = misc + MS_SUMB + ((size_t)cs0 * 2 + 0) * DL + ch; const float* f1a = misc + MS_SUMA + ((size_t)(cs0 + 1) * 2 + 0) * DL + ch; const float* f1b = misc + MS_SUMB + ((size_t)(cs0 + 1) * 2 + 0) * DL + ch;
            const float* b1b = misc + MS_SUMB + ((size_t)(cs0 + 1) * 2 + 1) * DL + ch; const float* b0a = misc + MS_SUMA + ((size_t)cs0 * 2 + 1) * DL + ch; const float* b0b = misc + MS_SUMB + ((size_t)cs0 * 2 + 1) * DL + ch;
#pragma unroll
            for (int q = 0; q < 4; ++q) { const f32x4 v0 = *(const f32x4*)(f0b + 4 * q), a1 = *(const f32x4*)(f1a + 4 * q), v1 = *(const f32x4*)(f1b + 4 * q);
                const f32x4 w1 = *(const f32x4*)(b1b + 4 * q), a0 = *(const f32x4*)(b0a + 4 * q), w0 = *(const f32x4*)(b0b + 4 * q);
#pragma unroll
                for (int e = 0; e < 4; ++e) { cf[4 * q + e] = a1[e] * v0[e] + v1[e]; cbk[4 * q + e] = a0[e] * w1[e] + w0[e]; } }
            for (int cc = 0; cc < c; ++cc) { const float* pa = misc + MS_SUMA + ((size_t)(b * NSUB + cc) * 2 + 0) * DL + ch; const float* pb = misc + MS_SUMB + ((size_t)(b * NSUB + cc) * 2 + 0) * DL + ch;
#pragma unroll
                for (int q = 0; q < 4; ++q) { const f32x4 va = *(const f32x4*)(pa + 4 * q), vb = *(const f32x4*)(pb + 4 * q);
#pragma unroll
                    for (int e = 0; e < 4; ++e) cf[4 * q + e] = va[e] * cf[4 * q + e] + vb[e]; } }
            for (int cc = NSUB - 1; cc > c; --cc) { const float* pa = misc + MS_SUMA + ((size_t)(b * NSUB + cc) * 2 + 1) * DL + ch; const float* pb = misc + MS_SUMB + ((size_t)(b * NSUB + cc) * 2 + 1) * DL + ch;
#pragma unroll
                for (int q = 0; q < 4; ++q) { const f32x4 va = *(const f32x4*)(pa + 4 * q), vb = *(const f32x4*)(pb + 4 * q);
#pragma unroll
                    for (int e = 0; e < 4; ++e) cbk[4 * q + e] = va[e] * cbk[4 * q + e] + vb[e]; } }
        }
        v4u nx[2][4];
        { const size_t off = (size_t)t0 * DL + ch;
#pragma unroll
          for (int hh = 0; hh < 2; ++hh) { nx[hh][0] = *(const GAS v4u*)(Sb + off + 8 * hh); nx[hh][1] = *(const GAS v4u*)(PF + off + 8 * hh); nx[hh][2] = *(const GAS v4u*)(PB + off + 8 * hh); nx[hh][3] = *(const GAS v4u*)(GATE + off + 8 * hh); } }
        for (int tt = 0; tt < 16; ++tt) {
            v4u cu[2][4];
#pragma unroll
            for (int hh = 0; hh < 2; ++hh)
#pragma unroll
                for (int a4 = 0; a4 < 4; ++a4) cu[hh][a4] = nx[hh][a4];
            if (tt < 15) { const size_t off = (size_t)(t0 + tt + 1) * DL + ch;
#pragma unroll
                for (int hh = 0; hh < 2; ++hh) { nx[hh][0] = *(const GAS v4u*)(Sb + off + 8 * hh); nx[hh][1] = *(const GAS v4u*)(PF + off + 8 * hh); nx[hh][2] = *(const GAS v4u*)(PB + off + 8 * hh); nx[hh][3] = *(const GAS v4u*)(GATE + off + 8 * hh); } }
            float y[16]; float ss = 0.f;
#pragma unroll
            for (int hh = 0; hh < 2; ++hh) {
                const v4u s4 = cu[hh][0], f4 = cu[hh][1], b4 = cu[hh][2], g4 = cu[hh][3];
                const unsigned sw[4] = {s4.x, s4.y, s4.z, s4.w}, fw[4] = {f4.x, f4.y, f4.z, f4.w}, bw[4] = {b4.x, b4.y, b4.z, b4.w}, gw4[4] = {g4.x, g4.y, g4.z, g4.w};
#pragma unroll
                for (int q = 0; q < 4; ++q) { const int i0 = 8 * hh + 2 * q;
                    const float v0 = (bf_lo(sw[q]) + bf_lo(fw[q]) * cf[i0] + bf_lo(bw[q]) * cbk[i0]) * gelu_tanh_f(bf_lo(gw4[q]));
                    const float v1 = (bf_hi(sw[q]) + bf_hi(fw[q]) * cf[i0 + 1] + bf_hi(bw[q]) * cbk[i0 + 1]) * gelu_tanh_f(bf_hi(gw4[q]));
                    y[i0] = v0; y[i0 + 1] = v1; ss += v0 * v0 + v1 * v1; }
            }
            const float r = 1.0f / sqrtf(wave_sum(ss) * (1.0f / DL) + EPS);
            float gn[16];
#pragma unroll
            for (int q = 0; q < 4; ++q) { const f32x4 v = *(const f32x4*)(gl + ch + 4 * q);
#pragma unroll
                for (int e = 0; e < 4; ++e) gn[4 * q + e] = v[e]; }
            v4u o0, o1;
            o0.x = pk2(y[0] * r * gn[0], y[1] * r * gn[1]); o0.y = pk2(y[2] * r * gn[2], y[3] * r * gn[3]); o0.z = pk2(y[4] * r * gn[4], y[5] * r * gn[5]); o0.w = pk2(y[6] * r * gn[6], y[7] * r * gn[7]);
            o1.x = pk2(y[8] * r * gn[8], y[9] * r * gn[9]); o1.y = pk2(y[10] * r * gn[10], y[11] * r * gn[11]); o1.z = pk2(y[12] * r * gn[12], y[13] * r * gn[13]); o1.w = pk2(y[14] * r * gn[14], y[15] * r * gn[15]);
            GAS v4u* dst = (GAS v4u*)(YMIX + (size_t)(t0 + tt) * D + ch); dst[0] = o0; dst[1] = o1;
        }
    }
}

__device__ __forceinline__ void p5b_four(const Args& A, LAS unsigned char* lds, int lane, int wave, int vcu, int G) {
    const int gw = vcu * NWAVES + wave, NGW = G * NWAVES;
    const float* misc = (const float*)(A.ws + WS_MISC); const bf16* AB = (const bf16*)(A.ws + WS_AB); const bf16* FOUR = (const bf16*)(A.ws + WS_FOUR);
    bf16* YMIX = (bf16*)(A.ws + WS_YMIX); const float* gf = A.in[15];
    LAS bf16* rowbuf = (LAS bf16*)(lds + wave * 4096);
    const int g = lane >> 3, jl = lane & 7;
    for (int t = gw; t < T; t += NGW) {
        const int b = t / SEQ, k = t % SEQ, kp = (k <= 2048) ? k : SEQ - k; const float sg = (k <= 2048) ? 1.0f : -1.0f;
        float av[8], bv[8];
        if (kp < 2048) {
            const bf16* row = AB + ((size_t)b * 2048 + kp) * 1024 + g * 64 + jl * 8;
            const v4u a4 = *(const GAS v4u*)row, b4 = *(const GAS v4u*)(row + 512);
            const v4u w4 = *(const GAS v4u*)(FOUR + ((size_t)b * SEQ + 2048) * DF + g * 128 + jl * 8);
            const float sk = (kp & 1) ? -1.0f : 1.0f;
            av[0] = bf_lo(a4.x) + sk * bf_lo(w4.x); av[1] = bf_hi(a4.x) + sk * bf_hi(w4.x); av[2] = bf_lo(a4.y) + sk * bf_lo(w4.y); av[3] = bf_hi(a4.y) + sk * bf_hi(w4.y);
            av[4] = bf_lo(a4.z) + sk * bf_lo(w4.z); av[5] = bf_hi(a4.z) + sk * bf_hi(w4.z); av[6] = bf_lo(a4.w) + sk * bf_lo(w4.w); av[7] = bf_hi(a4.w) + sk * bf_hi(w4.w);
            bv[0] = bf_lo(b4.x); bv[1] = bf_hi(b4.x); bv[2] = bf_lo(b4.y); bv[3] = bf_hi(b4.y); bv[4] = bf_lo(b4.z); bv[5] = bf_hi(b4.z); bv[6] = bf_lo(b4.w); bv[7] = bf_hi(b4.w);
        } else {
            const v4u w4 = *(const GAS v4u*)(FOUR + ((size_t)b * SEQ + 2048) * DF + g * 128 + jl * 8);
            av[0] = bf_lo(w4.x); av[1] = bf_hi(w4.x); av[2] = bf_lo(w4.y); av[3] = bf_hi(w4.y); av[4] = bf_lo(w4.z); av[5] = bf_hi(w4.z); av[6] = bf_lo(w4.w); av[7] = bf_hi(w4.w);
            for (int nb = 0; nb < 32; ++nb) { const float* p = misc + MS_ALT + ((size_t)b * 32 + nb) * 512 + g * 64 + jl * 8; const f32x4 p0 = *(const f32x4*)p, p1 = *(const f32x4*)(p + 4);
                av[0] += p0[0]; av[1] += p0[1]; av[2] += p0[2]; av[3] += p0[3]; av[4] += p1[0]; av[5] += p1[1]; av[6] += p1[2]; av[7] += p1[3]; }
#pragma unroll
            for (int i = 0; i < 8; ++i) bv[i] = 0.f;
        }
        float y0[8], y1[8]; float ss = 0.f;
#pragma unroll
        for (int i = 0; i < 8; ++i) { y0[i] = av[i] + sg * bv[i]; y1[i] = av[i] - sg * bv[i]; }
        if (jl == 0) { y0[0] = av[0]; y1[0] = misc[MS_NYQ + (size_t)(b * 8 + g) * P64_LD + kp]; }
#pragma unroll
        for (int i = 0; i < 8; ++i) ss += y0[i] * y0[i] + y1[i] * y1[i];
        const float r = 1.0f / sqrtf(wave_sum(ss) * (1.0f / DF) + EPS);
#pragma unroll
        for (int i = 0; i < 8; ++i) { const int mp = jl * 8 + i, m0 = mp, m1 = (mp == 0) ? 64 : 128 - mp;
            rowbuf[g * 128 + m0] = (bf16)f2bf(y0[i] * r * gf[g * 128 + m0]); rowbuf[g * 128 + m1] = (bf16)f2bf(y1[i] * r * gf[g * 128 + m1]); }
        LDS_WAIT(); asm volatile("" ::: "memory");
        { const v4u q0 = *(const LAS v4u*)(rowbuf + lane * 16), q1 = *(const LAS v4u*)(rowbuf + lane * 16 + 8);
          GAS v4u* dst = (GAS v4u*)(YMIX + (size_t)t * D + DL + lane * 16); dst[0] = q0; dst[1] = q1; }
        LDS_WAIT(); asm volatile("" ::: "memory");
    }
}
}
namespace mk {
struct SchedTiles {      static constexpr bool DSTPF = false;
    const char* Abase; const char* Bbase; int nM, nN, G, c; unsigned lda_b, ldb_b;
    __device__ __forceinline__ bool next(int i, pg8::Unit& u) {
        const int L = i * G + c; if (L >= nM * nN) return false;
        int pm, pn; tile_order(L, nM, nN, pm, pn);
        u.pm = pm; u.pn = pn; u.aux0 = 0; u.aux1 = 0; u.nt = 0; u.a = Abase + (size_t)pm * 256 * lda_b; u.b = Bbase + (size_t)pn * 256 * ldb_b; return true;
    }
};
struct EpiBf16 {
    static __device__ __forceinline__ int a_row(int h, int R) { return 128 * h + R; }
    bf16* O; int ldc;
    __device__ __forceinline__ void operator()(f32x4 (&acc)[2][2][4][2], const pg8::Unit& u, int wr, int wc, int fr, int fq, LAS unsigned char*) const {
        const int row0 = u.pm * 256 + wr * 64 + fr, col0 = u.pn * 256 + wc * 32 + 8 * fq;
#pragma unroll
        for (int ai = 0; ai < 2; ++ai)
#pragma unroll
            for (int m = 0; m < 4; ++m) { const unsigned off = ((unsigned)(row0 + ai * 128 + m * 16) * (unsigned)ldc + col0) * 2u;
#pragma unroll
                for (int bj = 0; bj < 2; ++bj) { const f32x4 v0 = acc[ai][bj][m][0], v1 = acc[ai][bj][m][1];
                    v4u w; w.x = cvt_pk_bf16(v0[0], v0[1]); w.y = cvt_pk_bf16(v0[2], v0[3]); w.z = cvt_pk_bf16(v1[0], v1[1]); w.w = cvt_pk_bf16(v1[2], v1[3]);
                    *(GAS v4u*)((GAS char*)O + off + bj * 256) = w; } }
    }
};

constexpr int P8_BPITCH = 264;
__device__ __forceinline__ void p8_ln_router(const Args& A, LAS unsigned char* lds, int tid, int lane, int wave, int vcu, int G) {
    const float* mod = (const float*)(A.ws + WS_MOD); const bf16* MIX = (const bf16*)(A.ws + WS_MIX);
    bf16* H2HI = (bf16*)(A.ws + WS_H2HI); bf16* H2LO = (bf16*)(A.ws + WS_H2LO); unsigned* H2F8 = (unsigned*)(A.ws + WS_H2F8); const bf16* WR = (const bf16*)(A.ws + WS_WR);
    int* cnt = (int*)(A.ws + WS_CTL) + CW_CNT; int* rt_tok = (int*)(A.ws + WS_ROUTE + RT_TOK); int* rt_dst = (int*)(A.ws + WS_ROUTE + RT_DST); float* rt_w = (float*)(A.ws + WS_ROUTE + RT_W);
    LAS bf16* bl = (LAS bf16*)lds;
    LAS float* lg = (LAS float*)(lds + 2 * 64 * P8_BPITCH * 2) + wave * (16 * 65);
    { const int gw = vcu * NWAVES + wave, NGW = G * NWAVES;
      for (int i = gw * 64 + lane; i < T; i += NGW * 64) { const int s = i / TS, tl = i % TS; rt_tok[((size_t)s * NEX + NE) * TS + tl] = tl; rt_dst[((size_t)s * NEX + NE) * TS + tl] = tl * 9 + 8; } }
    for (int tb = vcu; tb < T / 128; tb += G) {
        const int t0 = tb * 128 + wave * 16;
        LAS f32x4* pv = (LAS f32x4*)lds;
        {   const int b = (tb * 128) / SEQ; __syncthreads();
            const f32x4* s0 = (const f32x4*)(mod + (size_t)b * MODW + 2 * D); const f32x4* s1 = (const f32x4*)A.in[17]; const f32x4* s2 = (const f32x4*)A.in[18];
            const f32x4* s3 = (const f32x4*)(mod + (size_t)b * MODW + 3 * D); const f32x4* s4 = (const f32x4*)(mod + (size_t)b * MODW + 4 * D);
            pv[tid] = s0[tid]; pv[512 + tid] = s1[tid]; pv[1024 + tid] = s2[tid]; pv[1536 + tid] = s3[tid]; pv[2048 + tid] = s4[tid];
            __syncthreads(); }
#ifndef P8_REP
#define P8_REP 1
#endif
        f32x4 lacc[4]; const int arow = lane & 15, akq = lane >> 4;
        for (int rep8 = 0; rep8 < P8_REP; ++rep8) {
        for (int i = 0; i < 16; i += 2) {
            asm volatile("" ::: "memory");
            const int t = t0 + i;
            const GAS f32x4* xr = (const GAS f32x4*)(A.in[0] + (size_t)t * D) + lane; const GAS v2u* mr = (const GAS v2u*)(MIX + (size_t)t * D) + lane;
            const LAS f32x4* g1 = pv + lane;
            f32x4 v[8], u[8]; float s = 0.f, q = 0.f;
#pragma unroll
            for (int j = 0; j < 8; ++j) { const f32x4 xv = __builtin_nontemporal_load(xr + 64 * j), xw = __builtin_nontemporal_load(xr + 64 * j + 512), gv = g1[64 * j]; const v2u mv = __builtin_nontemporal_load(mr + 64 * j), mw = __builtin_nontemporal_load(mr + 64 * j + 512);
                v[j] = xv * ALPHA + gv * (f32x4){bf_lo(mv.x), bf_hi(mv.x), bf_lo(mv.y), bf_hi(mv.y)}; s += (v[j].x + v[j].y) + (v[j].z + v[j].w);
                u[j] = xw * ALPHA + gv * (f32x4){bf_lo(mw.x), bf_hi(mw.x), bf_lo(mw.y), bf_hi(mw.y)}; q += (u[j].x + u[j].y) + (u[j].z + u[j].w); }
            float mean = wave_sum(s) * (1.f / D), meanu = wave_sum(q) * (1.f / D), s2 = 0.f, q2 = 0.f;
#pragma unroll
            for (int j = 0; j < 8; ++j) { v[j] = v[j] - mean; u[j] = u[j] - meanu; s2 += (v[j].x * v[j].x + v[j].y * v[j].y) + (v[j].z * v[j].z + v[j].w * v[j].w); q2 += (u[j].x * u[j].x + u[j].y * u[j].y) + (u[j].z * u[j].z + u[j].w * u[j].w); }
            float rstd = 1.f / sqrtf(wave_sum(s2) * (1.f / D) + EPS), rstdu = 1.f / sqrtf(wave_sum(q2) * (1.f / D) + EPS);
            const LAS f32x4* lg1 = pv + 512 + lane; const LAS f32x4* lb1 = pv + 1024 + lane; GAS f32x4* xo = (GAS f32x4*)(A.out + (size_t)t * D) + lane;
            s = 0.f; q = 0.f;
#pragma unroll
            for (int j = 0; j < 8; ++j) { const f32x4 lg = lg1[64 * j], lb = lb1[64 * j]; v[j] = v[j] * rstd * lg + lb; u[j] = u[j] * rstdu * lg + lb; xo[64 * j] = v[j]; xo[64 * j + 512] = u[j];
                s += (v[j].x + v[j].y) + (v[j].z + v[j].w); q += (u[j].x + u[j].y) + (u[j].z + u[j].w); }
            mean = wave_sum(s) * (1.f / D); meanu = wave_sum(q) * (1.f / D); s2 = 0.f; q2 = 0.f;
#pragma unroll
            for (int j = 0; j < 8; ++j) { v[j] = v[j] - mean; u[j] = u[j] - meanu; s2 += (v[j].x * v[j].x + v[j].y * v[j].y) + (v[j].z * v[j].z + v[j].w * v[j].w); q2 += (u[j].x * u[j].x + u[j].y * u[j].y) + (u[j].z * u[j].z + u[j].w * u[j].w); }
            rstd = 1.f / sqrtf(wave_sum(s2) * (1.f / D) + EPS); rstdu = 1.f / sqrtf(wave_sum(q2) * (1.f / D) + EPS);
            const LAS f32x4* sh2 = pv + 1536 + lane; const LAS f32x4* sc2 = pv + 2048 + lane;
#pragma unroll
            for (int tt = 0; tt < 2; ++tt) {
                GAS v2u* oh = (GAS v2u*)(H2HI + (size_t)(t + tt) * D) + lane; GAS v2u* ol = (GAS v2u*)(H2LO + (size_t)(t + tt) * D) + lane; GAS unsigned* o8 = (GAS unsigned*)(H2F8 + (size_t)(t + tt) * (D / 4)) + lane;
#pragma unroll
                for (int j = 0; j < 8; ++j) { const f32x4 y = (tt ? u[j] * rstdu : v[j] * rstd) * (sc2[64 * j] + 1.0f) + sh2[64 * j];
                    const unsigned h0 = f2bf(y.x), h1 = f2bf(y.y), h2_ = f2bf(y.z), h3 = f2bf(y.w);
                    v2u o; o.x = h0 | (h1 << 16); o.y = h2_ | (h3 << 16); oh[64 * j] = o; o8[64 * j] = pk4_fp8(y.x, y.y, y.z, y.w);
                    o.x = pk2(y.x - __builtin_bit_cast(float, h0 << 16), y.y - __builtin_bit_cast(float, h1 << 16)); o.y = pk2(y.z - __builtin_bit_cast(float, h2_ << 16), y.w - __builtin_bit_cast(float, h3 << 16)); ol[64 * j] = o; }
            }
        }
        VM_WAIT();
#pragma unroll
        for (int n = 0; n < 4; ++n) lacc[n] = (f32x4){0.f, 0.f, 0.f, 0.f};
        for (int kc = 0; kc < 8; ++kc) {
            __syncthreads();
#pragma unroll
            for (int q = 0; q < 8; ++q) { const int p = q * NTHR + tid, rowi = p >> 5, piece = p & 31;
                const v4u w = *(const GAS v4u*)(WR + (size_t)rowi * D + kc * 256 + piece * 8);
                *(LAS v4u*)(bl + rowi * P8_BPITCH + piece * 8) = w; }
            __syncthreads();
#pragma unroll 2
            for (int ks = 0; ks < 8; ++ks) {
                const size_t aoff = (size_t)(t0 + arow) * D + kc * 256 + ks * 32 + akq * 8;
                const bf16x8 ah = *(const GAS bf16x8*)(H2HI + aoff), al = *(const GAS bf16x8*)(H2LO + aoff);
#pragma unroll
                for (int n = 0; n < 4; ++n) {
                    const bf16x8 bh = *(const LAS bf16x8*)(bl + (n * 16 + arow) * P8_BPITCH + ks * 32 + akq * 8);
                    const bf16x8 blo = *(const LAS bf16x8*)(bl + (64 + n * 16 + arow) * P8_BPITCH + ks * 32 + akq * 8);
                    lacc[n] = __builtin_amdgcn_mfma_f32_16x16x32_bf16(ah, bh, lacc[n], 0, 0, 0);
                    lacc[n] = __builtin_amdgcn_mfma_f32_16x16x32_bf16(al, bh, lacc[n], 0, 0, 0);
                    lacc[n] = __builtin_amdgcn_mfma_f32_16x16x32_bf16(ah, blo, lacc[n], 0, 0, 0);
                }
            }
        }
        }
#pragma unroll
        for (int n = 0; n < 4; ++n)
#pragma unroll
            for (int r = 0; r < 4; ++r) lg[(4 * akq + r) * 65 + 16 * n + arow] = lacc[n][r];
        LDS_WAIT(); asm volatile("" ::: "memory");
        const float rb = A.in[20][lane];
        for (int i = 0; i < 16; ++i) {
            const int t = t0 + i, sl = t / TS, tl = t % TS;
            const float z = lg[i * 65 + lane]; const float sc = 1.0f / (1.0f + expf(-z)); const float sel = sc + rb;
            float m1 = sel; m1 = fmaxf(m1, __shfl_xor(m1, 1)); m1 = fmaxf(m1, __shfl_xor(m1, 2)); m1 = fmaxf(m1, __shfl_xor(m1, 4));
            const unsigned long long eq = __ballot(sel == m1); const unsigned grp = (unsigned)(eq >> (lane & ~7)) & 0xffu; const int first = __builtin_ctz(grp | 0x100u);
            float m2 = ((lane & 7) == first) ? -1e30f : sel; m2 = fmaxf(m2, __shfl_xor(m2, 1)); m2 = fmaxf(m2, __shfl_xor(m2, 2)); m2 = fmaxf(m2, __shfl_xor(m2, 4));
            const float gs = m1 + m2; const int g = lane >> 3;
            int grank = 0;
#pragma unroll
            for (int q = 0; q < 8; ++q) { const float o = __shfl(gs, q * 8); grank += (o > gs || (o == gs && q < g)) ? 1 : 0; }
            const bool allowed = grank < 4;
            const float msel = allowed ? sel : -1e30f;
            int rank = 0;
            for (int q = 0; q < 64; ++q) { const float o = __shfl(msel, q); rank += (o > msel || (o == msel && q < lane)) ? 1 : 0; }
            const bool chosen = allowed && rank < 8;
            const unsigned long long cm = __ballot(chosen);
            const float wsum = wave_sum(chosen ? sc : 0.f);
            if (chosen) {
                const int j = __builtin_popcountll(cm & ((1ull << lane) - 1ull));
                const int pos = atomicAdd(&cnt[sl * 64 + lane], 1);
                rt_tok[((size_t)sl * NEX + lane) * TS + pos] = tl; rt_dst[((size_t)sl * NEX + lane) * TS + pos] = tl * 9 + j;
                rt_w[(size_t)t * 8 + j] = 2.5f * sc / (wsum + 1e-20f);
            }
        }
    }
}

struct MoeTab { LAS int* ucum; LAS int* segoff; LAS int* cnt; LAS int* idbuf; LAS int* myexp; };
__device__ __forceinline__ MoeTab moe_tab(LAS unsigned char* lds) { MoeTab m; m.ucum = (LAS int*)(lds + SCR_OFF); m.segoff = m.ucum + 72; m.cnt = m.segoff + 72; m.idbuf = m.cnt + 72; m.myexp = m.idbuf + 768; return m; }
__device__ __forceinline__ void moe_tables(const Args& A, LAS unsigned char* lds, int s, int ctiles, int tid, int G, int c) {
    MoeTab m = moe_tab(lds); const int* cnt = (const int*)(A.ws + WS_CTL) + CW_CNT + s * 64;
    __syncthreads();
    if (tid < 64) m.cnt[tid] = __hip_atomic_load(cnt + tid, RLX_AGENT);
    if (tid == 64) m.cnt[64] = TS;
    __syncthreads();
    if (tid == 0) { int u = 0, r = 0; for (int e = 0; e < NEX; ++e) { m.ucum[e] = u; m.segoff[e] = r; const int tl = (m.cnt[e] + 255) >> 8; u += tl * ctiles; r += tl * 256; } m.ucum[NEX] = u; }
    __syncthreads();
    if (tid < 256) { const int L = tid * G + c; int e = -1; if (L < m.ucum[NEX]) { e = 0; for (int q = 1; q < NEX; ++q) e += (m.ucum[q] <= L) ? 1 : 0; } m.myexp[tid] = e; }
    __syncthreads();
}
template <bool DSTPF_> struct SchedMoe {
    static constexpr bool DSTPF = DSTPF_;
    const int* dsts;
    MoeTab tb; const char* Abase; const char* Bbase; const int* lists; int G, c, ctiles; unsigned a_pitch, bexp_bytes, btile_bytes; bool gather;
    __device__ __forceinline__ bool next(int i, pg8::Unit& u) {
        if (i >= 256) return false; const int e = tb.myexp[i]; if (e < 0) return false; const int L = i * G + c;
        const int r = L - tb.ucum[e], rt = r / ctiles, ct = r % ctiles;
        u.pm = rt; u.pn = ct | ((i % 3) << 8); u.aux0 = e; u.aux1 = tb.segoff[e] + rt * 256; u.nt = 0;
        u.a = gather ? Abase : Abase + (size_t)u.aux1 * a_pitch; u.b = Bbase + (size_t)e * bexp_bytes + (size_t)ct * btile_bytes; return true;
    }
    __device__ __forceinline__ unsigned row_off_global(const pg8::Unit& u, int row) const {
        const int n = tb.cnt[u.aux0]; int idx = u.pm * 256 + row; idx = idx < n ? idx : n - 1;
        return (unsigned)lists[(size_t)u.aux0 * TS + idx] * a_pitch;
    }
    __device__ __forceinline__ void prefetch_rows(const pg8::Unit& u, int ui, LAS unsigned char* lds, int wid, int lane) const {
        if (wid < 4) { const int n = tb.cnt[u.aux0]; int idx = u.pm * 256 + wid * 64 + lane; idx = idx < n ? idx : n - 1;
            __builtin_amdgcn_global_load_lds((const unsigned*)(lists + (size_t)u.aux0 * TS + idx), (LAS unsigned*)(tb.idbuf + (ui & 1) * 256 + wid * 64), 4, 0, 0); }
    }
    __device__ __forceinline__ void prefetch_dst(const pg8::Unit& u, int ui, int wid, int lane) const {
        if (wid < 4) { const int n = tb.cnt[u.aux0]; int idx = u.pm * 256 + wid * 64 + lane; idx = idx < n ? idx : n - 1;
            __builtin_amdgcn_global_load_lds((const unsigned*)(dsts + (size_t)u.aux0 * TS + idx), (LAS unsigned*)(tb.idbuf + (ui % 3) * 256 + wid * 64), 4, 0, 0); }
    }
    __device__ __forceinline__ unsigned row_off_lds(int ui, int row, LAS unsigned char*) const { return (unsigned)tb.idbuf[(ui & 1) * 256 + row] * a_pitch; }
};
struct EpiGU {
    static __device__ __forceinline__ int a_row(int h, int R) { return 128 * h + R; }
    unsigned char* ACT; bool dry;
    __device__ __forceinline__ void operator()(f32x4 (&acc)[2][2][4][2], const pg8::Unit& u, int wr, int wc, int fr, int fq, LAS unsigned char*) const {
        if (dry) { float s = 0.f;
#pragma unroll
            for (int ai = 0; ai < 2; ++ai)
#pragma unroll
                for (int bj = 0; bj < 2; ++bj)
#pragma unroll
                    for (int m = 0; m < 4; ++m)
#pragma unroll
                        for (int n2 = 0; n2 < 2; ++n2) s += acc[ai][bj][m][n2][0] + acc[ai][bj][m][n2][1] + acc[ai][bj][m][n2][2] + acc[ai][bj][m][n2][3];
            if (s == 1.2345e-30f) ACT[0] = 0; return; }
        const int row0 = u.aux1 + wr * 64 + fr, col0 = (u.pn & 255) * 128 + wc * 32 + 8 * fq;
#pragma unroll
        for (int ai = 0; ai < 2; ++ai)
#pragma unroll
            for (int m = 0; m < 4; ++m) { const unsigned off = (unsigned)(row0 + ai * 128 + m * 16) * DE + col0;
                f32x4 a0, a1;
#pragma unroll
                for (int e = 0; e < 4; ++e) { a0[e] = silu_f(acc[ai][0][m][0][e]) * acc[ai][1][m][0][e]; a1[e] = silu_f(acc[ai][0][m][1][e]) * acc[ai][1][m][1][e]; }
                v2u w; w.x = pk4_fp8(a0[0], a0[1], a0[2], a0[3]); w.y = pk4_fp8(a1[0], a1[1], a1[2], a1[3]);
                *(GAS v2u*)((GAS char*)ACT + off) = w; }
    }
};
struct EpiDN {
    static __device__ __forceinline__ int a_row(int h, int R) { return 128 * h + R; }
    unsigned char* OUTTOK; LAS int* idbuf; LAS int* cnt; bool dry;
    __device__ __forceinline__ void operator()(f32x4 (&acc)[2][2][4][2], const pg8::Unit& u, int wr, int wc, int fr, int fq, LAS unsigned char*) const {
        if (dry) { float s = 0.f;
#pragma unroll
            for (int ai = 0; ai < 2; ++ai)
#pragma unroll
                for (int bj = 0; bj < 2; ++bj)
#pragma unroll
                    for (int m = 0; m < 4; ++m)
#pragma unroll
                        for (int n2 = 0; n2 < 2; ++n2) s += acc[ai][bj][m][n2][0] + acc[ai][bj][m][n2][1] + acc[ai][bj][m][n2][2] + acc[ai][bj][m][n2][3];
            if (s == 1.2345e-30f) OUTTOK[0] = 0; return; }
        int tz = threadIdx.x; asm volatile("" : "+v"(tz)); fr = tz & 15; fq = (tz >> 4) & 3;
        const int n = cnt[u.aux0], rl0 = u.pm * 256 + wr * 64 + fr, col0 = (u.pn & 255) * 256 + wc * 64 + 16 * fq;
        const LAS int* dl = idbuf + (u.pn >> 8) * 256 - u.pm * 256;
#pragma unroll
        for (int ai = 0; ai < 2; ++ai)
#pragma unroll
            for (int m = 0; m < 4; ++m) { const int rl = rl0 + ai * 128 + m * 16;
                if (rl < n) { const unsigned off = (unsigned)dl[rl] * D + col0;
                    const f32x4 v0 = acc[ai][0][m][0] * 16.f, v1 = acc[ai][0][m][1] * 16.f, v2 = acc[ai][1][m][0] * 16.f, v3 = acc[ai][1][m][1] * 16.f;
                    v4u w; w.x = pk4_fp8(v0[0], v0[1], v0[2], v0[3]); w.y = pk4_fp8(v1[0], v1[1], v1[2], v1[3]); w.z = pk4_fp8(v2[0], v2[1], v2[2], v2[3]); w.w = pk4_fp8(v3[0], v3[1], v3[2], v3[3]);
                    *(GAS v4u*)((GAS char*)OUTTOK + off) = w; } }
    }
};
__device__ __forceinline__ void moe_combine(const Args& A, LAS unsigned char* lds, int s, int tid, int lane, int wave, int vcu, int G, float* wout) {
    const int gw = vcu * NWAVES + wave, NGW = G * NWAVES;
    const float* mod = (const float*)(A.ws + WS_MOD); const unsigned char* OT = A.ws + WS_OUTTOK; const float* rt_w = (const float*)(A.ws + WS_ROUTE + RT_W);
    LAS f32x4* pv = (LAS f32x4*)lds;
    for (int tb = vcu; tb < TS / 128; tb += G) {
      { const int b = (s * TS + tb * 128) / SEQ; __syncthreads();
        pv[tid] = ((const f32x4*)(mod + (size_t)b * MODW + 5 * D))[tid]; pv[512 + tid] = ((const f32x4*)A.in[27])[tid]; pv[1024 + tid] = ((const f32x4*)A.in[28])[tid];
        __syncthreads(); }
      for (int i = 0; i < 16; ++i) {
        asm volatile("" ::: "memory");
        const int tl = tb * 128 + wave * 16 + i, t = s * TS + tl;
        const GAS f32x4* xo = (const GAS f32x4*)(A.out + (size_t)t * D) + 4 * lane; GAS f32x4* yo = (GAS f32x4*)(wout + (size_t)t * D) + 4 * lane;
        const LAS f32x4* g2 = pv + 4 * lane;
        const GAS v4u* rows = (const GAS v4u*)(OT + (size_t)tl * 9 * D) + lane;
        float w[8];
        { const f32x4 w0 = *(const GAS f32x4*)(rt_w + (size_t)t * 8), w1 = *(const GAS f32x4*)(rt_w + (size_t)t * 8 + 4); w[0] = w0[0]; w[1] = w0[1]; w[2] = w0[2]; w[3] = w0[3]; w[4] = w1[0]; w[5] = w1[1]; w[6] = w1[2]; w[7] = w1[3]; }
        v4u q[9][2];
#pragma unroll
        for (int k = 0; k < 9; ++k)
#pragma unroll
            for (int j = 0; j < 2; ++j) q[k][j] = __builtin_nontemporal_load(rows + k * 128 + 64 * j);
        f32x4 f[8]; float sm = 0.f;
#pragma unroll
        for (int j = 0; j < 2; ++j) {
            f32x4 a[4];
            a[0] = fp8x4_to_f32(q[8][j].x); a[1] = fp8x4_to_f32(q[8][j].y); a[2] = fp8x4_to_f32(q[8][j].z); a[3] = fp8x4_to_f32(q[8][j].w);
#pragma unroll
            for (int k = 0; k < 8; ++k) { a[0] = a[0] + w[k] * fp8x4_to_f32(q[k][j].x); a[1] = a[1] + w[k] * fp8x4_to_f32(q[k][j].y); a[2] = a[2] + w[k] * fp8x4_to_f32(q[k][j].z); a[3] = a[3] + w[k] * fp8x4_to_f32(q[k][j].w); }
#pragma unroll
            for (int i = 0; i < 4; ++i) { const f32x4 y = xo[256 * j + i] * ALPHA + g2[256 * j + i] * (a[i] * 0.0625f); f[4 * j + i] = y; sm += (y.x + y.y) + (y.z + y.w); }
        }
        const float mean = wave_sum(sm) * (1.f / D); float s2 = 0.f;
#pragma unroll
        for (int j = 0; j < 8; ++j) { f[j] = f[j] - mean; s2 += (f[j].x * f[j].x + f[j].y * f[j].y) + (f[j].z * f[j].z + f[j].w * f[j].w); }
        const float rstd = 1.f / sqrtf(wave_sum(s2) * (1.f / D) + EPS);
        const LAS f32x4* lg2 = pv + 512 + 4 * lane; const LAS f32x4* lb2 = pv + 1024 + 4 * lane;
#pragma unroll
        for (int j = 0; j < 2; ++j)
#pragma unroll
            for (int i = 0; i < 4; ++i) yo[256 * j + i] = f[4 * j + i] * rstd * lg2[256 * j + i] + lb2[256 * j + i];
      }
    }
}
}
namespace mk {
#ifndef GU_DRY
#define GU_DRY 0
#endif
#ifndef DN_DRY
#define DN_DRY 0
#endif
#ifndef DBL_MASK
#define DBL_MASK 0
#endif
#define REPS(k) for (int rep_ = 0; rep_ < (((DBL_MASK) >> (k)) & 1) + 1; ++rep_)
#ifndef MK_LAST_PHASE
#define MK_LAST_PHASE 2
#endif
__global__ void __launch_bounds__(NTHR, 2) mk_fwd(Args args) {
    extern __shared__ __attribute__((aligned(16))) unsigned char lds_raw[];
    LAS unsigned char* lds = (LAS unsigned char*)lds_raw;
    volatile LAS unsigned* MISC = (volatile LAS unsigned*)(lds + LDSCTL_OFF);
    const int tid = threadIdx.x, lane = tid & 63, wave = __builtin_amdgcn_readfirstlane(tid >> 6);
    const int G = gridDim.x; const int bx = blockIdx.x; const int vcu = (G % 8 == 0) ? (bx % 8) * (G / 8) + bx / 8 : bx;
    unsigned* ctl = (unsigned*)(args.ws + WS_CTL);
    for (int u = tid; u < (LDS_BYTES - LDSCTL_OFF) / 4; u += NTHR) ((LAS unsigned*)(lds + LDSCTL_OFF))[u] = 0u;
    __syncthreads();
    XcdBarrier bar = xcd_barrier_post(ctl + CW_BAR + args.li * XCD_BAR_WORDS, MISC + 8);
    const int lo = args.ph_lo, hi = args.ph_hi;
#define IN(k) (lo <= (k) && (k) < hi)
#define BOTH(k) (IN(k) && IN((k) + 1))
#define GRID_BAR() xcd_barrier(bar)
#define OPQ() int tq = threadIdx.x; asm volatile("" : "+v"(tq)); const int tidq = tq, laneq = tq & 63

    if (IN(0)) { REPS(0) { OPQ(); p0_adaln(args, lds, tidq, G); p0_fold(args, lds, tidq, G); p0_weights(args, lds, tidq, laneq, wave, vcu, G); } if (BOTH(0)) GRID_BAR(); }
    if (IN(1)) { REPS(1) { OPQ(); p1_hnorm(args, laneq, wave, vcu, G); } if (BOTH(1)) GRID_BAR(); }
    if (IN(2)) { REPS(2) {
        SchedInproj S{(const char*)(args.ws + WS_H), (const char*)(args.ws + WS_WIN), G, bx};
        static_assert(WS_GATE == WS_U + (size_t)TT * DL * 2 && WS_FOUR == WS_GATE + (size_t)T * DL * 2, "U|GATE|FOUR contiguous");
        EpiInproj E{(bf16*)(args.ws + WS_U), (bf16*)(args.ws + WS_UPART)};
        pg8::gemm_phase<EpiInproj, SchedInproj, true, false>(lds, D / 64, D * 2, D * 2, S, E); }
        if (BOTH(2)) GRID_BAR();
    }
#ifndef SKIP_P3
    if (IN(3)) { REPS(3) { OPQ(); p3_conv(args, laneq, wave, vcu, G); p3_fold(args, lds, laneq, wave, vcu, G); } if (BOTH(3)) GRID_BAR(); }
#endif
    if (IN(4)) { REPS(4) {
#ifndef SKIP_DFT
        { SchedDft S{(const char*)(args.ws + WS_CS), (const char*)(args.ws + WS_PQT), G, vcu}; EpiDft E{(bf16*)(args.ws + WS_AB)};
          pg8::gemm_phase<EpiDft, SchedDft, true, false>(lds, 2048 / 64, 4096, 4096, S, E); }
#endif
#ifndef SKIP_LRU
        { SchedGates S{(const char*)(args.ws + WS_UC), (const char*)(args.ws + WS_WG4), G, vcu};
          EpiLru E{(const bf16*)(args.ws + WS_UC), args.in[10], args.in[12], (bf16*)(args.ws + WS_S), (bf16*)(args.ws + WS_PF), (bf16*)(args.ws + WS_PB), (float*)(args.ws + WS_MISC)};
          pg8::gemm_phase<EpiLru, SchedGates, false, false>(lds, 256 / 64, DL * 2, 512, S, E); }
#endif
        }
        if (BOTH(4)) GRID_BAR();
    }
#ifndef SKIP_P5
    if (IN(5)) { REPS(5) { OPQ(); p5a_fix(args, lds, tidq, laneq, wave, vcu, G); } if (BOTH(5)) GRID_BAR(); }
    if (IN(6)) { REPS(6) { OPQ(); p5b_four(args, lds, laneq, wave, vcu, G); } if (BOTH(6)) GRID_BAR(); }
#endif
#ifndef SKIP_P7
    if (IN(7)) { REPS(7) {
        SchedTiles S{(const char*)(args.ws + WS_YMIX), (const char*)(args.ws + WS_WOUT), T / 256, D / 256, G, bx, D * 2, D * 2};
        EpiBf16 E{(bf16*)(args.ws + WS_MIX), D};
        pg8::gemm_phase<EpiBf16, SchedTiles, true, false>(lds, D / 64, D * 2, D * 2, S, E); }
        if (BOTH(7)) GRID_BAR();
    }
#endif
#ifndef SKIP_P8
    if (IN(8)) { OPQ(); p8_ln_router(args, lds, tidq, laneq, wave, vcu, G); if (BOTH(8)) GRID_BAR(); }
#endif
#pragma unroll
    for (int s = 0; s < NSLICE; ++s) {
        const int p0 = 9 + 3 * s;
#ifndef SKIP_GU
        if (IN(p0)) { REPS(9) {
            { OPQ(); moe_tables(args, lds, s, 4, tidq, G, vcu); }
            SchedMoe<false> S{nullptr, moe_tab(lds), (const char*)(args.ws + WS_H2F8) + (size_t)s * TS * D, (const char*)(args.ws + WS_WGU), (const int*)(args.ws + WS_ROUTE + RT_TOK) + (size_t)s * NEX * TS, G, vcu, 4, (unsigned)D, 1024u * D, 256u * D, true};
            EpiGU E{args.ws + WS_ACT, (GU_DRY) && rep_ == 0};
            pg8::gemm_phase<EpiGU, SchedMoe<false>, true, true, true, 0x79797979>(lds, D / 128, D, D, S, E); }
            if (BOTH(p0)) GRID_BAR();
        }
#endif
#ifndef SKIP_DN
        if (IN(p0 + 1)) { REPS(10) {
            { OPQ(); moe_tables(args, lds, s, 8, tidq, G, vcu); }
            SchedMoe<true> S{(const int*)(args.ws + WS_ROUTE + RT_DST) + (size_t)s * NEX * TS, moe_tab(lds), (const char*)(args.ws + WS_ACT), (const char*)(args.ws + WS_WD), nullptr, G, vcu, 8, (unsigned)DE, 2048u * DE, 256u * DE, false};
            EpiDN E{args.ws + WS_OUTTOK, moe_tab(lds).idbuf, moe_tab(lds).cnt, (DN_DRY) && rep_ == 0};
            pg8::gemm_phase<EpiDN, SchedMoe<true>, true, false, true, 0x79797979>(lds, DE / 128, DE, DE, S, E); }
            if (BOTH(p0 + 1)) GRID_BAR();
        }
#endif
#ifndef SKIP_CB
        if (IN(p0 + 2)) { REPS(11) { OPQ(); moe_combine(args, lds, s, tidq, laneq, wave, vcu, G, (((DBL_MASK >> 11) & 1) && rep_ == 0) ? (float*)(args.ws + WS_UC) - (size_t)s * TS * D : args.out); } if (BOTH(p0 + 2)) GRID_BAR(); }
#endif
    }
#undef IN
#undef BOTH
}
}
static int g_grid = 0;
static void mk_launch(void* const* d_in, void* d_out, void* d_ws, hipStream_t stream, int lo, int hi, int li) {
    if (g_grid == 0) {
        int dev = 0, cus = 0; hipGetDevice(&dev); hipDeviceGetAttribute(&cus, hipDeviceAttributeMultiprocessorCount, dev);
        if (hipFuncSetAttribute((const void*)mk::mk_fwd, hipFuncAttributeMaxDynamicSharedMemorySize, mk::LDS_BYTES) != hipSuccess) { fprintf(stderr, "hipFuncSetAttribute failed\n"); g_grid = -1; return; }
        int per_cu = 0; (void)hipOccupancyMaxActiveBlocksPerMultiprocessor(&per_cu, (const void*)mk::mk_fwd, mk::NTHR, mk::LDS_BYTES); (void)hipGetLastError();
        if (per_cu < 1) fprintf(stderr, "occupancy query says %d\n", per_cu);
        g_grid = cus > 0 ? cus : 256;
    }
    if (g_grid < 0) return;
    mk::Args a{}; for (int i = 0; i < 29; ++i) a.in[i] = (const float*)d_in[i];
    a.out = (float*)d_out; a.ws = (unsigned char*)d_ws; a.ph_lo = lo; a.ph_hi = hi; a.li = li; a.pad = 0;
    hipLaunchKernelGGL(mk::mk_fwd, dim3(g_grid), dim3(mk::NTHR), mk::LDS_BYTES, stream, a);
}
extern "C" void kernel_launch(void* const* d_in, const int* in_sizes, int n_in, void* d_out, int out_size, void* d_ws, size_t ws_size, hipStream_t stream) {
    if (ws_size < mk::WS_END) { fprintf(stderr, "workspace too small\n"); return; }
    (void)hipMemsetAsync((unsigned char*)d_ws + mk::WS_CTL, 0, mk::CTL_ZERO_BYTES, stream);
    constexpr int NPH = 9 + 3 * mk::NSLICE;
#if MK_SPLIT
    for (int p = 0; p < NPH; ++p) mk_launch(d_in, d_out, d_ws, stream, p, p + 1, 0);
#else
    mk_launch(d_in, d_out, d_ws, stream, 0, NPH, 0);
#endif
}
```

```cpp
#include <hip/hip_runtime.h>
#include <cstdio>
#include <cstdint>
#define MK_SPLIT 0
#define GAS __attribute__((address_space(1)))
#define LAS __attribute__((address_space(3)))
namespace mk {
constexpr int D = 2048, NB = 8, SEQ = 4096, T = NB * SEQ, CTX = 256, TC = NB * CTX, TT = T + TC;
constexpr int DL = 1024, DF = 1024, DIN = 3072, NE = 64, NEX = 65, DE = 512;
constexpr int MODW = 6 * D;
constexpr float ALPHA = 1.189207115002721f, EPS = 1e-6f, PI2 = 6.283185307179586f;
constexpr int NWAVES = 8, NTHR = 512;
constexpr int NSLICE = 1, TS = T / NSLICE;
constexpr int SLOT_ROWS = TS * 8 + NE * 256 + TS;

typedef unsigned short bf16;
typedef unsigned v4u __attribute__((ext_vector_type(4)));
typedef unsigned v2u __attribute__((ext_vector_type(2)));
typedef float f32x4 __attribute__((ext_vector_type(4)));
typedef float f32x2 __attribute__((ext_vector_type(2)));
typedef short bf16x8 __attribute__((ext_vector_type(8)));
typedef int v8i __attribute__((ext_vector_type(8)));
typedef int v4i __attribute__((ext_vector_type(4)));

constexpr size_t MiB = 1u << 20;
constexpr size_t WS_CTL = 0, CTL_ZERO_BYTES = 1 * MiB;
constexpr size_t WS_MOD = 1 * MiB;
constexpr size_t WS_MISC = 2 * MiB;
constexpr size_t WS_WIN = 10 * MiB;
constexpr size_t WS_WOUT = 22 * MiB;
constexpr size_t WS_WG4 = 30 * MiB;
constexpr size_t WS_WR = 32 * MiB;
constexpr size_t WS_CS = 34 * MiB;
constexpr size_t WS_WGU = 50 * MiB;
constexpr size_t WS_WD = 180 * MiB;
constexpr size_t WS_DYN = 245 * MiB;
constexpr size_t WS_H = WS_DYN;
constexpr size_t WS_PF = WS_DYN, WS_PB = WS_DYN + 64 * MiB;
constexpr size_t WS_MIX = WS_DYN;
constexpr size_t WS_U = WS_DYN + 136 * MiB;
constexpr size_t WS_GATE = WS_U + 68 * MiB;
constexpr size_t WS_FOUR = WS_GATE + 64 * MiB;
constexpr size_t WS_UC = WS_FOUR + 64 * MiB;
constexpr size_t WS_S = WS_UC + 68 * MiB;
constexpr size_t WS_UPART = WS_S;
constexpr size_t WS_YMIX = WS_S + 64 * MiB;
constexpr float YMIX_SCALE = 8.0f, H_SCALE = 16.0f;
constexpr size_t WS_PQT = WS_YMIX + 128 * MiB;
constexpr size_t WS_AB = WS_PQT + 32 * MiB;
constexpr size_t WS_END_MIXER = WS_AB + 32 * MiB;
constexpr size_t WS_H2HI = WS_YMIX;
constexpr size_t WS_H2LO = WS_U;
constexpr size_t WS_OUTTOK = WS_DYN;
constexpr size_t OUTTOK_BYTES = (size_t)TS * 9 * D;
constexpr size_t WS_ACT = WS_OUTTOK + OUTTOK_BYTES;
constexpr size_t ACT_BYTES = (size_t)SLOT_ROWS * DE;
constexpr size_t WS_H2F8 = WS_OUTTOK + 736 * MiB;
constexpr size_t WS_ROUTE = WS_H2F8 + 64 * MiB;
constexpr size_t WS_END = WS_ROUTE + 24 * MiB;
static_assert(WS_H2F8 >= WS_END_MIXER, "H2F8 clear of the mixer buffers");
static_assert(WS_ACT + ACT_BYTES <= WS_H2F8, "MoE overlay map");
static_assert(WS_END <= 1150 * MiB, "workspace budget");
constexpr size_t RT_TOK = 0;
constexpr size_t RT_DST = RT_TOK + (size_t)NSLICE * NEX * TS * 4;
constexpr size_t RT_W = RT_DST + (size_t)NSLICE * NEX * TS * 4;
static_assert(RT_W + (size_t)T * 8 * 4 <= 24 * MiB, "routing tables");
constexpr int MS_SUMA = 0;
constexpr int NSUB = SEQ / 128;
constexpr int MS_SUMB = MS_SUMA + (TT / 128) * 2 * DL;
constexpr int MS_P64 = MS_SUMB + (TT / 128) * 2 * DL;
constexpr int P64_LD = 2112;
constexpr int MS_ALT = MS_P64 + NB * 8 * P64_LD;
constexpr int MS_NYQ = MS_ALT + NB * 32 * 512;
constexpr int MS_SP = MS_NYQ + NB * 8 * P64_LD;
constexpr int MS_GB = MS_SP + 2 * DL;
constexpr int MS_P64B = MS_GB + 4 * DL;
constexpr int MS_END = MS_P64B + 64 * 1024;
static_assert((size_t)MS_END * 4 <= 8 * MiB, "MISC region");
constexpr int CW_TMO = 0, CW_CODE = 1, CW_BAR = 4096, CW_CNT = 8192;

constexpr int RING_BYTES = 131072, LDSCTL_OFF = RING_BYTES, SCR_OFF = LDSCTL_OFF + 512, LDS_BYTES = 147456;

#define RLX_AGENT __ATOMIC_RELAXED, __HIP_MEMORY_SCOPE_AGENT
#define LDS_WAIT() asm volatile("s_waitcnt lgkmcnt(0)" ::: "memory")
#define VM_WAIT() asm volatile("s_waitcnt vmcnt(0)" ::: "memory")
__device__ __forceinline__ unsigned f2bf(float f) { unsigned u = __builtin_bit_cast(unsigned, f); return (u + 0x7fffu + ((u >> 16) & 1u)) >> 16; }
__device__ __forceinline__ unsigned pk2(float lo, float hi) { return f2bf(lo) | (f2bf(hi) << 16); }
__device__ __forceinline__ unsigned cvt_pk_bf16(float lo, float hi) { unsigned r; asm volatile("v_cvt_pk_bf16_f32 %0, %1, %2" : "=v"(r) : "v"(lo), "v"(hi)); return r; }
__device__ __forceinline__ unsigned pk4_fp8(float a, float b, float c, float d) {
    a = __builtin_amdgcn_fmed3f(a, -448.f, 448.f); b = __builtin_amdgcn_fmed3f(b, -448.f, 448.f); c = __builtin_amdgcn_fmed3f(c, -448.f, 448.f); d = __builtin_amdgcn_fmed3f(d, -448.f, 448.f);
    int r = __builtin_amdgcn_cvt_pk_fp8_f32(a, b, 0, false); r = __builtin_amdgcn_cvt_pk_fp8_f32(c, d, r, true); return (unsigned)r; }
__device__ __forceinline__ f32x4 fp8x4_to_f32(unsigned w) { const f32x2 lo = __builtin_amdgcn_cvt_pk_f32_fp8((int)w, false), hi = __builtin_amdgcn_cvt_pk_f32_fp8((int)w, true); return (f32x4){lo.x, lo.y, hi.x, hi.y}; }
__device__ __forceinline__ unsigned fp8x2_to_bf16x2(unsigned w, bool hiword) {
    unsigned long long r;
    if (hiword) asm volatile("v_cvt_pk_f32_fp8_sdwa %0, %1 src0_sel:WORD_1" : "=&v"(r) : "v"(w));
    else        asm volatile("v_cvt_pk_f32_fp8_e32 %0, %1" : "=&v"(r) : "v"(w));
    unsigned lo = (unsigned)r, hi = (unsigned)(r >> 32);
    asm volatile("" : "+v"(lo), "+v"(hi));
    return __builtin_amdgcn_perm(hi, lo, 0x07060302u);
}
__device__ __forceinline__ float bf_lo(unsigned w) { return __builtin_bit_cast(float, w << 16); }
__device__ __forceinline__ float bf_hi(unsigned w) { return __builtin_bit_cast(float, w & 0xffff0000u); }
__device__ __forceinline__ float bf2f(bf16 h) { return __builtin_bit_cast(float, (unsigned)h << 16); }
template <int CTRL> __device__ __forceinline__ float dppx(float v) {
    return __builtin_bit_cast(float, __builtin_amdgcn_update_dpp(0, __builtin_bit_cast(int, v), CTRL, 0xF, 0xF, true));
}
__device__ __forceinline__ float wave_sum(float v) {
    v += dppx<0xB1>(v);
    v += dppx<0x4E>(v);
    v += dppx<0x141>(v);
    v += dppx<0x140>(v);
    const int iv = __builtin_bit_cast(int, v);
    const float r0 = __builtin_bit_cast(float, __builtin_amdgcn_readlane(iv, 0)), r1 = __builtin_bit_cast(float, __builtin_amdgcn_readlane(iv, 16));
    const float r2 = __builtin_bit_cast(float, __builtin_amdgcn_readlane(iv, 32)), r3 = __builtin_bit_cast(float, __builtin_amdgcn_readlane(iv, 48));
    return (r0 + r1) + (r2 + r3);
}
__device__ __forceinline__ float group8_max(float v) {
    v = fmaxf(v, dppx<0xB1>(v)); v = fmaxf(v, dppx<0x4E>(v)); v = fmaxf(v, dppx<0x141>(v)); return v;
}
__device__ __forceinline__ float sigmoid_f(float x) { return __builtin_amdgcn_rcpf(1.0f + __expf(-x)); }
__device__ __forceinline__ float silu_f(float x) { return x * sigmoid_f(x); }
__device__ __forceinline__ float gelu_tanh_f(float x) { const float u = 0.7978845608028654f * (x + 0.044715f * x * x * x); const float e = __expf(2.0f * u); const float th = 1.0f - 2.0f * __builtin_amdgcn_rcpf(e + 1.0f); return 0.5f * x * (1.0f + th); }

#define XB_TMO      128
#define XB_XCNT(j)  (256  + 64 * (j))
#define XB_XSUB(j)  (1280 + 64 * (j))
#define XB_XGEN(j)  (2304 + 64 * (j))
#define XB_TOP      3328
#define XB_TOPGEN   3392
#define XCD_BAR_WORDS 3456
#define XB_SPIN_CAP (1u << 18)
__device__ __forceinline__ unsigned xb_ld(unsigned* p)              { return __hip_atomic_load(p, __ATOMIC_RELAXED, __HIP_MEMORY_SCOPE_AGENT); }
__device__ __forceinline__ unsigned xb_add(unsigned* p, unsigned v) { return __hip_atomic_fetch_add(p, v, __ATOMIC_RELAXED, __HIP_MEMORY_SCOPE_AGENT); }
__device__ __forceinline__ unsigned xb_xcc_id() { return (unsigned)__builtin_amdgcn_s_getreg((3 << 11) | 20) & 0xFu; }
#define XB_SPIN(cond, bar) do { unsigned _sp = 0; while (cond) { __builtin_amdgcn_s_sleep(1); \
    if ((++_sp & 255u) == 0u) { if (xb_ld(&(bar)[XB_TMO])) break; if (_sp > XB_SPIN_CAP) { atomicAdd(&(bar)[XB_TMO], 1u); break; } } } } while (0)
struct XcdBarrier { unsigned* bar; unsigned x; volatile LAS unsigned* st; };
__device__ __forceinline__ XcdBarrier xcd_barrier_post(unsigned* bar, volatile LAS unsigned* st) {
    XcdBarrier b; b.bar = bar; b.x = xb_xcc_id(); b.st = st;
    if (threadIdx.x == 0) (void)xb_add(&bar[XB_XCNT(b.x)], 1u);
    return b;
}
__device__ __forceinline__ void xcd_barrier_complete(unsigned* bar, unsigned x, unsigned& nloc, unsigned& nx) {
    const unsigned G = gridDim.x * gridDim.y * gridDim.z;
    unsigned sum, cnt, mine, sp = 0u;
    for (;;) {
        sum = 0u; cnt = 0u; mine = 0u;
#pragma unroll
        for (unsigned j = 0; j < 16; ++j) { const unsigned c = xb_ld(&bar[XB_XCNT(j)]); sum += c; cnt += (c > 0u) ? 1u : 0u; mine = (j == x) ? c : mine; }
        if (sum == G) break;
        __builtin_amdgcn_s_sleep(1);
        if ((++sp & 255u) == 0u) { if (xb_ld(&bar[XB_TMO])) break; if (sp > XB_SPIN_CAP) { atomicAdd(&bar[XB_TMO], 1u); break; } }
    }
    nloc = mine > 0u ? mine : 1u; nx = cnt > 0u ? cnt : 1u;
}
__device__ __forceinline__ void xcd_barrier(const XcdBarrier& b) {
    asm volatile("s_waitcnt vmcnt(0)" ::: "memory");
    __syncthreads();
    if (threadIdx.x == 0) {
        unsigned* bar = b.bar;
        __builtin_amdgcn_s_waitcnt(0);
        unsigned nloc = b.st[0], nx = b.st[1];
        if (nloc == 0u) { xcd_barrier_complete(bar, b.x, nloc, nx); b.st[0] = nloc; b.st[1] = nx; }
        const unsigned old = xb_add(&bar[XB_XSUB(b.x)], 1u);
        const unsigned gen = old / nloc;
        if (old + 1u == (gen + 1u) * nloc) {
            __builtin_amdgcn_fence(__ATOMIC_RELEASE, "agent");
            asm volatile("s_waitcnt vmcnt(0)" ::: "memory");
            const unsigned og = xb_add(&bar[XB_TOP], 1u);
            const unsigned tg = og / nx;
            if (og + 1u == (tg + 1u) * nx) xb_add(&bar[XB_TOPGEN], 1u);
            else XB_SPIN(xb_ld(&bar[XB_TOPGEN]) == tg, bar);
            __builtin_amdgcn_fence(__ATOMIC_ACQUIRE, "agent");
            xb_add(&bar[XB_XGEN(b.x)], 1u);
            asm volatile("s_waitcnt vmcnt(0)" ::: "memory");
        } else {
            XB_SPIN(xb_ld(&bar[XB_XGEN(b.x)]) == gen, bar);
            __builtin_amdgcn_fence(__ATOMIC_ACQUIRE, "agent");
            asm volatile("s_waitcnt vmcnt(0)" ::: "memory");
        }
    }
    __syncthreads();
}

namespace pg8 {
constexpr int BM = 256, BK = 64, HALF = 128, HTB = HALF * BK * 2, STAGE_BYTES = 8 * HTB;
__host__ __device__ __forceinline__ int lds_byte(int r, int c) { const int st = (r >> 4) * 2 + (c >> 5), rr = r & 15, cc = c & 31, ob = rr * 64 + cc * 2; return st * 1024 + (ob ^ (((ob >> 9) & 1) << 5)); }
__host__ __device__ __forceinline__ void stage_rc(int b, int& R, int& C) { const int st = b / 1024, sb = b % 1024, swz = sb ^ (((sb >> 9) & 1) << 5); R = (st >> 1) * 16 + swz / 64; C = (st & 1) * 32 + (swz % 64) / 2; }
__host__ __device__ __forceinline__ int perm_slot32(int c) { return 16 * ((c >> 2) & 1) + 4 * ((c >> 3) & 3) + (c & 3); }

__host__ __device__ __forceinline__ int perm_slot256(int c) { return 128 * ((c >> 3) & 1) + 32 * (c >> 6) + 16 * ((c >> 2) & 1) + 4 * ((c >> 4) & 3) + (c & 3); }
template <int N> struct IntC { static constexpr int value = N; };
struct Unit { const char* a; const char* b; int pm, pn, aux0, aux1, nt; };

template <class Epi, class Sched, bool ALIGN_EPI, bool GATHER, bool F8 = false, int SCW = 0x7f7f7f7f>
__device__ __forceinline__ void gemm_phase(LAS unsigned char* lds, const int nt_, const unsigned lda_b, const unsigned ldb_b, Sched& S, const Epi& E) {
    int nt = nt_; asm volatile("" : "+s"(nt));
    int tid_ = threadIdx.x; asm volatile("" : "+v"(tid_));
    const int tid = tid_, wid = __builtin_amdgcn_readfirstlane(tid >> 6), lane = tid & 63, wr = wid >> 2, wc = wid & 3, fr = lane & 15, fq = lane >> 4;
    unsigned voffA[2][2], voffB[2][2], cbyte[2]; int Rr[2];
#pragma unroll
    for (int i = 0; i < 2; ++i) { int R, C; stage_rc(tid * 16 + i * 8192, R, C); Rr[i] = R; cbyte[i] = (unsigned)C * 2u;
#pragma unroll
        for (int h = 0; h < 2; ++h) { voffB[h][i] = (unsigned)(R + HALF * h) * ldb_b + (unsigned)C * 2u; voffA[h][i] = (unsigned)Epi::a_row(h, R) * lda_b + (unsigned)C * 2u; } }
    const unsigned ldsw = (unsigned)wid * 1024u;
    const int aoff = lds_byte(wr * 64 + fr, fq * 8), boff = lds_byte(wc * 32 + fr, fq * 8);
#define PG8_SA(b, h) (((b) * 2 + (h)) * HTB)
#define PG8_SB(b, h) ((4 + (b) * 2 + (h)) * HTB)
#define PG8_STAGE(bufoff, gbase, voff) do { _Pragma("unroll") for (int _i = 0; _i < 2; ++_i) \
        __builtin_amdgcn_global_load_lds((const unsigned*)((const char*)(gbase) + (voff)[_i]), (LAS unsigned*)(lds + (bufoff) + ldsw + _i * 8192), 16, 0, 0); } while (0)
#define PG8_LDA(dst, b, h) do { _Pragma("unroll") for (int m = 0; m < 4; ++m) _Pragma("unroll") for (int k = 0; k < 2; ++k) dst[m][k] = *(const LAS v4i*)(lds + PG8_SA(b, h) + aoff + m * 2048 + k * 1024); } while (0)
#define PG8_LDB(dst, b, h) do { _Pragma("unroll") for (int n = 0; n < 2; ++n) _Pragma("unroll") for (int k = 0; k < 2; ++k) dst[n][k] = *(const LAS v4i*)(lds + PG8_SB(b, h) + boff + n * 2048 + k * 1024); } while (0)
#define PG8_CAT(x) __builtin_shufflevector((x)[0], (x)[1], 0, 1, 2, 3, 4, 5, 6, 7)
#define PG8_MMA(ai, bj, At, Bt) do { __builtin_amdgcn_s_setprio(1); _Pragma("unroll") for (int m = 0; m < 4; ++m) _Pragma("unroll") for (int n = 0; n < 2; ++n) { \
        if constexpr (F8) { const v8i b8_ = PG8_CAT(Bt[n]), a8_ = PG8_CAT(At[m]);   \
            asm volatile("v_mfma_scale_f32_16x16x128_f8f6f4 %0, %1, %2, %0, %3, %4 op_sel_hi:[0,0,0]" : "+v"(acc[ai][bj][m][n]) : "v"(b8_), "v"(a8_), "v"(scw_), "v"(sca_)); } \
        else { _Pragma("unroll") for (int k = 0; k < 2; ++k) acc[ai][bj][m][n] = __builtin_amdgcn_mfma_f32_16x16x32_bf16(__builtin_bit_cast(bf16x8, Bt[n][k]), __builtin_bit_cast(bf16x8, At[m][k]), acc[ai][bj][m][n], 0, 0, 0); } } \
        __builtin_amdgcn_s_setprio(0); } while (0)
#define PG8_WAIT_V(n) asm volatile("s_waitcnt vmcnt(" #n ")" ::: "memory")
#define PG8_WAIT_VN(n) asm volatile("s_waitcnt vmcnt(%0)" :: "n"(n) : "memory")
#define PG8_WAIT_RLX(rlx, n) asm volatile("s_cmp_lg_u32 %0, 0\n\ts_cbranch_scc1 .Lrx%=\n\ts_waitcnt vmcnt(8)\n.Lrx%=:\n\ts_waitcnt vmcnt(%1)" :: "s"(rlx), "n"(n) : "scc", "memory")
#define PG8_WAIT_L(n) asm volatile("s_waitcnt lgkmcnt(" #n ")" ::: "memory")
#define PG8_BAR __builtin_amdgcn_s_barrier()
#define PG8_SCHED __builtin_amdgcn_sched_barrier(0)
    int scw_ = SCW, sca_ = 0x7f7f7f7f; asm volatile("" : "+v"(scw_), "+v"(sca_));
    Unit cur, nxt; int ui = 0;
    if (!S.next(0, cur)) return;
    f32x4 acc[2][2][4][2];
#pragma unroll
    for (int a = 0; a < 2; ++a)
#pragma unroll
        for (int b = 0; b < 2; ++b)
#pragma unroll
            for (int m = 0; m < 4; ++m)
#pragma unroll
                for (int n = 0; n < 2; ++n) acc[a][b][m][n] = (f32x4){0.f, 0.f, 0.f, 0.f};
    v4i At[4][2], B0[2][2], B1[2][2];
    const char* cA = cur.a; const char* cB = cur.b;
    if constexpr (Sched::DSTPF) S.prefetch_dst(cur, 0, wid, lane);
    if constexpr (GATHER) {
#pragma unroll
        for (int h = 0; h < 2; ++h)
#pragma unroll
            for (int i = 0; i < 2; ++i) voffA[h][i] = S.row_off_global(cur, HALF * h + Rr[i]) + cbyte[i];
    }
    PG8_STAGE(PG8_SB(0, 0), cB, voffB[0]); PG8_STAGE(PG8_SB(0, 1), cB, voffB[1]); PG8_STAGE(PG8_SA(0, 0), cA, voffA[0]); PG8_STAGE(PG8_SA(0, 1), cA, voffA[1]);
    if (wr == 1) PG8_BAR;
    PG8_WAIT_V(2); PG8_BAR;
    PG8_STAGE(PG8_SB(1, 0), cB + 128, voffB[0]); PG8_STAGE(PG8_SA(1, 0), cA + 128, voffA[0]); PG8_STAGE(PG8_SB(1, 1), cB + 128, voffB[1]);
    PG8_WAIT_V(6); PG8_BAR;
    for (;;) {
        const bool has_next = S.next(ui + 1, nxt);
        const char* nA = has_next ? nxt.a : cA; const char* nB = has_next ? nxt.b : cB;
        if constexpr (GATHER) { if (has_next) S.prefetch_rows(nxt, ui + 1, lds, wid, lane); }
        if constexpr (Sched::DSTPF) { if (has_next) S.prefetch_dst(nxt, ui + 1, wid, lane); }
        const int ntu = (cur.nt > 0) ? cur.nt : nt;
        asm volatile(".p2align 8" ::: "memory");
        for (int t = 0; t < ntu; t += 2) {
            const bool rlx = (Epi::NST > 0) && t == 0 && ui > 0;
            int rlxs = 0; if constexpr (!F8 && Epi::NST > 0) { rlxs = __builtin_amdgcn_readfirstlane(rlx ? 1 : 0); asm volatile("" : "+s"(rlxs)); }
            const bool last = (t == ntu - 2);
            const char* a1 = cA + (size_t)(t + 1) * 128;
            const char* a2 = last ? nA : cA + (size_t)(t + 2) * 128; const char* b2 = last ? nB : cB + (size_t)(t + 2) * 128;
            const char* a3 = a2 + 128; const char* b3 = b2 + 128;
            unsigned oa[2][2];
#pragma unroll
            for (int h = 0; h < 2; ++h)
#pragma unroll
                for (int i = 0; i < 2; ++i) oa[h][i] = voffA[h][i];
            if constexpr (GATHER) { if (last && has_next) {
#pragma unroll
                for (int h = 0; h < 2; ++h)
#pragma unroll
                    for (int i = 0; i < 2; ++i) oa[h][i] = S.row_off_lds(ui + 1, HALF * h + Rr[i], lds) + cbyte[i]; } }
            PG8_LDB(B0, 0, 0); PG8_LDB(B1, 0, 1); PG8_SCHED; PG8_LDA(At, 0, 0); PG8_STAGE(PG8_SA(1, 1), a1, voffA[1]);
            if constexpr (F8) { if (rlx) PG8_WAIT_VN(8 + Epi::NST); else PG8_WAIT_V(8); } else if constexpr (Epi::NST > 0) PG8_WAIT_RLX(rlxs, 8 + Epi::NST); else PG8_WAIT_V(8); PG8_WAIT_L(0); PG8_BAR; PG8_MMA(0, 0, At, B0); PG8_MMA(0, 1, At, B1); PG8_BAR; PG8_SCHED;
            PG8_LDA(At, 0, 1); PG8_STAGE(PG8_SB(0, 0), b2, voffB[0]); PG8_STAGE(PG8_SB(0, 1), b2, voffB[1]); PG8_STAGE(PG8_SA(0, 0), a2, oa[0]);
            if constexpr (F8) { if (rlx) PG8_WAIT_VN(8 + Epi::NST); else PG8_WAIT_V(8); } else if constexpr (Epi::NST > 0) PG8_WAIT_RLX(rlxs, 8 + Epi::NST); else PG8_WAIT_V(8); PG8_WAIT_L(0); PG8_BAR; PG8_MMA(1, 0, At, B0); PG8_MMA(1, 1, At, B1); PG8_BAR; PG8_SCHED;
            PG8_LDB(B0, 1, 0); PG8_LDB(B1, 1, 1); PG8_SCHED; PG8_LDA(At, 1, 0); PG8_STAGE(PG8_SA(0, 1), a2, oa[1]);
            PG8_WAIT_V(8); PG8_WAIT_L(0); PG8_BAR; PG8_MMA(0, 0, At, B0); PG8_MMA(0, 1, At, B1); PG8_BAR; PG8_SCHED;
            PG8_LDA(At, 1, 1); PG8_STAGE(PG8_SB(1, 0), b3, voffB[0]); PG8_STAGE(PG8_SB(1, 1), b3, voffB[1]); PG8_STAGE(PG8_SA(1, 0), a3, oa[0]);
            PG8_WAIT_V(8); PG8_WAIT_L(0); PG8_BAR; PG8_MMA(1, 0, At, B0); PG8_MMA(1, 1, At, B1); PG8_BAR; PG8_SCHED;
            if constexpr (GATHER) { if (last) {
#pragma unroll
                for (int h = 0; h < 2; ++h)
#pragma unroll
                    for (int i = 0; i < 2; ++i) voffA[h][i] = oa[h][i]; } }
        }
        if constexpr (ALIGN_EPI) { if (wr == 0) PG8_BAR; }
        if constexpr (F8) asm volatile("s_nop 15\n\ts_nop 15" ::: "memory");
        E(acc, cur, wr, wc, fr, fq, lds);
        if (!has_next) break;
#pragma unroll
        for (int a = 0; a < 2; ++a)
#pragma unroll
            for (int b = 0; b < 2; ++b)
#pragma unroll
                for (int m = 0; m < 4; ++m)
#pragma unroll
                    for (int n = 0; n < 2; ++n) acc[a][b][m][n] = (f32x4){0.f, 0.f, 0.f, 0.f};
        cur = nxt; cA = nA; cB = nB; ++ui;
        if constexpr (ALIGN_EPI) { if (wr == 1) PG8_BAR; }
    }
    PG8_WAIT_V(0);
    if constexpr (!ALIGN_EPI) { if (wr == 0) PG8_BAR; }
    PG8_BAR;
#undef PG8_SA
#undef PG8_SB
#undef PG8_STAGE
#undef PG8_LDA
#undef PG8_LDB
#undef PG8_MMA
#undef PG8_CAT
#undef PG8_WAIT_V
#undef PG8_WAIT_VN
#undef PG8_WAIT_RLX
#undef PG8_WAIT_L
#undef PG8_BAR
#undef PG8_SCHED
}
}
}
namespace mk {
struct Args { const float* in[29]; float* out; unsigned char* ws; int ph_lo, ph_hi, li, pad; };
static_assert(sizeof(Args) == 31 * 8 + 16, "Args has no padding");

__device__ __forceinline__ void tile_order(int L, int nM, int nN, int& pm, int& pn) {
    const int nwg = nM * nN; int wgid = L;
    { const int q = nwg / 8, r = nwg % 8, xcd = wgid % 8, off = wgid / 8; wgid = (xcd < r ? xcd * (q + 1) : r * (q + 1) + (xcd - r) * q) + off; }
    const int nig = 8 * nN, gid = wgid / nig, fm = gid * 8, gsz = (nM - fm) < 8 ? (nM - fm) : 8;
    pm = fm + ((wgid % nig) % gsz); pn = (wgid % nig) / gsz;
}

__device__ __forceinline__ void p0_adaln(const Args& A, LAS unsigned char* lds, int tid, int G) {
    LAS float* st = (LAS float*)lds;
    const float* c = A.in[1]; const float* cc = A.in[3]; const float* w = A.in[4]; const float* bias = A.in[5];
    float* mod = (float*)(A.ws + WS_MOD);
    const int cg = tid % 12, kg = tid / 12;
    __syncthreads();
    for (int cb = blockIdx.x; cb < 256; cb += G) {
        for (int i = tid; i < 9 * D; i += NTHR) { const float v = (i < 8 * D) ? c[i] : cc[i - 8 * D]; st[i] = v / (1.0f + __expf(-v)); }
        __syncthreads();
        float acc[9][4];
#pragma unroll
        for (int r = 0; r < 9; ++r)
#pragma unroll
            for (int j = 0; j < 4; ++j) acc[r][j] = 0.f;
        const int col0 = cb * 48 + cg * 4;
        if (kg < 42) {
            for (int k = kg; k < D; k += 42) {
                const f32x4 wv = *(const f32x4*)(w + (size_t)k * MODW + col0);
#pragma unroll
                for (int r = 0; r < 9; ++r) { const float s = st[r * D + k];
#pragma unroll
                    for (int j = 0; j < 4; ++j) acc[r][j] += s * wv[j]; }
            }
        }
        __syncthreads();
        if (kg < 42) {
#pragma unroll
            for (int r = 0; r < 9; ++r)
#pragma unroll
                for (int j = 0; j < 4; ++j) st[(kg * 12 + cg) * 36 + r * 4 + j] = acc[r][j];
        }
        __syncthreads();
        if (tid < 432) { const int ocg = tid / 36, rj = tid % 36, r = rj >> 2, j = rj & 3; float s = 0.f;
            for (int q = 0; q < 42; ++q) s += st[(q * 12 + ocg) * 36 + rj];
            const int col = cb * 48 + ocg * 4 + j; mod[(size_t)r * MODW + col] = s + bias[col]; }
        __syncthreads();
    }
}

__device__ __forceinline__ void tr_item(const float* W, int ldw, int k0, int n0, bf16* WT, size_t dst_row0, int ldk, bool perm, LAS float* scr, int lane) {
#pragma unroll 8
    for (int i = 0; i < 32; ++i) { const int kk = 2 * i + (lane >> 5); scr[kk * 33 + (lane & 31)] = W[(size_t)(k0 + kk) * ldw + n0 + (lane & 31)]; }
    LDS_WAIT(); asm volatile("" ::: "memory");
    const int c = lane & 7;
#pragma unroll
    for (int j = 0; j < 4; ++j) { const int n = (lane >> 3) + 8 * j; const LAS float* s = scr + (8 * c) * 33 + n;
        v4u o; o.x = pk2(s[0 * 33], s[1 * 33]); o.y = pk2(s[2 * 33], s[3 * 33]); o.z = pk2(s[4 * 33], s[5 * 33]); o.w = pk2(s[6 * 33], s[7 * 33]);
        const int slot = perm ? pg8::perm_slot32(n) : n;
        *(GAS v4u*)(WT + (dst_row0 + slot) * (size_t)ldk + k0 + 8 * c) = o; }
    LDS_WAIT(); asm volatile("" ::: "memory");
}
__device__ __forceinline__ void tr_item_f8(const float* W, int ldw, int k0, int n0, unsigned char* WT, size_t dst_row0, int ldk, int mode256, LAS float* scr, int lane, const float mul = 64.f) {
#pragma unroll 8
    for (int i = 0; i < 32; ++i) { const int kk = 2 * i + (lane >> 5); scr[kk * 33 + (lane & 31)] = __builtin_nontemporal_load(W + (size_t)(k0 + kk) * ldw + n0 + (lane & 31)); }
    LDS_WAIT(); asm volatile("" ::: "memory");
    const int c = lane & 7;
#pragma unroll
    for (int j = 0; j < 4; ++j) { const int n = (lane >> 3) + 8 * j; const LAS float* s = scr + (8 * c) * 33 + n;
        v2u o; o.x = pk4_fp8(s[0 * 33] * mul, s[1 * 33] * mul, s[2 * 33] * mul, s[3 * 33] * mul); o.y = pk4_fp8(s[4 * 33] * mul, s[5 * 33] * mul, s[6 * 33] * mul, s[7 * 33] * mul);
        const int slot = mode256 ? pg8::perm_slot256((n0 & 255) + n) : pg8::perm_slot32(n);
        *(GAS v2u*)(WT + (dst_row0 + slot) * (size_t)ldk + k0 + 8 * c) = o; }
    LDS_WAIT(); asm volatile("" ::: "memory");
}
__device__ __forceinline__ void tr_item_hilo(const float* W, int ldw, int k0, int n0, bf16* WT, int ldk, LAS float* scr, int lane) {
#pragma unroll 8
    for (int i = 0; i < 32; ++i) { const int kk = 2 * i + (lane >> 5); scr[kk * 33 + (lane & 31)] = W[(size_t)(k0 + kk) * ldw + n0 + (lane & 31)]; }
    LDS_WAIT(); asm volatile("" ::: "memory");
    const int c = lane & 7;
#pragma unroll
    for (int j = 0; j < 4; ++j) { const int n = (lane >> 3) + 8 * j; const LAS float* s = scr + (8 * c) * 33 + n;
        float v[8]; unsigned hb[8], lb[8];
#pragma unroll
        for (int q = 0; q < 8; ++q) { v[q] = s[q * 33]; hb[q] = f2bf(v[q]); lb[q] = f2bf(v[q] - __builtin_bit_cast(float, hb[q] << 16)); }
        v4u oh, ol; oh.x = hb[0] | (hb[1] << 16); oh.y = hb[2] | (hb[3] << 16); oh.z = hb[4] | (hb[5] << 16); oh.w = hb[6] | (hb[7] << 16);
        ol.x = lb[0] | (lb[1] << 16); ol.y = lb[2] | (lb[3] << 16); ol.z = lb[4] | (lb[5] << 16); ol.w = lb[6] | (lb[7] << 16);
        *(GAS v4u*)(WT + (size_t)(n0 + n) * ldk + k0 + 8 * c) = oh;
        *(GAS v4u*)(WT + (size_t)(NE + n0 + n) * ldk + k0 + 8 * c) = ol; }
    LDS_WAIT(); asm volatile("" ::: "memory");
}

template <int PART = 7>
__device__ __forceinline__ void p0_weights(const Args& A, LAS unsigned char* lds, int tid, int lane, int wave, int vcu, int G) {
    LAS float* scr = (LAS float*)(lds + wave * 16384);
    const int gw = vcu * NWAVES + wave, NGW = G * NWAVES;
    bf16* WIN = (bf16*)(A.ws + WS_WIN); bf16* WOUT = (bf16*)(A.ws + WS_WOUT); unsigned char* WGU = A.ws + WS_WGU; unsigned char* WD = A.ws + WS_WD; bf16* WR = (bf16*)(A.ws + WS_WR);
    constexpr int I_IN = 32 * 64, I_OUT = 32 * 64, I_GU = 32 * 16, I_D = 8 * 64, I_R = 32 * 2;
    constexpr int NITEMS = I_IN + I_OUT + NEX * (2 * I_GU + I_D) + I_R;
    if (PART & 3)
    for (int it = gw; it < NITEMS; it += NGW) {
        int r = it;
        if (r < I_IN) { const int kb = r / 64, nb = r % 64; tr_item_f8(A.in[6], DIN, 64 * kb, 32 * nb, (unsigned char*)WIN, (size_t)32 * nb, D, 0, scr, lane); continue; } r -= I_IN;
        if (r < I_OUT) { const int kb = r / 64, nb = r % 64; tr_item_f8(A.in[16], D, 64 * kb, 32 * nb, (unsigned char*)WOUT, (size_t)32 * nb, D, 0, scr, lane); continue; } r -= I_OUT;
        if (r < NEX * 2 * I_GU) { const int e = r / (2 * I_GU); int q = r % (2 * I_GU); const int bj = q / I_GU; q %= I_GU; const int kb = q / 16, nb = q % 16;
            const float* W = (e < NE) ? A.in[bj ? 22 : 21] + (size_t)e * D * DE : A.in[bj ? 25 : 24];
            const int n0 = 32 * nb, ct = n0 >> 7, wcg = (n0 >> 5) & 3;
            tr_item_f8(W, DE, 64 * kb, n0, WGU, (size_t)e * 1024 + ct * 256 + bj * 128 + wcg * 32, D, 0, scr, lane, bj ? -64.f * 0.6931471805599453f : -64.f * 1.4426950408889634f); continue; } r -= NEX * 2 * I_GU;
        if (r < NEX * I_D) { const int e = r / I_D, q = r % I_D, kb = q / 64, nb = q % 64;
            const float* W = (e < NE) ? A.in[23] + (size_t)e * DE * D : A.in[26];
            tr_item_f8(W, D, 64 * kb, 32 * nb, WD, (size_t)e * D + ((32 * nb) & ~255), DE, 1, scr, lane); continue; } r -= NEX * I_D;
        { const int kb = r / 2, nb = r % 2; tr_item_hilo(A.in[19], NE, 64 * kb, 32 * nb, WR, D, scr, lane); }
    }
    if (!(PART & 4)) return;
    { float* misc = (float*)(A.ws + WS_MISC); const int i = gw * 64 + lane;
      if (i < 2 * DL) { const float l = -A.in[13][i]; misc[MS_SP + i] = -8.0f * 1.4426950408889634f * ((l > 20.f) ? l : log1pf(expf(l)));
          const int d = i >> 10, ch = i & 1023; misc[MS_GB + d * 2 * DL + ch] = -1.4426950408889634f * A.in[10][i]; misc[MS_GB + d * 2 * DL + DL + ch] = -1.4426950408889634f * A.in[12][i]; } }
    {   bf16* WG4 = (bf16*)(A.ws + WS_WG4);
        for (int it = gw; it < 4 * 4 * 4 * 32; it += NGW) {
            const int k8 = it & 31, gt = (it >> 5) & 3, q = (it >> 7) & 3, h = it >> 9, cl = lane;
            const float* src = ((gt & 1) ? A.in[11] : A.in[9]) + ((size_t)(gt >> 1) * 4 + h) * 65536 + q * 64 + cl;
            float v[8];
#pragma unroll
            for (int j = 0; j < 8; ++j) v[j] = -1.4426950408889634f * src[(size_t)(k8 * 8 + j) * 256];
            const int rho = (gt >> 1) * 128 + (cl >> 4) * 32 + (gt & 1) * 16 + ((cl >> 2) & 3) * 4 + (cl & 3);
            v4u o; o.x = pk2(v[0], v[1]); o.y = pk2(v[2], v[3]); o.z = pk2(v[4], v[5]); o.w = pk2(v[6], v[7]);
            *(GAS v4u*)(WG4 + ((size_t)h * 1024 + q * 256 + rho) * 256 + k8 * 8) = o;
        }
    }
    {   bf16* CS = (bf16*)(A.ws + WS_CS);
        for (int it = gw; it < 2 * 2048 * 4; it += NGW) {
            const int nq = it & 3, k = (it >> 2) & 2047, ty = it >> 13, n0 = nq * 512 + lane * 8;
            float v[8];
#pragma unroll
            for (int j = 0; j < 8; ++j) { const float x = (float)((k * (n0 + j)) & 4095) * (1.0f / 4096.0f); v[j] = ty ? __builtin_amdgcn_sinf(x) : __builtin_amdgcn_cosf(x); }
            v4u o; o.x = pk2(v[0], v[1]); o.y = pk2(v[2], v[3]); o.z = pk2(v[4], v[5]); o.w = pk2(v[6], v[7]);
            *(GAS v4u*)(CS + ((size_t)ty * 2048 + k) * 2048 + n0) = o;
        }
    }
}
__device__ __forceinline__ void p0_fold(const Args& A, LAS unsigned char* lds, int tid, int G) {
    LAS float* wt = (LAS float*)lds;
    LAS float* tb = (LAS float*)(lds + 64 * 129 * 4);
    bf16* WIN = (bf16*)(A.ws + WS_WIN);
    const float scale = 1.0f / 724.0773439350247f;
    for (int it = blockIdx.x; it < 256; it += G) {
        const int kb = it >> 3, g = it & 7, k0 = kb * 64;
        __syncthreads();
        if (tid < 128) { tb[tid] = __builtin_amdgcn_cosf((float)tid * (1.0f / 128.0f)); tb[128 + tid] = __builtin_amdgcn_sinf((float)tid * (1.0f / 128.0f)); }
        for (int i = tid; i < 64 * 128; i += NTHR) { const int kk = i >> 7, c = i & 127; wt[kk * 129 + c] = A.in[6][(size_t)(k0 + kk) * DIN + 2 * DL + g * 128 + c]; }
        __syncthreads();
        const int j = tid & 127, kq = tid >> 7, jj = (j <= 64) ? j : j - 64; const bool isc = (j <= 64);
        float acc[16];
#pragma unroll
        for (int i = 0; i < 16; ++i) acc[i] = 0.f;
        for (int c = 0; c < 128; ++c) { const int ph = (c * jj) & 127; const float tv = isc ? tb[ph] : -tb[128 + ph];
#pragma unroll
            for (int i = 0; i < 16; ++i) acc[i] += wt[(kq * 16 + i) * 129 + c] * tv; }
        const int col = g * 128 + j, row = 2 * DL + (col & ~31) + pg8::perm_slot32(col & 31);
        const float s64 = scale * 64.f; v4u o0;
        o0.x = pk4_fp8(acc[0] * s64, acc[1] * s64, acc[2] * s64, acc[3] * s64); o0.y = pk4_fp8(acc[4] * s64, acc[5] * s64, acc[6] * s64, acc[7] * s64);
        o0.z = pk4_fp8(acc[8] * s64, acc[9] * s64, acc[10] * s64, acc[11] * s64); o0.w = pk4_fp8(acc[12] * s64, acc[13] * s64, acc[14] * s64, acc[15] * s64);
        *(GAS v4u*)((unsigned char*)WIN + (size_t)row * D + k0 + kq * 16) = o0;
    }
    __syncthreads();
}

__device__ __forceinline__ void p1_hnorm(const Args& A, int lane, int wave, int vcu, int G) {
    const int gw = vcu * NWAVES + wave, NGW = G * NWAVES;
    const float* mod = (const float*)(A.ws + WS_MOD); bf16* H = (bf16*)(A.ws + WS_H);
    for (int r0 = gw; r0 < TT; r0 += 2 * NGW) {
        const int r1 = r0 + NGW; const bool has1 = r1 < TT; const int r1c = has1 ? r1 : r0;
        const float* x0 = (r0 < T) ? A.in[0] + (size_t)r0 * D : A.in[2] + (size_t)(r0 - T) * D; const float* x1 = (r1c < T) ? A.in[0] + (size_t)r1c * D : A.in[2] + (size_t)(r1c - T) * D;
        const int b0 = (r0 < T) ? r0 / SEQ : 8, b1 = (r1c < T) ? r1c / SEQ : 8;
        const GAS f32x4* xr0 = (const GAS f32x4*)x0 + lane; const GAS f32x4* xr1 = (const GAS f32x4*)x1 + lane;
        f32x4 v[8], u[8]; float s = 0.f, q = 0.f;
#pragma unroll
        for (int j = 0; j < 8; ++j) { v[j] = __builtin_nontemporal_load(xr0 + 64 * j); u[j] = __builtin_nontemporal_load(xr1 + 64 * j); }
#pragma unroll
        for (int j = 0; j < 8; ++j) { s += (v[j].x + v[j].y) + (v[j].z + v[j].w); q += (u[j].x + u[j].y) + (u[j].z + u[j].w); }
        const float mean0 = wave_sum(s) * (1.f / D), mean1 = wave_sum(q) * (1.f / D); float s2 = 0.f, q2 = 0.f;
#pragma unroll
        for (int j = 0; j < 8; ++j) { v[j] = v[j] - mean0; u[j] = u[j] - mean1; s2 += (v[j].x * v[j].x + v[j].y * v[j].y) + (v[j].z * v[j].z + v[j].w * v[j].w); q2 += (u[j].x * u[j].x + u[j].y * u[j].y) + (u[j].z * u[j].z + u[j].w * u[j].w); }
        const float rstd0 = 1.f / sqrtf(wave_sum(s2) * (1.f / D) + EPS), rstd1 = 1.f / sqrtf(wave_sum(q2) * (1.f / D) + EPS);
        { const GAS f32x4* sh = (const GAS f32x4*)(mod + (size_t)b0 * MODW) + lane; const GAS f32x4* sc = (const GAS f32x4*)(mod + (size_t)b0 * MODW + D) + lane; GAS unsigned* o8 = (GAS unsigned*)((unsigned char*)H + (size_t)r0 * D) + lane;
#pragma unroll
          for (int j = 0; j < 8; ++j) { const f32x4 a = sh[64 * j], m = sc[64 * j]; const f32x4 y = (v[j] * rstd0 * (m + 1.0f) + a) * H_SCALE; o8[64 * j] = pk4_fp8(y.x, y.y, y.z, y.w); } }
        if (has1) { const GAS f32x4* sh = (const GAS f32x4*)(mod + (size_t)b1 * MODW) + lane; const GAS f32x4* sc = (const GAS f32x4*)(mod + (size_t)b1 * MODW + D) + lane; GAS unsigned* o8 = (GAS unsigned*)((unsigned char*)H + (size_t)r1 * D) + lane;
#pragma unroll
          for (int j = 0; j < 8; ++j) { const f32x4 a = sh[64 * j], m = sc[64 * j]; const f32x4 y = (u[j] * rstd1 * (m + 1.0f) + a) * H_SCALE; o8[64 * j] = pk4_fp8(y.x, y.y, y.z, y.w); } }
    }
}

struct SchedInproj {
    static constexpr bool DSTPF = false;
    const char* H; const char* W; int G, c;
    __device__ __forceinline__ bool next(int i, pg8::Unit& u) {
        int L = i * G + c;
        if (G == 256 && c < 128) { if (i > 6) return false; L = (i == 0) ? 1536 + c : (i - 1) * G + c; }
        if (L >= 1536 + 128) return false;
        if (L < 1536) { int pm, pn; tile_order(L, 128, 12, pm, pn);
            u.pm = pm; u.pn = pn; u.aux0 = 0; u.aux1 = 0; u.nt = 0; u.a = H + (size_t)pm * 256 * D; u.b = W + (size_t)pn * 256 * D; }
        else {
            const int x = L - 1536, tile = x >> 2, ks = x & 3, pm = 128 + (tile >> 2), pn = tile & 3;
            u.pm = pm; u.pn = pn; u.aux0 = 1 + ks; u.aux1 = 0; u.nt = 4; u.a = H + (size_t)pm * 256 * D + ks * 512; u.b = W + (size_t)pn * 256 * D + ks * 512; }
        return true;
    }
};
struct EpiInproj {
    static __device__ __forceinline__ int a_row(int h, int R) { return 128 * h + R; }
    static constexpr int NST = 16;
    bf16* U; bf16* UPART;
    __device__ __forceinline__ void operator()(const f32x4 (&acc)[2][2][4][2], const pg8::Unit& u, int wr, int wc, int fr, int fq, LAS unsigned char*) const {
        const int arr = u.pn >> 2; const size_t aoff = (arr >= 1 ? (size_t)TT * DL : 0) + (arr >= 2 ? (size_t)T * DL : 0);
        bf16* base = U + aoff;
        int rowsub = 0; if (u.aux0 > 0) { base = UPART + (size_t)(u.aux0 - 1) * TC * DL; rowsub = T; }
        const int row0 = u.pm * 256 + wr * 64 + fr - rowsub, col0 = (u.pn & 3) * 256 + wc * 32 + 8 * fq;
#pragma unroll
        for (int ai = 0; ai < 2; ++ai)
#pragma unroll
            for (int m = 0; m < 4; ++m) { bf16* rowp = base + (size_t)(row0 + ai * 128 + m * 16) * DL + col0;
#pragma unroll
                for (int bj = 0; bj < 2; ++bj) { const f32x4 v0 = acc[ai][bj][m][0], v1 = acc[ai][bj][m][1];
                    v4u w; w.x = cvt_pk_bf16(v0[0], v0[1]); w.y = cvt_pk_bf16(v0[2], v0[3]); w.z = cvt_pk_bf16(v1[0], v1[1]); w.w = cvt_pk_bf16(v1[2], v1[3]);
                    *(v4u*)(rowp + bj * 128) = w; } }
    }
};
}
namespace mk {
__device__ __forceinline__ void p3_conv(const Args& A, int lane, int wave, int vcu, int G) {
    const int gw = vcu * NWAVES + wave, NGW = G * NWAVES;
    const bf16* U = (const bf16*)(A.ws + WS_U); const bf16* UPART = (const bf16*)(A.ws + WS_UPART); bf16* UC = (bf16*)(A.ws + WS_UC);
    const float* cw = A.in[7]; const float* cb = A.in[8];
    const f32x4 z4 = (f32x4){0.f, 0.f, 0.f, 0.f};
    auto cvt = [&](v2u q) -> f32x4 { return (f32x4){bf_lo(q.x), bf_hi(q.x), bf_lo(q.y), bf_hi(q.y)}; };
    for (int it = gw; it < (TC / 4) * 4; it += NGW) {
        const int rq = it >> 2, cblk = it & 3, r0 = rq * 4, ch = cblk * 256 + lane * 4;
        const int slo = r0 & ~255, shi = slo + 256;
        const f32x4 w0 = *(const f32x4*)(cw + ch), w1 = *(const f32x4*)(cw + DL + ch), w2 = *(const f32x4*)(cw + 2 * DL + ch), w3 = *(const f32x4*)(cw + 3 * DL + ch), bb = *(const f32x4*)(cb + ch);
        f32x4 acc[7];
#pragma unroll
        for (int j = 0; j < 7; ++j) acc[j] = z4;
#pragma unroll
        for (int h = 0; h < 1; ++h) {
            v2u raw[7][4];
#pragma unroll
            for (int j = 0; j < 7; ++j) { int r = r0 - 2 + j; r = r < slo ? slo : (r >= shi ? shi - 1 : r);
#pragma unroll
                for (int ks = 0; ks < 4; ++ks) raw[j][ks] = *(const GAS v2u*)(UPART + ((size_t)(h * 4 + ks) * TC + r) * DL + ch); }
#pragma unroll
            for (int j = 0; j < 7; ++j) {
#pragma unroll
                for (int ks = 0; ks < 4; ++ks) acc[j] = acc[j] + cvt(raw[j][ks]); }
        }
#pragma unroll
        for (int j = 0; j < 7; ++j) { const int r = r0 - 2 + j; if (r < slo || r >= shi) acc[j] = z4; }
#pragma unroll
        for (int p = 0; p < 4; ++p) {
            const f32x4 y = bb + w0 * acc[p] + w1 * acc[p + 1] + w2 * acc[p + 2] + w3 * acc[p + 3];
            v2u o; o.x = pk2(y.x, y.y); o.y = pk2(y.z, y.w); *(GAS v2u*)(UC + (size_t)(T + r0 + p) * DL + ch) = o;
        }
    }
    for (int it = gw; it < (T / 64) * 4; it += NGW) {
        const int rb = it >> 2, cblk = it & 3, r0 = rb * 64, ch = cblk * 256 + lane * 4;
        const f32x4 w0 = *(const f32x4*)(cw + ch), w1 = *(const f32x4*)(cw + DL + ch), w2 = *(const f32x4*)(cw + 2 * DL + ch), w3 = *(const f32x4*)(cw + 3 * DL + ch), bb = *(const f32x4*)(cb + ch);
        const bf16* src = U + (size_t)r0 * DL + ch; bf16* dst = UC + (size_t)r0 * DL + ch;
        v2u raw[3][8];
        const v2u q0 = *(const GAS v2u*)src;
#pragma unroll
        for (int j = 0; j < 8; ++j) raw[0][j] = *(const GAS v2u*)(src + (size_t)(j + 1) * DL);
#pragma unroll
        for (int j = 0; j < 8; ++j) raw[1][j] = *(const GAS v2u*)(src + (size_t)(j + 9) * DL);
        f32x4 um2 = z4, um1 = z4, u0 = cvt(q0);
#pragma unroll
        for (int bq = 0; bq < 8; ++bq) {
            if (bq + 2 < 8) {
#pragma unroll
                for (int j = 0; j < 8; ++j) { const int r = (bq + 2) * 8 + j + 1; if (r < 64) raw[(bq + 2) % 3][j] = *(const GAS v2u*)(src + (size_t)r * DL); }
            }
#pragma unroll
            for (int j = 0; j < 8; ++j) {
                const int p = bq * 8 + j;
                const f32x4 up1 = (p < 63) ? cvt(raw[bq % 3][j]) : z4;
                const f32x4 y = bb + w0 * um2 + w1 * um1 + w2 * u0 + w3 * up1;
                v2u o; o.x = pk2(y.x, y.y); o.y = pk2(y.z, y.w); *(GAS v2u*)(dst + (size_t)p * DL) = o;
                um2 = um1; um1 = u0; u0 = up1;
            }
        }
    }
}
__device__ __forceinline__ void p3_fold(const Args& A, LAS unsigned char* lds, int lane, int wave, int vcu, int G) {
    const int gw = vcu * NWAVES + wave, NGW = G * NWAVES;
    const bf16* FOUR = (const bf16*)(A.ws + WS_FOUR); bf16* PQT = (bf16*)(A.ws + WS_PQT); float* misc = (float*)(A.ws + WS_MISC);
    LAS bf16* scr = (LAS bf16*)(lds + wave * 16384);
    const int c8 = lane & 7, rr = lane >> 3;
    for (int it = gw; it < NB * 16 * 32; it += NGW) {
        const int nb = it & 31, cblk = (it >> 5) & 15, b = it >> 9, g = cblk >> 1, half = cblk & 1, n0 = nb * 64;
        const bf16* base = FOUR + (size_t)b * SEQ * DF + g * 128 + half * 64 + c8 * 8;
#pragma unroll
        for (int s = 0; s < 8; ++s) {
            const int nn = s * 8 + rr, n = n0 + nn;
            const v4u x = *(const GAS v4u*)(base + (size_t)n * DF);
            v4u xm = (v4u){0u, 0u, 0u, 0u}; if (n >= 1) xm = *(const GAS v4u*)(base + (size_t)(SEQ - n) * DF);
            float v[8], vm[8];
            v[0] = bf_lo(x.x); v[1] = bf_hi(x.x); v[2] = bf_lo(x.y); v[3] = bf_hi(x.y); v[4] = bf_lo(x.z); v[5] = bf_hi(x.z); v[6] = bf_lo(x.w); v[7] = bf_hi(x.w);
            vm[0] = bf_lo(xm.x); vm[1] = bf_hi(xm.x); vm[2] = bf_lo(xm.y); vm[3] = bf_hi(xm.y); vm[4] = bf_lo(xm.z); vm[5] = bf_hi(xm.z); vm[6] = bf_lo(xm.w); vm[7] = bf_hi(xm.w);
#pragma unroll
            for (int j = 0; j < 8; ++j) {
                float p;
                if (half == 0) p = v[j] + vm[j];
                else if (c8 == 0 && j == 0) { const float pn = v[0] + vm[0]; misc[MS_P64 + (b * 8 + g) * P64_LD + n] = pn; ((bf16*)(misc + MS_P64B))[(b * 8 + g) * 2048 + n] = (bf16)f2bf(pn); p = 0.f; }
                else p = (n >= 1) ? v[j] - vm[j] : 0.f;
                scr[(c8 * 8 + j) * 66 + nn] = (bf16)f2bf(p);
            }
        }
        LDS_WAIT(); asm volatile("" ::: "memory");
        bf16* dst = PQT + (((size_t)b * 2 + half) * 512 + g * 64) * 2048 + n0 + c8 * 8;
#pragma unroll
        for (int s = 0; s < 8; ++s) {
            const int jj = s * 8 + rr; const LAS bf16* q = scr + jj * 66 + c8 * 8;
            const unsigned a0 = q[0] | ((unsigned)q[1] << 16), a1 = q[2] | ((unsigned)q[3] << 16), a2 = q[4] | ((unsigned)q[5] << 16), a3 = q[6] | ((unsigned)q[7] << 16);
            *(GAS v4u*)(dst + (size_t)jj * 2048) = (v4u){a0, a1, a2, a3};
            if (half == 0) {
                float ps = (bf_lo(a0) - bf_hi(a0)) + (bf_lo(a1) - bf_hi(a1)) + (bf_lo(a2) - bf_hi(a2)) + (bf_lo(a3) - bf_hi(a3));
                ps += __shfl_xor(ps, 1); ps += __shfl_xor(ps, 2); ps += __shfl_xor(ps, 4);
                if (c8 == 0) misc[MS_ALT + (b * 32 + nb) * 512 + g * 64 + jj] = ps;
            }
        }
        LDS_WAIT(); asm volatile("" ::: "memory");
    }
    if (gw < NB * 8) { const int b = gw >> 3, g = gw & 7; if (lane == 0) misc[MS_P64 + (b * 8 + g) * P64_LD + 2048] = bf2f(FOUR[((size_t)b * SEQ + 2048) * DF + g * 128 + 64]); }
}

struct SchedDft {
    static constexpr bool DSTPF = false;
    const char* CS; const char* PQT; int G, c;
    __device__ __forceinline__ bool next(int i, pg8::Unit& u) {
        const int L = i * G + c; if (L >= 256) return false;
        const int b = L >> 5, kt = (L >> 2) & 7, ct = L & 3, type = ct >> 1;
        u.pm = kt; u.pn = ct; u.aux0 = b; u.aux1 = 0; u.nt = 0;
        u.a = CS + ((size_t)type * 2048 + kt * 256) * 4096; u.b = PQT + (((size_t)b * 2 + type) * 512 + (ct & 1) * 256) * 4096; return true;
    }
};
struct EpiDft {
    static constexpr int NST = 0;
    static __device__ __forceinline__ int a_row(int h, int R) { return 128 * h + R; }
    bf16* AB;
    __device__ __forceinline__ void operator()(f32x4 (&acc)[2][2][4][2], const pg8::Unit& u, int wr, int wc, int fr, int fq, LAS unsigned char*) const {
        const int row0 = u.pm * 256 + wr * 64 + fr, col0 = u.pn * 256 + wc * 32 + 4 * fq;
        bf16* base = AB + (size_t)u.aux0 * 2048 * 1024;
#pragma unroll
        for (int ai = 0; ai < 2; ++ai)
#pragma unroll
            for (int m = 0; m < 4; ++m) { bf16* rowp = base + (size_t)(row0 + ai * 128 + m * 16) * 1024 + col0;
#pragma unroll
                for (int bj = 0; bj < 2; ++bj)
#pragma unroll
                    for (int n = 0; n < 2; ++n) { const f32x4 v = acc[ai][bj][m][n]; v2u w; w.x = cvt_pk_bf16(v[0], v[1]); w.y = cvt_pk_bf16(v[2], v[3]); *(v2u*)(rowp + bj * 128 + n * 16) = w; } }
    }
};

struct SchedGates {
    static constexpr bool DSTPF = false;
    const char* UC; const char* WG4; int G, c;
    __device__ __forceinline__ bool next(int i, pg8::Unit& u) {
        const int L = i * G + c; if (L >= (TT / 256) * 16) return false;
        const int st = L >> 4, hq = L & 15;
        u.pm = st; u.pn = hq; u.aux0 = st; u.aux1 = hq; u.nt = 0;
        u.a = UC + (size_t)st * 256 * (DL * 2) + (hq >> 2) * 512; u.b = WG4 + (size_t)hq * 256 * 512; return true;
    }
};
template <int CTRL> __device__ __forceinline__ float dpp_f(float oldv, float src) {
    return __builtin_bit_cast(float, __builtin_amdgcn_update_dpp(__builtin_bit_cast(int, oldv), __builtin_bit_cast(int, src), CTRL, 0xF, 0xF, false));
}
template <int DIR, int DIST> __device__ __forceinline__ void scan_step(float& a, float& b) {
    const float ap = dpp_f<(DIR ? 0x100 : 0x110) + DIST>(1.0f, a), bp = dpp_f<(DIR ? 0x100 : 0x110) + DIST>(0.0f, b);
    b = a * bp + b; a = ap * a;
}
struct EpiLru {
    static constexpr int NST = 14;
    static __device__ __forceinline__ int a_row(int h, int R) { return 128 * (R >> 6) + 8 * (R & 15) + 4 * h + ((R >> 4) & 3); }
    const bf16* UC; const float* ba; const float* bx; bf16* S; bf16* PF; bf16* PB; float* misc;
    __device__ __forceinline__ void operator()(f32x4 (&acc)[2][2][4][2], const pg8::Unit& u, int wr, int wc, int fr, int fq, LAS unsigned char*) const {
        int tz = threadIdx.x; asm volatile("" : "+v"(tz));
        fr = tz & 15; fq = (tz >> 4) & 3;
        const int st = u.aux0, hq = u.aux1, ch0 = hq * 64 + wc * 16 + fq * 4;
        const int row0 = st * 256 + wr * 128 + fr * 8;
        v2u ucp[2][4];
#pragma unroll
        for (int ai = 0; ai < 2; ++ai)
#pragma unroll
            for (int m = 0; m < 4; ++m) ucp[ai][m] = *(const GAS v2u*)((const GAS char*)UC + ((unsigned)(row0 + 4 * ai + m) * DL + ch0) * 2u);
#pragma unroll
        for (int d = 0; d < 2; ++d) {
            const f32x4 bav = *(const f32x4*)(misc + MS_GB + d * 2 * DL + ch0), bxv = *(const f32x4*)(misc + MS_GB + d * 2 * DL + DL + ch0), spv = *(const f32x4*)(misc + MS_SP + d * DL + ch0);
            f32x4 c = (f32x4){1.f, 1.f, 1.f, 1.f}, h = (f32x4){0.f, 0.f, 0.f, 0.f};
#pragma unroll
            for (int ii = 0; ii < 8; ++ii) { const int i = d ? 7 - ii : ii, ai = i >> 2, m = i & 3;
                const f32x4 x = (f32x4){bf_lo(ucp[ai][m].x), bf_hi(ucp[ai][m].x), bf_lo(ucp[ai][m].y), bf_hi(ucp[ai][m].y)};
                const f32x4 p0 = acc[ai][d][m][0] + bav, p1 = acc[ai][d][m][1] + bxv;
                f32x4 a, b;
#pragma unroll
                for (int e = 0; e < 4; ++e) { const float r = __builtin_amdgcn_rcpf(1.0f + __builtin_amdgcn_exp2f(p0[e])), q = 1.0f + __builtin_amdgcn_exp2f(p1[e]); const float av = __builtin_amdgcn_exp2f(r * spv[e]); a[e] = av;
                    const float om = fmaxf(1.0f - av * av, 0.f); b[e] = om * __builtin_amdgcn_rsqf(fmaxf(om * q * q, 1e-30f)); }
                h = a * h + b * x; c = c * a; acc[ai][d][m][0] = c; acc[ai][d][m][1] = h;
                if (ii & 1) __builtin_amdgcn_sched_barrier(0); }
            f32x4 cin, hin;
#pragma unroll
            for (int e = 0; e < 4; ++e) { float ta = c[e], tb = h[e];
                if (d == 0) { scan_step<0, 1>(ta, tb); scan_step<0, 2>(ta, tb); scan_step<0, 4>(ta, tb); scan_step<0, 8>(ta, tb); }
                else        { scan_step<1, 1>(ta, tb); scan_step<1, 2>(ta, tb); scan_step<1, 4>(ta, tb); scan_step<1, 8>(ta, tb); }
                cin[e] = d ? dpp_f<0x101>(1.0f, ta) : dpp_f<0x111>(1.0f, ta); hin[e] = d ? dpp_f<0x101>(0.0f, tb) : dpp_f<0x111>(0.0f, tb); }
#pragma unroll
            for (int i = 0; i < 8; ++i) { const int ai = i >> 2, m = i & 3; const f32x4 cl = acc[ai][d][m][0]; acc[ai][d][m][1] = acc[ai][d][m][1] + cl * hin; acc[ai][d][m][0] = cl * cin; }
            __builtin_amdgcn_sched_barrier(0);
        }
        const int sub = st * 2 + wr;
#pragma unroll
        for (int ai = 0; ai < 2; ++ai)
#pragma unroll
            for (int m = 0; m < 4; ++m) {
                const f32x4 pf = acc[ai][0][m][0], hf = acc[ai][0][m][1], pb = acc[ai][1][m][0], hb = acc[ai][1][m][1];
                const unsigned off = ((unsigned)(row0 + 4 * ai + m) * DL + ch0) * 2u;
                if (st < T / 256) {
                    v2u o; o.x = cvt_pk_bf16(hf[0] + hb[0], hf[1] + hb[1]); o.y = cvt_pk_bf16(hf[2] + hb[2], hf[3] + hb[3]); *(GAS v2u*)((GAS char*)S + off) = o;
                    o.x = cvt_pk_bf16(pf[0], pf[1]); o.y = cvt_pk_bf16(pf[2], pf[3]); *(GAS v2u*)((GAS char*)PF + off) = o;
                    o.x = cvt_pk_bf16(pb[0], pb[1]); o.y = cvt_pk_bf16(pb[2], pb[3]); *(GAS v2u*)((GAS char*)PB + off) = o;
                }
                if (ai == 1 && m == 3 && fr == 15) { *(f32x4*)(misc + MS_SUMA + ((size_t)sub * 2 + 0) * DL + ch0) = pf; *(f32x4*)(misc + MS_SUMB + ((size_t)sub * 2 + 0) * DL + ch0) = hf; }
                if (ai == 0 && m == 0 && fr == 0) { *(f32x4*)(misc + MS_SUMA + ((size_t)sub * 2 + 1) * DL + ch0) = pb; *(f32x4*)(misc + MS_SUMB + ((size_t)sub * 2 + 1) * DL + ch0) = hb; }
            }
    }
};

template <int PART = 3>
__device__ __forceinline__ void p5a_fix(const Args& A, LAS unsigned char* lds, int tid, int lane, int wave, int vcu, int G, int wg0 = 0, int nwg = 0) {
    const int gw = vcu * NWAVES + wave, NGW = G * NWAVES;
    const float* misc = (const float*)(A.ws + WS_MISC);
    const bf16* Sb = (const bf16*)(A.ws + WS_S); const bf16* PF = (const bf16*)(A.ws + WS_PF); const bf16* PB = (const bf16*)(A.ws + WS_PB); const bf16* GATE = (const bf16*)(A.ws + WS_GATE);
    bf16* YMIX = (bf16*)(A.ws + WS_YMIX); const float* gl = A.in[14];
    if ((PART & 1) && vcu >= wg0) {
        const int NP = nwg > 0 ? nwg : G, pw = vcu - wg0;
        float* nyq = (float*)(A.ws + WS_MISC) + MS_NYQ;
        const bf16* CSm = (const bf16*)(A.ws + WS_CS); const bf16* P64B = (const bf16*)(misc + MS_P64B);
        const int arow = lane & 15, akq = lane >> 4;
        LAS f32x4* red = (LAS f32x4*)lds;
        for (int base = 0; base < 128 * 4; base += 2 * NP) {
            const int it = base + (wave & 1) * NP + pw, kq = wave >> 1;
            const bool act = it < 128 * 4;
            const int k0 = (it >> 2) * 16, bg0 = (it & 3) * 16;
            f32x4 acc = (f32x4){0.f, 0.f, 0.f, 0.f};
            if (act) {
                const bf16* ap = CSm + (size_t)(k0 + arow) * 2048 + kq * 512 + akq * 8; const bf16* bp = P64B + (size_t)(bg0 + arow) * 2048 + kq * 512 + akq * 8;
                bf16x8 af[16], bq[16];
#pragma unroll
                for (int ks = 0; ks < 16; ++ks) { af[ks] = *(const GAS bf16x8*)(ap + ks * 32); bq[ks] = *(const GAS bf16x8*)(bp + ks * 32); }
#pragma unroll
                for (int ks = 0; ks < 16; ++ks) acc = __builtin_amdgcn_mfma_f32_16x16x32_bf16(af[ks], bq[ks], acc, 0, 0, 0);
            }
            __syncthreads();
            red[wave * 64 + lane] = acc;
            __syncthreads();
            if (act && kq == 0) {
                acc = acc + red[(wave + 2) * 64 + lane] + red[(wave + 4) * 64 + lane] + red[(wave + 6) * 64 + lane];
                const int bg = bg0 + arow; const float p2048 = misc[MS_P64 + (size_t)bg * P64_LD + 2048];
                f32x4 o;
#pragma unroll
                for (int r = 0; r < 4; ++r) o[r] = acc[r] + (((4 * akq + r) & 1) ? -p2048 : p2048);
                *(f32x4*)(nyq + (size_t)bg * P64_LD + k0 + 4 * akq) = o;
            }
        }
        for (int bg = pw * NWAVES + wave; bg < 64; bg += NP * NWAVES) { const float* src = misc + MS_P64 + (size_t)bg * P64_LD; float a = 0.f;
#pragma unroll 8
            for (int n = lane; n < 2048; n += 64) a += (n & 1) ? -src[n] : src[n];
            a = wave_sum(a) + src[2048]; if (lane == 0) nyq[(size_t)bg * P64_LD + 2048] = a; }
    }
    if (PART & 2)
    for (int sc = vcu; sc < T / 128; sc += G) {
        const int it = sc * 8 + wave;
        const int t0 = it * 16, b = t0 / SEQ, c = (t0 % SEQ) / 128, ch = lane * 16;
        LAS float* cl = (LAS float*)lds;
        __syncthreads();
        {   const int c2 = tid * 2, cs0 = T / 128 + 2 * b;
            typedef float v2f __attribute__((ext_vector_type(2)));
            auto LA = [&](int sub, int d) -> v2f { return *(const v2f*)(misc + MS_SUMA + ((size_t)sub * 2 + d) * DL + c2); };
            auto LB = [&](int sub, int d) -> v2f { return *(const v2f*)(misc + MS_SUMB + ((size_t)sub * 2 + d) * DL + c2); };
            v2f f = LA(cs0 + 1, 0) * LB(cs0, 0) + LB(cs0 + 1, 0), r = LA(cs0, 1) * LB(cs0 + 1, 1) + LB(cs0, 1);
            for (int cc0 = 0; cc0 < c; cc0 += 8) { v2f a[8], q[8];
#pragma unroll
                for (int k = 0; k < 8; ++k) { const int cc = (cc0 + k < c) ? cc0 + k : c - 1; a[k] = LA(b * NSUB + cc, 0); q[k] = LB(b * NSUB + cc, 0); }
#pragma unroll
                for (int k = 0; k < 8; ++k) if (cc0 + k < c) f = a[k] * f + q[k]; }
            for (int cc0 = NSUB - 1; cc0 > c; cc0 -= 8) { v2f a[8], q[8];
#pragma unroll
                for (int k = 0; k < 8; ++k) { const int cc = (cc0 - k > c) ? cc0 - k : c + 1; a[k] = LA(b * NSUB + cc, 1); q[k] = LB(b * NSUB + cc, 1); }
#pragma unroll
                for (int k = 0; k < 8; ++k) if (cc0 - k > c) r = a[k] * r + q[k]; }
            *(LAS v2f*)(cl + c2) = f; *(LAS v2f*)(cl + 1024 + c2) = r;
        }
        __syncthreads();
        float cf[16], cbk[16];
#pragma unroll
        for (int q = 0; q < 4; ++q) { const f32x4 vf = *(const LAS f32x4*)(cl + ch + 4 * q), vb = *(const LAS f32x4*)(cl + 1024 + ch + 4 * q);
#pragma unroll
            for (int e = 0; e < 4; ++e) { cf[4 * q + e] = vf[e]; cbk[4 * q + e] = vb[e]; } }
        v4u nx[2][4];
        { const size_t off = (size_t)t0 * DL + ch;
#pragma unroll
          for (int hh = 0; hh < 2; ++hh) { nx[hh][0] = *(const GAS v4u*)(Sb + off + 8 * hh); nx[hh][1] = *(const GAS v4u*)(PF + off + 8 * hh); nx[hh][2] = *(const GAS v4u*)(PB + off + 8 * hh); nx[hh][3] = *(const GAS v4u*)(GATE + off + 8 * hh); } }
        for (int tt = 0; tt < 16; ++tt) {
            v4u cu[2][4];
#pragma unroll
            for (int hh = 0; hh < 2; ++hh)
#pragma unroll
                for (int a4 = 0; a4 < 4; ++a4) cu[hh][a4] = nx[hh][a4];
            if (tt < 15) { const size_t off = (size_t)(t0 + tt + 1) * DL + ch;
#pragma unroll
                for (int hh = 0; hh < 2; ++hh) { nx[hh][0] = *(const GAS v4u*)(Sb + off + 8 * hh); nx[hh][1] = *(const GAS v4u*)(PF + off + 8 * hh); nx[hh][2] = *(const GAS v4u*)(PB + off + 8 * hh); nx[hh][3] = *(const GAS v4u*)(GATE + off + 8 * hh); } }
            float y[16]; float ss = 0.f;
#pragma unroll
            for (int hh = 0; hh < 2; ++hh) {
                const v4u s4 = cu[hh][0], f4 = cu[hh][1], b4 = cu[hh][2], g4 = cu[hh][3];
                const unsigned sw[4] = {s4.x, s4.y, s4.z, s4.w}, fw[4] = {f4.x, f4.y, f4.z, f4.w}, bw[4] = {b4.x, b4.y, b4.z, b4.w}, gw4[4] = {g4.x, g4.y, g4.z, g4.w};
#pragma unroll
                for (int q = 0; q < 4; ++q) { const int i0 = 8 * hh + 2 * q;
                    const float v0 = (bf_lo(sw[q]) + bf_lo(fw[q]) * cf[i0] + bf_lo(bw[q]) * cbk[i0]) * gelu_tanh_f(bf_lo(gw4[q]));
                    const float v1 = (bf_hi(sw[q]) + bf_hi(fw[q]) * cf[i0 + 1] + bf_hi(bw[q]) * cbk[i0 + 1]) * gelu_tanh_f(bf_hi(gw4[q]));
                    y[i0] = v0; y[i0 + 1] = v1; ss += v0 * v0 + v1 * v1; }
            }
            const float r = 1.0f / sqrtf(wave_sum(ss) * (1.0f / DL) + EPS);
            float gn[16];
#pragma unroll
            for (int q = 0; q < 4; ++q) { const f32x4 v = *(const f32x4*)(gl + ch + 4 * q);
#pragma unroll
                for (int e = 0; e < 4; ++e) gn[4 * q + e] = v[e]; }
            const float r8 = r * YMIX_SCALE; v4u o0;
            o0.x = pk4_fp8(y[0] * r8 * gn[0], y[1] * r8 * gn[1], y[2] * r8 * gn[2], y[3] * r8 * gn[3]); o0.y = pk4_fp8(y[4] * r8 * gn[4], y[5] * r8 * gn[5], y[6] * r8 * gn[6], y[7] * r8 * gn[7]);
            o0.z = pk4_fp8(y[8] * r8 * gn[8], y[9] * r8 * gn[9], y[10] * r8 * gn[10], y[11] * r8 * gn[11]); o0.w = pk4_fp8(y[12] * r8 * gn[12], y[13] * r8 * gn[13], y[14] * r8 * gn[14], y[15] * r8 * gn[15]);
            *(GAS v4u*)((unsigned char*)YMIX + (size_t)(t0 + tt) * D + ch) = o0;
        }
    }
}

__device__ __forceinline__ void p5b_four(const Args& A, LAS unsigned char* lds, int lane, int wave, int vcu, int G) {
    const int gw = vcu * NWAVES + wave, NGW = G * NWAVES;
    const float* misc = (const float*)(A.ws + WS_MISC); const bf16* AB = (const bf16*)(A.ws + WS_AB); const bf16* FOUR = (const bf16*)(A.ws + WS_FOUR);
    bf16* YMIX = (bf16*)(A.ws + WS_YMIX); const float* gf = A.in[15];
    const int g = lane >> 3, jl = lane & 7, nbl = (lane & ~7) | ((lane + 1) & 7);
    float gf0[8], gf1[8];
#pragma unroll
    for (int q = 0; q < 2; ++q) { const f32x4 v0 = *(const f32x4*)(gf + g * 128 + 8 * jl + 4 * q), v1 = *(const f32x4*)(gf + g * 128 + 8 * (15 - jl) + 4 * q);
#pragma unroll
        for (int e = 0; e < 4; ++e) { gf0[4 * q + e] = v0[e]; gf1[4 * q + e] = v1[e]; } }
    auto unpack = [&](const v4u a, float* o) { o[0] = bf_lo(a.x); o[1] = bf_hi(a.x); o[2] = bf_lo(a.y); o[3] = bf_hi(a.y); o[4] = bf_lo(a.z); o[5] = bf_hi(a.z); o[6] = bf_lo(a.w); o[7] = bf_hi(a.w); };
    auto put = [&](int t, const float* c0, float nb, const float* c1, float r) {
        const float r8 = r * YMIX_SCALE; v2u o0, o1;
        o0.x = pk4_fp8(c0[0] * r8 * gf0[0], c0[1] * r8 * gf0[1], c0[2] * r8 * gf0[2], c0[3] * r8 * gf0[3]); o0.y = pk4_fp8(c0[4] * r8 * gf0[4], c0[5] * r8 * gf0[5], c0[6] * r8 * gf0[6], c0[7] * r8 * gf0[7]);
        o1.x = pk4_fp8(nb * r8 * gf1[0], c1[7] * r8 * gf1[1], c1[6] * r8 * gf1[2], c1[5] * r8 * gf1[3]); o1.y = pk4_fp8(c1[4] * r8 * gf1[4], c1[3] * r8 * gf1[5], c1[2] * r8 * gf1[6], c1[1] * r8 * gf1[7]);
        unsigned char* dst = (unsigned char*)YMIX + (size_t)t * D + DL + g * 128;
        *(GAS v2u*)(dst + 8 * jl) = o0; *(GAS v2u*)(dst + 8 * (15 - jl)) = o1; };
    for (int it0 = gw * 8; it0 < NB * 2048; it0 += NGW * 8) {
        const int b = it0 >> 11, kp0 = it0 & 2047;
        float wv[8]; unpack(*(const GAS v4u*)(FOUR + ((size_t)b * SEQ + 2048) * DF + g * 128 + jl * 8), wv);
        v4u ra[8], rb[8]; float nq[8];
#pragma unroll
        for (int j = 0; j < 8; ++j) { const bf16* row = AB + ((size_t)b * 2048 + kp0 + j) * 1024 + g * 64 + jl * 8;
            ra[j] = *(const GAS v4u*)row; rb[j] = *(const GAS v4u*)(row + 512); nq[j] = misc[MS_NYQ + (size_t)(b * 8 + g) * P64_LD + kp0 + j]; }
#pragma unroll
        for (int j = 0; j < 8; ++j) {
            const int kp = kp0 + j; const float sk = (kp & 1) ? -1.0f : 1.0f;
            float av[8], bv[8], y0[8], y1[8]; unpack(ra[j], av); unpack(rb[j], bv);
            float ss = 0.f;
#pragma unroll
            for (int i = 0; i < 8; ++i) { const float a = av[i] + sk * wv[i]; y0[i] = a + bv[i]; y1[i] = a - bv[i]; }
            if (jl == 0) { y0[0] = av[0] + sk * wv[0]; y1[0] = nq[j]; }
#pragma unroll
            for (int i = 0; i < 8; ++i) ss += y0[i] * y0[i] + y1[i] * y1[i];
            const float r = 1.0f / sqrtf(wave_sum(ss) * (1.0f / DF) + EPS);
            put(b * SEQ + kp, y0, __shfl(y1[0], nbl), y1, r);
            if (kp >= 1) {
                const float e2 = (jl == 0) ? y1[0] : y0[0];
                if (jl != 0) y0[0] = y1[0];
                float m0[8]; m0[0] = y0[0];
#pragma unroll
                for (int i = 1; i < 8; ++i) m0[i] = y1[i];
                put(b * SEQ + SEQ - kp, m0, __shfl(e2, nbl), y0, r);
            }
        }
        if (kp0 == 0) {
            float av[8];
#pragma unroll
            for (int i = 0; i < 8; ++i) av[i] = wv[i];
#pragma unroll 8
            for (int nb = 0; nb < 32; ++nb) { const float* p = misc + MS_ALT + ((size_t)b * 32 + nb) * 512 + g * 64 + jl * 8; const f32x4 p0 = *(const f32x4*)p, p1 = *(const f32x4*)(p + 4);
                av[0] += p0[0]; av[1] += p0[1]; av[2] += p0[2]; av[3] += p0[3]; av[4] += p1[0]; av[5] += p1[1]; av[6] += p1[2]; av[7] += p1[3]; }
            float y1[8];
#pragma unroll
            for (int i = 0; i < 8; ++i) y1[i] = av[i];
            if (jl == 0) y1[0] = misc[MS_NYQ + (size_t)(b * 8 + g) * P64_LD + 2048];
            float ss = 0.f;
#pragma unroll
            for (int i = 0; i < 8; ++i) ss += av[i] * av[i] + y1[i] * y1[i];
            const float r = 1.0f / sqrtf(wave_sum(ss) * (1.0f / DF) + EPS);
            put(b * SEQ + 2048, av, __shfl(y1[0], nbl), y1, r);
        }
    }
}
}
namespace mk {
struct SchedTiles {      static constexpr bool DSTPF = false;
    const char* Abase; const char* Bbase; int nM, nN, G, c; unsigned lda_b, ldb_b;
    __device__ __forceinline__ bool next(int i, pg8::Unit& u) {
        const int L = i * G + c; if (L >= nM * nN) return false;
        int pm, pn; tile_order(L, nM, nN, pm, pn);
        u.pm = pm; u.pn = pn; u.aux0 = 0; u.aux1 = 0; u.nt = 0; u.a = Abase + (size_t)pm * 256 * lda_b; u.b = Bbase + (size_t)pn * 256 * ldb_b; return true;
    }
};
struct EpiBf16 {
    static constexpr int NST = 16;
    static __device__ __forceinline__ int a_row(int h, int R) { return 128 * h + R; }
    bf16* O; int ldc;
    __device__ __forceinline__ void operator()(f32x4 (&acc)[2][2][4][2], const pg8::Unit& u, int wr, int wc, int fr, int fq, LAS unsigned char*) const {
        const int row0 = u.pm * 256 + wr * 64 + fr, col0 = u.pn * 256 + wc * 32 + 8 * fq;
#pragma unroll
        for (int ai = 0; ai < 2; ++ai)
#pragma unroll
            for (int m = 0; m < 4; ++m) { const unsigned off = ((unsigned)(row0 + ai * 128 + m * 16) * (unsigned)ldc + col0) * 2u;
#pragma unroll
                for (int bj = 0; bj < 2; ++bj) { const f32x4 v0 = acc[ai][bj][m][0], v1 = acc[ai][bj][m][1];
                    v4u w; w.x = cvt_pk_bf16(v0[0], v0[1]); w.y = cvt_pk_bf16(v0[2], v0[3]); w.z = cvt_pk_bf16(v1[0], v1[1]); w.w = cvt_pk_bf16(v1[2], v1[3]);
                    *(GAS v4u*)((GAS char*)O + off + bj * 256) = w; } }
    }
};

constexpr int P8_BPITCH = 264;
template <int PART = 3>
__device__ __forceinline__ void p8_ln_router(const Args& A, LAS unsigned char* lds, int tid, int lane, int wave, int vcu, int G) {
    const float* mod = (const float*)(A.ws + WS_MOD); const bf16* MIX = (const bf16*)(A.ws + WS_MIX);
    bf16* H2LO = (bf16*)(A.ws + WS_H2LO); unsigned* H2F8 = (unsigned*)(A.ws + WS_H2F8); const bf16* WR = (const bf16*)(A.ws + WS_WR);
    int* cnt = (int*)(A.ws + WS_CTL) + CW_CNT; int* rt_tok = (int*)(A.ws + WS_ROUTE + RT_TOK); int* rt_dst = (int*)(A.ws + WS_ROUTE + RT_DST); float* rt_w = (float*)(A.ws + WS_ROUTE + RT_W);
    LAS bf16* bl = (LAS bf16*)lds;
    LAS float* lg = (LAS float*)(lds + 2 * 64 * P8_BPITCH * 2) + wave * (16 * 65);
    { const int gw = vcu * NWAVES + wave, NGW = G * NWAVES;
      for (int i = gw * 64 + lane; i < T; i += NGW * 64) { const int s = i / TS, tl = i % TS; rt_tok[((size_t)s * NEX + NE) * TS + tl] = tl; rt_dst[((size_t)s * NEX + NE) * TS + tl] = tl * 9 + 8; } }
    for (int tb = vcu; tb < T / 128; tb += G) {
        const int t0 = tb * 128 + wave * 16;
        LAS f32x4* pv = (LAS f32x4*)lds;
        {   const int b = (tb * 128) / SEQ; __syncthreads();
            const f32x4* s0 = (const f32x4*)(mod + (size_t)b * MODW + 2 * D); const f32x4* s1 = (const f32x4*)A.in[17]; const f32x4* s2 = (const f32x4*)A.in[18];
            const f32x4* s3 = (const f32x4*)(mod + (size_t)b * MODW + 3 * D); const f32x4* s4 = (const f32x4*)(mod + (size_t)b * MODW + 4 * D);
            pv[tid] = s0[tid]; pv[512 + tid] = s1[tid]; pv[1024 + tid] = s2[tid]; pv[1536 + tid] = s3[tid]; pv[2048 + tid] = s4[tid];
            __syncthreads(); }
        f32x4 lacc[4]; const int arow = lane & 15, akq = lane >> 4;
        if (PART & 1)
        for (int i = 0; i < 16; i += 2) {
            asm volatile("" ::: "memory");
            const int t = t0 + i;
            const GAS f32x4* xr = (const GAS f32x4*)(A.in[0] + (size_t)t * D) + lane; const GAS v2u* mr = (const GAS v2u*)(MIX + (size_t)t * D) + lane;
            const LAS f32x4* g1 = pv + lane;
            f32x4 v[8], u[8]; float s = 0.f, q = 0.f;
#pragma unroll
            for (int j = 0; j < 8; ++j) { const f32x4 xv = __builtin_nontemporal_load(xr + 64 * j), xw = __builtin_nontemporal_load(xr + 64 * j + 512), gv = g1[64 * j]; const v2u mv = __builtin_nontemporal_load(mr + 64 * j), mw = __builtin_nontemporal_load(mr + 64 * j + 512);
                v[j] = xv * ALPHA + gv * (f32x4){bf_lo(mv.x), bf_hi(mv.x), bf_lo(mv.y), bf_hi(mv.y)}; s += (v[j].x + v[j].y) + (v[j].z + v[j].w);
                u[j] = xw * ALPHA + gv * (f32x4){bf_lo(mw.x), bf_hi(mw.x), bf_lo(mw.y), bf_hi(mw.y)}; q += (u[j].x + u[j].y) + (u[j].z + u[j].w); }
            float mean = wave_sum(s) * (1.f / D), meanu = wave_sum(q) * (1.f / D), s2 = 0.f, q2 = 0.f;
#pragma unroll
            for (int j = 0; j < 8; ++j) { v[j] = v[j] - mean; u[j] = u[j] - meanu; s2 += (v[j].x * v[j].x + v[j].y * v[j].y) + (v[j].z * v[j].z + v[j].w * v[j].w); q2 += (u[j].x * u[j].x + u[j].y * u[j].y) + (u[j].z * u[j].z + u[j].w * u[j].w); }
            float rstd = 1.f / sqrtf(wave_sum(s2) * (1.f / D) + EPS), rstdu = 1.f / sqrtf(wave_sum(q2) * (1.f / D) + EPS);
            const LAS f32x4* lg1 = pv + 512 + lane; const LAS f32x4* lb1 = pv + 1024 + lane; GAS v2u* xo = (GAS v2u*)(A.out + (size_t)t * D) + lane;
            s = 0.f; q = 0.f;
#pragma unroll
            for (int j = 0; j < 8; ++j) { const f32x4 lg = lg1[64 * j], lb = lb1[64 * j]; v[j] = v[j] * rstd * lg + lb; u[j] = u[j] * rstdu * lg + lb; { v2u o; o.x = pk2(v[j].x, v[j].y); o.y = pk2(v[j].z, v[j].w); xo[64 * j] = o; o.x = pk2(u[j].x, u[j].y); o.y = pk2(u[j].z, u[j].w); xo[64 * j + 1024] = o; }
                s += (v[j].x + v[j].y) + (v[j].z + v[j].w); q += (u[j].x + u[j].y) + (u[j].z + u[j].w); }
            mean = wave_sum(s) * (1.f / D); meanu = wave_sum(q) * (1.f / D); s2 = 0.f; q2 = 0.f;
#pragma unroll
            for (int j = 0; j < 8; ++j) { v[j] = v[j] - mean; u[j] = u[j] - meanu; s2 += (v[j].x * v[j].x + v[j].y * v[j].y) + (v[j].z * v[j].z + v[j].w * v[j].w); q2 += (u[j].x * u[j].x + u[j].y * u[j].y) + (u[j].z * u[j].z + u[j].w * u[j].w); }
            rstd = 1.f / sqrtf(wave_sum(s2) * (1.f / D) + EPS); rstdu = 1.f / sqrtf(wave_sum(q2) * (1.f / D) + EPS);
            const LAS f32x4* sh2 = pv + 1536 + lane; const LAS f32x4* sc2 = pv + 2048 + lane;
#pragma unroll
            for (int tt = 0; tt < 2; ++tt) {
                GAS v2u* ol = (GAS v2u*)(H2LO + (size_t)(t + tt) * D) + lane; GAS unsigned* o8 = (GAS unsigned*)(H2F8 + (size_t)(t + tt) * (D / 4)) + lane;
#pragma unroll
                for (int j = 0; j < 8; ++j) { const f32x4 y = (tt ? u[j] * rstdu : v[j] * rstd) * (sc2[64 * j] + 1.0f) + sh2[64 * j];
                    const unsigned p8 = pk4_fp8(y.x, y.y, y.z, y.w); o8[64 * j] = p8; const f32x4 yq = fp8x4_to_f32(p8);
                    v2u o; o.x = pk2(y.x - yq.x, y.y - yq.y); o.y = pk2(y.z - yq.z, y.w - yq.w); ol[64 * j] = o; }
            }
        }
        VM_WAIT();
        if (!(PART & 2)) continue;
#pragma unroll
        for (int n = 0; n < 4; ++n) lacc[n] = (f32x4){0.f, 0.f, 0.f, 0.f};
        v4u wreg[8]; v2u araw[2][8]; bf16x8 areg[2][8];
        auto ldw = [&](int kc) {
#pragma unroll
            for (int q = 0; q < 8; ++q) { const int p = q * NTHR + tid, rowi = p >> 5, piece = p & 31; wreg[q] = *(const GAS v4u*)(WR + (size_t)rowi * D + kc * 256 + piece * 8); } };
        auto lda = [&](int kc, int buf) {
#pragma unroll
            for (int ks = 0; ks < 8; ++ks) { const size_t aoff = (size_t)(t0 + arow) * D + kc * 256 + ks * 32 + akq * 8;
                araw[buf][ks] = *(const GAS v2u*)((const unsigned char*)H2F8 + aoff); areg[buf][ks] = *(const GAS bf16x8*)(H2LO + aoff); } };
        ldw(0); lda(0, 0);
#pragma unroll
        for (int kc = 0; kc < 8; ++kc) {
            __syncthreads();
#pragma unroll
            for (int q = 0; q < 8; ++q) { const int p = q * NTHR + tid, rowi = p >> 5, piece = p & 31; *(LAS v4u*)(bl + rowi * P8_BPITCH + piece * 8) = wreg[q]; }
            __syncthreads();
            if (kc + 1 < 8) { ldw(kc + 1); lda(kc + 1, (kc + 1) & 1); }
#pragma unroll
            for (int ks = 0; ks < 8; ++ks) {
                const bf16x8 al = areg[kc & 1][ks]; bf16x8 ah;
                {   const v2u q = araw[kc & 1][ks]; v4u hb; hb.x = fp8x2_to_bf16x2(q.x, false); hb.y = fp8x2_to_bf16x2(q.x, true); hb.z = fp8x2_to_bf16x2(q.y, false); hb.w = fp8x2_to_bf16x2(q.y, true);
                    ah = __builtin_bit_cast(bf16x8, hb); }
#pragma unroll
                for (int n = 0; n < 4; ++n) {
                    const bf16x8 bh = *(const LAS bf16x8*)(bl + (n * 16 + arow) * P8_BPITCH + ks * 32 + akq * 8);
                    const bf16x8 blo = *(const LAS bf16x8*)(bl + (64 + n * 16 + arow) * P8_BPITCH + ks * 32 + akq * 8);
                    lacc[n] = __builtin_amdgcn_mfma_f32_16x16x32_bf16(ah, bh, lacc[n], 0, 0, 0);
                    lacc[n] = __builtin_amdgcn_mfma_f32_16x16x32_bf16(al, bh, lacc[n], 0, 0, 0);
                    lacc[n] = __builtin_amdgcn_mfma_f32_16x16x32_bf16(ah, blo, lacc[n], 0, 0, 0);
                }
            }
        }
#pragma unroll
        for (int n = 0; n < 4; ++n)
#pragma unroll
            for (int r = 0; r < 4; ++r) lg[(4 * akq + r) * 65 + 16 * n + arow] = lacc[n][r];
        LDS_WAIT(); asm volatile("" ::: "memory");
        const float rb = A.in[20][lane];
        unsigned cmask = 0u;
#pragma unroll 2
        for (int i = 0; i < 16; ++i) {
            const float z = lg[i * 65 + lane]; const float sc = 1.0f / (1.0f + expf(-z)); const float sel = sc + rb;
            const float m1 = group8_max(sel);
            const unsigned long long eq = __ballot(sel == m1); const unsigned grp = (unsigned)(eq >> (lane & ~7)) & 0xffu; const int first = __builtin_ctz(grp | 0x100u);
            const float m2 = group8_max(((lane & 7) == first) ? -1e30f : sel);
            const float gs = m1 + m2; const int g = lane >> 3;
            int grank = 0;
#pragma unroll
            for (int qq = 0; qq < 8; ++qq) { const float o = __builtin_bit_cast(float, __builtin_amdgcn_readlane(__builtin_bit_cast(int, gs), qq * 8)); grank += (o > gs || (o == gs && qq < g)) ? 1 : 0; }
            const bool allowed = grank < 4;
            const float msel = allowed ? sel : -1e30f;
            int kb = __builtin_bit_cast(int, msel); kb ^= (kb >> 31) & 0x7fffffff; const int key = (kb & ~63) | (63 - lane);
            int rank = 0;
#pragma unroll
            for (int qq = 0; qq < 64; ++qq) { const int o = __builtin_amdgcn_readlane(key, qq); rank += (o > key) ? 1 : 0; }
            const bool chosen = allowed && rank < 8;
            const float wsum = wave_sum(chosen ? sc : 0.f);
            cmask |= (chosen ? 1u : 0u) << i;
            lg[i * 65 + lane] = sc; if (lane == 0) lg[i * 65 + 64] = 2.5f / (wsum + 1e-20f);
        }
        {   const int sl = t0 / TS, ncho = __builtin_popcount(cmask);
            int base = 0; if (ncho) base = atomicAdd(&cnt[sl * 64 + lane], ncho);
            for (int i = 0; i < 16; ++i) {
                const bool chosen = (cmask >> i) & 1u; const unsigned long long cm = __ballot(chosen);
                if (chosen) {
                    const int t = t0 + i, tl = t % TS, j = __builtin_popcountll(cm & ((1ull << lane) - 1ull)), pos = base + __builtin_popcount(cmask & ((1u << i) - 1u));
                    rt_tok[((size_t)sl * NEX + lane) * TS + pos] = tl; rt_dst[((size_t)sl * NEX + lane) * TS + pos] = tl * 9 + j;
                    rt_w[(size_t)t * 8 + j] = lg[i * 65 + lane] * lg[i * 65 + 64];
                }
            }
        }
    }
}

struct MoeTab { LAS int* ucum; LAS int* segoff; LAS int* cnt; LAS int* idbuf; LAS int* myexp; };
__device__ __forceinline__ MoeTab moe_tab(LAS unsigned char* lds) { MoeTab m; m.ucum = (LAS int*)(lds + SCR_OFF); m.segoff = m.ucum + 72; m.cnt = m.segoff + 72; m.idbuf = m.cnt + 72; m.myexp = m.idbuf + 768; return m; }
__device__ __forceinline__ void moe_tables(const Args& A, LAS unsigned char* lds, int s, int ctiles, int tid, int G, int c) {
    MoeTab m = moe_tab(lds); const int* cnt = (const int*)(A.ws + WS_CTL) + CW_CNT + s * 64;
    __syncthreads();
    if (tid < 64) m.cnt[tid] = __hip_atomic_load(cnt + tid, RLX_AGENT);
    if (tid == 64) m.cnt[64] = TS;
    __syncthreads();
    if (tid == 0) { int u = 0, r = 0; for (int e = 0; e < NEX; ++e) { m.ucum[e] = u; m.segoff[e] = r; const int tl = (m.cnt[e] + 255) >> 8; u += tl * ctiles; r += tl * 256; } m.ucum[NEX] = u; }
    __syncthreads();
    if (tid < 256) { const int L = tid * G + c; int e = -1; if (L < m.ucum[NEX]) { e = 0; for (int q = 1; q < NEX; ++q) e += (m.ucum[q] <= L) ? 1 : 0; } m.myexp[tid] = e; }
    __syncthreads();
}
template <bool DSTPF_> struct SchedMoe {
    static constexpr bool DSTPF = DSTPF_;
    const int* dsts;
    MoeTab tb; const char* Abase; const char* Bbase; const int* lists; int G, c, ctiles; unsigned a_pitch, bexp_bytes, btile_bytes; bool gather;
    __device__ __forceinline__ bool next(int i, pg8::Unit& u) {
        if (i >= 256) return false; const int e = tb.myexp[i]; if (e < 0) return false; const int L = i * G + c;
        const int r = L - tb.ucum[e], rt = r / ctiles, ct = r % ctiles;
        u.pm = rt; u.pn = ct | ((i % 3) << 8); u.aux0 = e; u.aux1 = tb.segoff[e] + rt * 256; u.nt = 0;
        u.a = gather ? Abase : Abase + (size_t)u.aux1 * a_pitch; u.b = Bbase + (size_t)e * bexp_bytes + (size_t)ct * btile_bytes; return true;
    }
    __device__ __forceinline__ unsigned row_off_global(const pg8::Unit& u, int row) const {
        const int n = tb.cnt[u.aux0]; int idx = u.pm * 256 + row; idx = idx < n ? idx : n - 1;
        return (unsigned)lists[(size_t)u.aux0 * TS + idx] * a_pitch;
    }
    __device__ __forceinline__ void prefetch_rows(const pg8::Unit& u, int ui, LAS unsigned char* lds, int wid, int lane) const {
        if (wid < 4) { const int n = tb.cnt[u.aux0]; int idx = u.pm * 256 + wid * 64 + lane; idx = idx < n ? idx : n - 1;
            __builtin_amdgcn_global_load_lds((const unsigned*)(lists + (size_t)u.aux0 * TS + idx), (LAS unsigned*)(tb.idbuf + (ui & 1) * 256 + wid * 64), 4, 0, 0); }
    }
    __device__ __forceinline__ void prefetch_dst(const pg8::Unit& u, int ui, int wid, int lane) const {
        if (wid < 4) { const int n = tb.cnt[u.aux0]; int idx = u.pm * 256 + wid * 64 + lane; idx = idx < n ? idx : n - 1;
            __builtin_amdgcn_global_load_lds((const unsigned*)(dsts + (size_t)u.aux0 * TS + idx), (LAS unsigned*)(tb.idbuf + (ui % 3) * 256 + wid * 64), 4, 0, 0); }
    }
    __device__ __forceinline__ unsigned row_off_lds(int ui, int row, LAS unsigned char*) const { return (unsigned)tb.idbuf[(ui & 1) * 256 + row] * a_pitch; }
};
struct EpiGU {
#if defined(GU_DRY)
    static constexpr int NST = 0;
#else
    static constexpr int NST = 8;
#endif
    static __device__ __forceinline__ int a_row(int h, int R) { return 128 * h + R; }
    unsigned char* ACT; bool dry;
    __device__ __forceinline__ void operator()(f32x4 (&acc)[2][2][4][2], const pg8::Unit& u, int wr, int wc, int fr, int fq, LAS unsigned char*) const {
        if (dry) { float s = 0.f;
#pragma unroll
            for (int ai = 0; ai < 2; ++ai)
#pragma unroll
                for (int bj = 0; bj < 2; ++bj)
#pragma unroll
                    for (int m = 0; m < 4; ++m)
#pragma unroll
                        for (int n2 = 0; n2 < 2; ++n2) s += acc[ai][bj][m][n2][0] + acc[ai][bj][m][n2][1] + acc[ai][bj][m][n2][2] + acc[ai][bj][m][n2][3];
            if (s == 1.2345e-30f) ACT[0] = 0; return; }
        const int row0 = u.aux1 + wr * 64 + fr, col0 = (u.pn & 255) * 128 + wc * 32 + 8 * fq;
#pragma unroll
        for (int ai = 0; ai < 2; ++ai)
#pragma unroll
            for (int m = 0; m < 4; ++m) { const unsigned off = (unsigned)(row0 + ai * 128 + m * 16) * DE + col0;
                f32x4 a0, a1;
#pragma unroll
                for (int e = 0; e < 4; ++e) { const float g0 = acc[ai][0][m][0][e], g1 = acc[ai][0][m][1][e];
                    a0[e] = g0 * acc[ai][1][m][0][e] * __builtin_amdgcn_rcpf(1.0f + __builtin_amdgcn_exp2f(g0)); a1[e] = g1 * acc[ai][1][m][1][e] * __builtin_amdgcn_rcpf(1.0f + __builtin_amdgcn_exp2f(g1)); }
                v2u w; w.x = pk4_fp8(a0[0], a0[1], a0[2], a0[3]); w.y = pk4_fp8(a1[0], a1[1], a1[2], a1[3]);
                *(GAS v2u*)((GAS char*)ACT + off) = w; }
    }
};
struct EpiDN {
#if defined(DN_DRY)
    static constexpr int NST = 0;
#else
    static constexpr int NST = 8;
#endif
    static __device__ __forceinline__ int a_row(int h, int R) { return 128 * h + R; }
    unsigned char* OUTTOK; LAS int* idbuf; LAS int* cnt; bool dry;
    __device__ __forceinline__ void operator()(f32x4 (&acc)[2][2][4][2], const pg8::Unit& u, int wr, int wc, int fr, int fq, LAS unsigned char*) const {
        if (dry) { float s = 0.f;
#pragma unroll
            for (int ai = 0; ai < 2; ++ai)
#pragma unroll
                for (int bj = 0; bj < 2; ++bj)
#pragma unroll
                    for (int m = 0; m < 4; ++m)
#pragma unroll
                        for (int n2 = 0; n2 < 2; ++n2) s += acc[ai][bj][m][n2][0] + acc[ai][bj][m][n2][1] + acc[ai][bj][m][n2][2] + acc[ai][bj][m][n2][3];
            if (s == 1.2345e-30f) OUTTOK[0] = 0; return; }
        int tz = threadIdx.x; asm volatile("" : "+v"(tz)); fr = tz & 15; fq = (tz >> 4) & 3;
        const int n = cnt[u.aux0], rl0 = u.pm * 256 + wr * 64 + fr, col0 = (u.pn & 255) * 256 + wc * 64 + 16 * fq;
        const LAS int* dl = idbuf + (u.pn >> 8) * 256 - u.pm * 256;
#pragma unroll
        for (int ai = 0; ai < 2; ++ai)
#pragma unroll
            for (int m = 0; m < 4; ++m) { const int rl = rl0 + ai * 128 + m * 16;
                {
                    const unsigned off = (rl < n) ? (unsigned)dl[rl] * D + col0 : (unsigned)(WS_H2F8 - WS_OUTTOK) + (unsigned)(tz & 511) * 16u;
                    const f32x4 v0 = acc[ai][0][m][0], v1 = acc[ai][0][m][1], v2 = acc[ai][1][m][0], v3 = acc[ai][1][m][1];
                    v4u w; w.x = pk4_fp8(v0[0], v0[1], v0[2], v0[3]); w.y = pk4_fp8(v1[0], v1[1], v1[2], v1[3]); w.z = pk4_fp8(v2[0], v2[1], v2[2], v2[3]); w.w = pk4_fp8(v3[0], v3[1], v3[2], v3[3]);
                    *(GAS v4u*)((GAS char*)OUTTOK + off) = w; } }
    }
};
__device__ __forceinline__ void moe_combine(const Args& A, LAS unsigned char* lds, int s, int tid, int lane, int wave, int vcu, int G, float* wout, float oscale = 1.0f, float oadd = 0.0f, int tmask = 0x7fffffff) {
    const int gw = vcu * NWAVES + wave, NGW = G * NWAVES;
    const float* mod = (const float*)(A.ws + WS_MOD); const unsigned char* OT = A.ws + WS_OUTTOK; const float* rt_w = (const float*)(A.ws + WS_ROUTE + RT_W);
    LAS f32x4* pv = (LAS f32x4*)lds;
    for (int tb = vcu; tb < TS / 128; tb += G) {
      { const int b = (s * TS + tb * 128) / SEQ; __syncthreads();
        pv[tid] = ((const f32x4*)(mod + (size_t)b * MODW + 5 * D))[tid]; pv[512 + tid] = ((const f32x4*)A.in[27])[tid]; pv[1024 + tid] = ((const f32x4*)A.in[28])[tid];
        __syncthreads(); }
      for (int i = 0; i < 16; ++i) {
        asm volatile("" ::: "memory");
        const int tl = tb * 128 + wave * 16 + i, t = s * TS + tl;
        const GAS v4u* xb = (const GAS v4u*)(A.out + (size_t)t * D) + 2 * lane; GAS f32x4* yo = (GAS f32x4*)(wout + (size_t)(t & tmask) * D) + 4 * lane;
        const LAS f32x4* g2 = pv + 4 * lane;
        const GAS v4u* rows = (const GAS v4u*)(OT + (size_t)tl * 9 * D) + lane;
        float w[8];
        { const f32x4 w0 = *(const GAS f32x4*)(rt_w + (size_t)t * 8), w1 = *(const GAS f32x4*)(rt_w + (size_t)t * 8 + 4); w[0] = w0[0]; w[1] = w0[1]; w[2] = w0[2]; w[3] = w0[3]; w[4] = w1[0]; w[5] = w1[1]; w[6] = w1[2]; w[7] = w1[3]; }
        v4u q[9][2];
#pragma unroll
        for (int k = 0; k < 9; ++k)
#pragma unroll
            for (int j = 0; j < 2; ++j) q[k][j] = __builtin_nontemporal_load(rows + k * 128 + 64 * j);
        v4u xq[2][2];
#pragma unroll
        for (int j = 0; j < 2; ++j) { xq[j][0] = xb[128 * j]; xq[j][1] = xb[128 * j + 1]; }
        f32x4 f[8]; float sm = 0.f;
#pragma unroll
        for (int j = 0; j < 2; ++j) {
            f32x4 a[4];
            a[0] = fp8x4_to_f32(q[8][j].x); a[1] = fp8x4_to_f32(q[8][j].y); a[2] = fp8x4_to_f32(q[8][j].z); a[3] = fp8x4_to_f32(q[8][j].w);
#pragma unroll
            for (int k = 0; k < 8; ++k) { a[0] = a[0] + w[k] * fp8x4_to_f32(q[k][j].x); a[1] = a[1] + w[k] * fp8x4_to_f32(q[k][j].y); a[2] = a[2] + w[k] * fp8x4_to_f32(q[k][j].z); a[3] = a[3] + w[k] * fp8x4_to_f32(q[k][j].w); }
#pragma unroll
            for (int i = 0; i < 4; ++i) { const unsigned x0 = (i < 2) ? ((i & 1) ? xq[j][0].z : xq[j][0].x) : ((i & 1) ? xq[j][1].z : xq[j][1].x), x1 = (i < 2) ? ((i & 1) ? xq[j][0].w : xq[j][0].y) : ((i & 1) ? xq[j][1].w : xq[j][1].y);
                const f32x4 y = (f32x4){bf_lo(x0), bf_hi(x0), bf_lo(x1), bf_hi(x1)} * ALPHA + g2[256 * j + i] * (a[i] * 0.0625f); f[4 * j + i] = y; sm += (y.x + y.y) + (y.z + y.w); }
        }
        const float mean = wave_sum(sm) * (1.f / D); float s2 = 0.f;
#pragma unroll
        for (int j = 0; j < 8; ++j) { f[j] = f[j] - mean; s2 += (f[j].x * f[j].x + f[j].y * f[j].y) + (f[j].z * f[j].z + f[j].w * f[j].w); }
        const float rstd = 1.f / sqrtf(wave_sum(s2) * (1.f / D) + EPS);
        const LAS f32x4* lg2 = pv + 512 + 4 * lane; const LAS f32x4* lb2 = pv + 1024 + 4 * lane;
#pragma unroll
        for (int j = 0; j < 2; ++j)
#pragma unroll
            for (int i = 0; i < 4; ++i) {
#if defined(MK_STAMP_A)
                f32x4 o = (f[4 * j + i] * rstd * lg2[256 * j + i] + lb2[256 * j + i]) * oscale; if (t == 0 && lane == 0 && j == 0 && i == 0) o.x += oadd; yo[256 * j + i] = o;
#else
                yo[256 * j + i] = f[4 * j + i] * rstd * lg2[256 * j + i] + lb2[256 * j + i];
#endif
            }
      }
    }
}
}
namespace mk {
#ifndef GU_DRY
#define GU_DRY 0
#endif
#ifndef DN_DRY
#define DN_DRY 0
#endif
#ifndef DBL_MASK
#define DBL_MASK 0
#endif
#define REPS(k) for (int rep_ = 0; rep_ < (((DBL_MASK) >> (k)) & 1) + 1; ++rep_)
#ifndef MK_LAST_PHASE
#define MK_LAST_PHASE 2
#endif
__global__ void __launch_bounds__(NTHR, 2) mk_fwd(Args args) {
    extern __shared__ __attribute__((aligned(16))) unsigned char lds_raw[];
    LAS unsigned char* lds = (LAS unsigned char*)lds_raw;
    volatile LAS unsigned* MISC = (volatile LAS unsigned*)(lds + LDSCTL_OFF);
    const int tid = threadIdx.x, lane = tid & 63, wave = __builtin_amdgcn_readfirstlane(tid >> 6);
    const int G = gridDim.x; const int bx = blockIdx.x; const int vcu = (G % 8 == 0) ? (bx % 8) * (G / 8) + bx / 8 : bx;
    unsigned* ctl = (unsigned*)(args.ws + WS_CTL);
    for (int u = tid; u < (LDS_BYTES - LDSCTL_OFF) / 4; u += NTHR) ((LAS unsigned*)(lds + LDSCTL_OFF))[u] = 0u;
    __syncthreads();
    XcdBarrier bar = xcd_barrier_post(ctl + CW_BAR + args.li * XCD_BAR_WORDS, MISC + 8);
    const int lo = args.ph_lo, hi = args.ph_hi;
    float g_oscale = 1.0f, g_oadd = 0.0f;
#define IN(k) (lo <= (k) && (k) < hi)
#define BOTH(k) (IN(k) && IN((k) + 1))
#ifndef MK_STAMP_OFF
#define MK_STAMP_OFF 0.f
#endif
#ifndef MK_STAMP_BIN
#define MK_STAMP_BIN 20.f
#endif
#if defined(MK_STAMP_A)
#ifndef MK_STAMP_AE
#define MK_STAMP_AE (MK_STAMP_A + 1)
#endif
    volatile unsigned long long* stamps = (volatile unsigned long long*)(ctl + 16384); int nst = 1;
    if (bx == 0 && tid == 0) stamps[0] = __builtin_amdgcn_s_memrealtime();
#define GRID_BAR() do { xcd_barrier(bar); if (bx == 0 && tid == 0) stamps[nst] = __builtin_amdgcn_s_memrealtime(); ++nst; } while (0)
#else
#define GRID_BAR() xcd_barrier(bar)
#endif
#define OPQ() int tq = threadIdx.x; asm volatile("" : "+v"(tq)); const int tidq = tq, laneq = tq & 63

#if defined(MK_SPLIT_P0)
    if (IN(0)) { { OPQ(); p0_adaln(args, lds, tidq, G); } GRID_BAR(); { OPQ(); p0_fold(args, lds, tidq, G); } GRID_BAR(); { OPQ(); p0_weights<1>(args, lds, tidq, laneq, wave, vcu, G); } GRID_BAR();
        { OPQ(); p0_weights<2>(args, lds, tidq, laneq, wave, vcu, G); } GRID_BAR(); { OPQ(); p0_weights<4>(args, lds, tidq, laneq, wave, vcu, G); } if (BOTH(0)) GRID_BAR(); }
#else
    if (IN(0)) { REPS(0) { OPQ(); p0_adaln(args, lds, tidq, G); p0_fold(args, lds, tidq, G); p0_weights(args, lds, tidq, laneq, wave, vcu, G); } if (BOTH(0)) GRID_BAR(); }
#endif
    if (IN(1)) { REPS(1) { OPQ(); p1_hnorm(args, laneq, wave, vcu, G); } if (BOTH(1)) GRID_BAR(); }
    if (IN(2)) { REPS(2) {
        SchedInproj S{(const char*)(args.ws + WS_H), (const char*)(args.ws + WS_WIN), G, bx};
        static_assert(WS_GATE == WS_U + (size_t)TT * DL * 2 && WS_FOUR == WS_GATE + (size_t)T * DL * 2, "U|GATE|FOUR contiguous");
        EpiInproj E{(bf16*)(args.ws + WS_U), (bf16*)(args.ws + WS_UPART)};
        pg8::gemm_phase<EpiInproj, SchedInproj, true, false, true, 0x75757575>(lds, D / 128, D, D, S, E); }
        if (BOTH(2)) GRID_BAR();
    }
#ifndef SKIP_P3
    #if defined(MK_SPLIT_P3)
    if (IN(3)) { { OPQ(); p3_conv(args, laneq, wave, vcu, G); } GRID_BAR(); { OPQ(); p3_fold(args, lds, laneq, wave, vcu, G); } if (BOTH(3)) GRID_BAR(); }
#else
    if (IN(3)) { REPS(3) { OPQ(); p3_conv(args, laneq, wave, vcu, G); p3_fold(args, lds, laneq, wave, vcu, G); } if (BOTH(3)) GRID_BAR(); }
#endif
#endif
    if (IN(4)) { REPS(4) {
#ifndef SKIP_DFT
        { SchedDft S{(const char*)(args.ws + WS_CS), (const char*)(args.ws + WS_PQT), G, vcu}; EpiDft E{(bf16*)(args.ws + WS_AB)};
          pg8::gemm_phase<EpiDft, SchedDft, true, false>(lds, 2048 / 64, 4096, 4096, S, E); }
#endif
#if defined(MK_SPLIT_P4)
        GRID_BAR();
#endif
#ifndef SKIP_LRU
        { SchedGates S{(const char*)(args.ws + WS_UC), (const char*)(args.ws + WS_WG4), G, vcu};
          EpiLru E{(const bf16*)(args.ws + WS_UC), args.in[10], args.in[12], (bf16*)(args.ws + WS_S), (bf16*)(args.ws + WS_PF), (bf16*)(args.ws + WS_PB), (float*)(args.ws + WS_MISC)};
          pg8::gemm_phase<EpiLru, SchedGates, false, false>(lds, 256 / 64, DL * 2, 512, S, E); }
#endif
#if !defined(MK_SPLIT_P5)
        { OPQ(); p5a_fix<1>(args, lds, tidq, laneq, wave, vcu, G, G / 2, G - G / 2); }
#endif
        }
        if (BOTH(4)) GRID_BAR();
    }
#ifndef SKIP_P5
#if defined(MK_SPLIT_P5)
    if (IN(5)) { { OPQ(); p5a_fix<1>(args, lds, tidq, laneq, wave, vcu, G); } GRID_BAR(); { OPQ(); p5a_fix<2>(args, lds, tidq, laneq, wave, vcu, G); } if (BOTH(5)) GRID_BAR(); }
#else
    if (IN(5)) { { OPQ(); p5a_fix<2>(args, lds, tidq, laneq, wave, vcu, G); } { OPQ(); p5b_four(args, lds, laneq, wave, vcu, G); } if (BOTH(5)) GRID_BAR(); }
#endif
#if defined(MK_SPLIT_P5)
    if (IN(6)) { REPS(6) { OPQ(); p5b_four(args, lds, laneq, wave, vcu, G); } if (BOTH(6)) GRID_BAR(); }
#endif
#endif
#ifndef SKIP_P7
    if (IN(7)) { REPS(7) {
        SchedTiles S{(const char*)(args.ws + WS_YMIX), (const char*)(args.ws + WS_WOUT), T / 256, D / 256, G, bx, D, D};
        EpiBf16 E{(bf16*)(args.ws + WS_MIX), D};
        pg8::gemm_phase<EpiBf16, SchedTiles, true, false, true, 0x76767676>(lds, D / 128, D, D, S, E); }
        if (BOTH(7)) GRID_BAR();
    }
#endif
#ifndef SKIP_P8
#if defined(MK_SPLIT_P8)
    if (IN(8)) { { OPQ(); p8_ln_router<1>(args, lds, tidq, laneq, wave, vcu, G); } GRID_BAR(); { OPQ(); p8_ln_router<2>(args, lds, tidq, laneq, wave, vcu, G); } if (BOTH(8)) GRID_BAR(); }
#else
    if (IN(8)) { OPQ(); p8_ln_router(args, lds, tidq, laneq, wave, vcu, G); if (BOTH(8)) GRID_BAR(); }
#endif
#endif
#pragma unroll
    for (int s = 0; s < NSLICE; ++s) {
        const int p0 = 9 + 3 * s;
#ifndef SKIP_GU
        if (IN(p0)) { REPS(9) {
            { OPQ(); moe_tables(args, lds, s, 4, tidq, G, vcu); }
            SchedMoe<false> S{nullptr, moe_tab(lds), (const char*)(args.ws + WS_H2F8) + (size_t)s * TS * D, (const char*)(args.ws + WS_WGU), (const int*)(args.ws + WS_ROUTE + RT_TOK) + (size_t)s * NEX * TS, G, vcu, 4, (unsigned)D, 1024u * D, 256u * D, true};
            EpiGU E{args.ws + WS_ACT, (GU_DRY) && rep_ == 0};
            pg8::gemm_phase<EpiGU, SchedMoe<false>, true, true, true, 0x79797979>(lds, D / 128, D, D, S, E); }
            if (BOTH(p0)) GRID_BAR();
        }
#endif
#ifndef SKIP_DN
        if (IN(p0 + 1)) { REPS(10) {
            { OPQ(); moe_tables(args, lds, s, 8, tidq, G, vcu); }
            SchedMoe<true> S{(const int*)(args.ws + WS_ROUTE + RT_DST) + (size_t)s * NEX * TS, moe_tab(lds), (const char*)(args.ws + WS_ACT), (const char*)(args.ws + WS_WD), nullptr, G, vcu, 8, (unsigned)DE, 2048u * DE, 256u * DE, false};
            EpiDN E{args.ws + WS_OUTTOK, moe_tab(lds).idbuf, moe_tab(lds).cnt, (DN_DRY) && rep_ == 0};
            pg8::gemm_phase<EpiDN, SchedMoe<true>, false, false, true, 0x7d7d7d7d>(lds, DE / 128, DE, DE, S, E); }
            if (BOTH(p0 + 1)) GRID_BAR();
        }
#endif
#ifndef SKIP_CB
#if defined(MK_STAMP_A)
        if (IN(p0 + 2)) { xcd_barrier(bar);
            const unsigned long long sa0 = __hip_atomic_load((unsigned long long*)&stamps[MK_STAMP_A], RLX_AGENT), sa1 = __hip_atomic_load((unsigned long long*)&stamps[MK_STAMP_AE], RLX_AGENT);
            const unsigned long long sb0 = __hip_atomic_load((unsigned long long*)&stamps[MK_STAMP_B], RLX_AGENT), sb1 = __hip_atomic_load((unsigned long long*)&stamps[MK_STAMP_B + 1], RLX_AGENT);
            const float ta = floorf(((float)(sa1 - sa0) * 0.01f + (MK_STAMP_OFF)) / (MK_STAMP_BIN)) * (MK_STAMP_BIN), tb = floorf(((float)(sb1 - sb0) * 0.01f + (MK_STAMP_OFF)) / (MK_STAMP_BIN)) * (MK_STAMP_BIN);
            g_oscale = 1.0f + sqrtf(ta * 1e-4f); g_oadd = 1.0f + tb * 0.1f; }
#endif
        if (IN(p0 + 2)) { REPS(11) { OPQ(); moe_combine(args, lds, s, tidq, laneq, wave, vcu, G, (((DBL_MASK >> 11) & 1) && rep_ == 0) ? (float*)(args.ws + WS_ACT) : args.out, g_oscale, g_oadd, (((DBL_MASK >> 11) & 1) && rep_ == 0) ? 16383 : 0x7fffffff); } if (BOTH(p0 + 2)) GRID_BAR(); }
#endif
    }
#undef IN
#undef BOTH
}
}
static int g_grid = 0;
static void mk_launch(void* const* d_in, void* d_out, void* d_ws, hipStream_t stream, int lo, int hi, int li) {
    if (g_grid == 0) {
        int dev = 0, cus = 0; hipGetDevice(&dev); hipDeviceGetAttribute(&cus, hipDeviceAttributeMultiprocessorCount, dev);
        if (hipFuncSetAttribute((const void*)mk::mk_fwd, hipFuncAttributeMaxDynamicSharedMemorySize, mk::LDS_BYTES) != hipSuccess) { fprintf(stderr, "hipFuncSetAttribute failed\n"); g_grid = -1; return; }
        int per_cu = 0; (void)hipOccupancyMaxActiveBlocksPerMultiprocessor(&per_cu, (const void*)mk::mk_fwd, mk::NTHR, mk::LDS_BYTES); (void)hipGetLastError();
        if (per_cu < 1) fprintf(stderr, "occupancy query says %d\n", per_cu);
        g_grid = cus > 0 ? cus : 256;
    }
    if (g_grid < 0) return;
    mk::Args a{}; for (int i = 0; i < 29; ++i) a.in[i] = (const float*)d_in[i];
    a.out = (float*)d_out; a.ws = (unsigned char*)d_ws; a.ph_lo = lo; a.ph_hi = hi; a.li = li; a.pad = 0;
    hipLaunchKernelGGL(mk::mk_fwd, dim3(g_grid), dim3(mk::NTHR), mk::LDS_BYTES, stream, a);
}
extern "C" void kernel_launch(void* const* d_in, const int* in_sizes, int n_in, void* d_out, int out_size, void* d_ws, size_t ws_size, hipStream_t stream) {
    if (ws_size < mk::WS_END) { fprintf(stderr, "workspace too small\n"); return; }
    (void)hipMemsetAsync((unsigned char*)d_ws + mk::WS_CTL, 0, mk::CTL_ZERO_BYTES, stream);
    constexpr int NPH = 9 + 3 * mk::NSLICE;
#if MK_SPLIT
    for (int p = 0; p < NPH; ++p) mk_launch(d_in, d_out, d_ws, stream, p, p + 1, 0);
#else
    mk_launch(d_in, d_out, d_ws, stream, 0, NPH, 0);
#endif
}
```

```cpp
#include <hip/hip_runtime.h>
#include <cstdio>
#include <cstdint>
#define MK_SPLIT 0
#define GAS __attribute__((address_space(1)))
#define LAS __attribute__((address_space(3)))
namespace mk {
constexpr int D = 2048, NB = 8, SEQ = 4096, T = NB * SEQ, CTX = 256, TC = NB * CTX, TT = T + TC;
constexpr int DL = 1024, DF = 1024, DIN = 3072, NE = 64, NEX = 65, DE = 512;
constexpr int MODW = 6 * D;
constexpr float ALPHA = 1.189207115002721f, EPS = 1e-6f, PI2 = 6.283185307179586f;
constexpr int NWAVES = 8, NTHR = 512;
constexpr int NSLICE = 1, TS = T / NSLICE;
constexpr int SLOT_ROWS = TS * 8 + NE * 256 + TS;

typedef unsigned short bf16;
typedef unsigned v4u __attribute__((ext_vector_type(4)));
typedef unsigned v2u __attribute__((ext_vector_type(2)));
typedef float f32x4 __attribute__((ext_vector_type(4)));
typedef float f32x2 __attribute__((ext_vector_type(2)));
typedef short bf16x8 __attribute__((ext_vector_type(8)));
typedef int v8i __attribute__((ext_vector_type(8)));
typedef int v4i __attribute__((ext_vector_type(4)));

constexpr size_t MiB = 1u << 20;
constexpr size_t WS_CTL = 0, CTL_ZERO_BYTES = 1 * MiB;
constexpr size_t WS_MOD = 1 * MiB;
constexpr size_t WS_MISC = 2 * MiB;
constexpr size_t WS_WIN = 10 * MiB;
constexpr size_t WS_WOUT = 22 * MiB;
constexpr size_t WS_WG4 = 30 * MiB;
constexpr size_t WS_WR = 32 * MiB;
constexpr size_t WS_CS = 34 * MiB;
constexpr size_t WS_WGU = 50 * MiB;
constexpr size_t WS_WD = 180 * MiB;
constexpr size_t WS_DYN = 245 * MiB;
constexpr size_t WS_H = WS_DYN;
constexpr size_t WS_PF = WS_DYN, WS_PB = WS_DYN + 64 * MiB;
constexpr size_t WS_MIX = WS_DYN;
constexpr size_t WS_U = WS_DYN + 136 * MiB;
constexpr size_t WS_GATE = WS_U + 68 * MiB;
constexpr size_t WS_FOUR = WS_GATE + 64 * MiB;
constexpr size_t WS_UC = WS_FOUR + 64 * MiB;
constexpr size_t WS_S = WS_UC + 68 * MiB;
constexpr size_t WS_UPART = WS_S;
constexpr size_t WS_YMIX = WS_S + 64 * MiB;
constexpr float YMIX_SCALE = 8.0f, H_SCALE = 16.0f;
constexpr size_t WS_PQT = WS_YMIX + 128 * MiB;
constexpr size_t WS_AB = WS_PQT + 32 * MiB;
constexpr size_t WS_END_MIXER = WS_AB + 32 * MiB;
constexpr size_t WS_H2HI = WS_YMIX;
constexpr size_t WS_H2LO = WS_U;
constexpr size_t WS_OUTTOK = WS_DYN;
constexpr size_t OUTTOK_BYTES = (size_t)TS * 9 * D;
constexpr size_t WS_ACT = WS_OUTTOK + OUTTOK_BYTES;
constexpr size_t ACT_BYTES = (size_t)SLOT_ROWS * DE;
constexpr size_t WS_H2F8 = WS_OUTTOK + 736 * MiB;
constexpr size_t WS_ROUTE = WS_H2F8 + 64 * MiB;
constexpr size_t WS_END = WS_ROUTE + 24 * MiB;
static_assert(WS_H2F8 >= WS_END_MIXER, "H2F8 clear of the mixer buffers");
static_assert(WS_ACT + ACT_BYTES <= WS_H2F8, "MoE overlay map");
static_assert(WS_END <= 1150 * MiB, "workspace budget");
constexpr size_t RT_TOK = 0;
constexpr size_t RT_DST = RT_TOK + (size_t)NSLICE * NEX * TS * 4;
constexpr size_t RT_W = RT_DST + (size_t)NSLICE * NEX * TS * 4;
static_assert(RT_W + (size_t)T * 8 * 4 <= 24 * MiB, "routing tables");
constexpr int MS_SUMA = 0;
constexpr int NSUB = SEQ / 128;
constexpr int MS_SUMB = MS_SUMA + (TT / 128) * 2 * DL;
constexpr int MS_P64 = MS_SUMB + (TT / 128) * 2 * DL;
constexpr int P64_LD = 2112;
constexpr int MS_ALT = MS_P64 + NB * 8 * P64_LD;
constexpr int MS_NYQ = MS_ALT + NB * 32 * 512;
constexpr int MS_SP = MS_NYQ + NB * 8 * P64_LD;
constexpr int MS_GB = MS_SP + 2 * DL;
constexpr int MS_P64B = MS_GB + 4 * DL;
constexpr int MS_END = MS_P64B + 64 * 1024;
static_assert((size_t)MS_END * 4 <= 8 * MiB, "MISC region");
constexpr int CW_TMO = 0, CW_CODE = 1, CW_BAR = 4096, CW_CNT = 8192;

constexpr int RING_BYTES = 131072, LDSCTL_OFF = RING_BYTES, SCR_OFF = LDSCTL_OFF + 512, LDS_BYTES = 147456;

#define RLX_AGENT __ATOMIC_RELAXED, __HIP_MEMORY_SCOPE_AGENT
#define LDS_WAIT() asm volatile("s_waitcnt lgkmcnt(0)" ::: "memory")
#define VM_WAIT() asm volatile("s_waitcnt vmcnt(0)" ::: "memory")
__device__ __forceinline__ unsigned f2bf(float f) { unsigned u = __builtin_bit_cast(unsigned, f); return (u + 0x7fffu + ((u >> 16) & 1u)) >> 16; }
__device__ __forceinline__ unsigned pk2(float lo, float hi) { return f2bf(lo) | (f2bf(hi) << 16); }
__device__ __forceinline__ unsigned cvt_pk_bf16(float lo, float hi) { unsigned r; asm volatile("v_cvt_pk_bf16_f32 %0, %1, %2" : "=v"(r) : "v"(lo), "v"(hi)); return r; }
__device__ __forceinline__ unsigned pk4_fp8(float a, float b, float c, float d) {
    a = __builtin_amdgcn_fmed3f(a, -448.f, 448.f); b = __builtin_amdgcn_fmed3f(b, -448.f, 448.f); c = __builtin_amdgcn_fmed3f(c, -448.f, 448.f); d = __builtin_amdgcn_fmed3f(d, -448.f, 448.f);
    int r = __builtin_amdgcn_cvt_pk_fp8_f32(a, b, 0, false); r = __builtin_amdgcn_cvt_pk_fp8_f32(c, d, r, true); return (unsigned)r; }
__device__ __forceinline__ f32x4 fp8x4_to_f32(unsigned w) { const f32x2 lo = __builtin_amdgcn_cvt_pk_f32_fp8((int)w, false), hi = __builtin_amdgcn_cvt_pk_f32_fp8((int)w, true); return (f32x4){lo.x, lo.y, hi.x, hi.y}; }
__device__ __forceinline__ unsigned fp8x2_to_bf16x2(unsigned w, bool hiword) {
    unsigned long long r;
    if (hiword) asm volatile("v_cvt_pk_f32_fp8_sdwa %0, %1 src0_sel:WORD_1" : "=&v"(r) : "v"(w));
    else        asm volatile("v_cvt_pk_f32_fp8_e32 %0, %1" : "=&v"(r) : "v"(w));
    unsigned lo = (unsigned)r, hi = (unsigned)(r >> 32);
    asm volatile("" : "+v"(lo), "+v"(hi));
    return __builtin_amdgcn_perm(hi, lo, 0x07060302u);
}
__device__ __forceinline__ float bf_lo(unsigned w) { return __builtin_bit_cast(float, w << 16); }
__device__ __forceinline__ float bf_hi(unsigned w) { return __builtin_bit_cast(float, w & 0xffff0000u); }
__device__ __forceinline__ float bf2f(bf16 h) { return __builtin_bit_cast(float, (unsigned)h << 16); }
template <int CTRL> __device__ __forceinline__ float dppx(float v) {
    return __builtin_bit_cast(float, __builtin_amdgcn_update_dpp(0, __builtin_bit_cast(int, v), CTRL, 0xF, 0xF, true));
}
__device__ __forceinline__ float wave_sum(float v) {
    v += dppx<0xB1>(v);
    v += dppx<0x4E>(v);
    v += dppx<0x141>(v);
    v += dppx<0x140>(v);
    const int iv = __builtin_bit_cast(int, v);
    const float r0 = __builtin_bit_cast(float, __builtin_amdgcn_readlane(iv, 0)), r1 = __builtin_bit_cast(float, __builtin_amdgcn_readlane(iv, 16));
    const float r2 = __builtin_bit_cast(float, __builtin_amdgcn_readlane(iv, 32)), r3 = __builtin_bit_cast(float, __builtin_amdgcn_readlane(iv, 48));
    return (r0 + r1) + (r2 + r3);
}
__device__ __forceinline__ float group8_max(float v) {
    v = fmaxf(v, dppx<0xB1>(v)); v = fmaxf(v, dppx<0x4E>(v)); v = fmaxf(v, dppx<0x141>(v)); return v;
}
__device__ __forceinline__ float sigmoid_f(float x) { return __builtin_amdgcn_rcpf(1.0f + __expf(-x)); }
__device__ __forceinline__ float silu_f(float x) { return x * sigmoid_f(x); }
__device__ __forceinline__ float gelu_tanh_f(float x) { const float u = 0.7978845608028654f * (x + 0.044715f * x * x * x); const float e = __expf(2.0f * u); const float th = 1.0f - 2.0f * __builtin_amdgcn_rcpf(e + 1.0f); return 0.5f * x * (1.0f + th); }

#define XB_TMO      128
#define XB_XCNT(j)  (256  + 64 * (j))
#define XB_XSUB(j)  (1280 + 64 * (j))
#define XB_XGEN(j)  (2304 + 64 * (j))
#define XB_TOP      3328
#define XB_TOPGEN   3392
#define XCD_BAR_WORDS 3456
#define XB_SPIN_CAP (1u << 18)
__device__ __forceinline__ unsigned xb_ld(unsigned* p)              { return __hip_atomic_load(p, __ATOMIC_RELAXED, __HIP_MEMORY_SCOPE_AGENT); }
__device__ __forceinline__ unsigned xb_add(unsigned* p, unsigned v) { return __hip_atomic_fetch_add(p, v, __ATOMIC_RELAXED, __HIP_MEMORY_SCOPE_AGENT); }
__device__ __forceinline__ unsigned xb_xcc_id() { return (unsigned)__builtin_amdgcn_s_getreg((3 << 11) | 20) & 0xFu; }
#define XB_SPIN(cond, bar) do { unsigned _sp = 0; while (cond) { __builtin_amdgcn_s_sleep(1); \
    if ((++_sp & 255u) == 0u) { if (xb_ld(&(bar)[XB_TMO])) break; if (_sp > XB_SPIN_CAP) { atomicAdd(&(bar)[XB_TMO], 1u); break; } } } } while (0)
struct XcdBarrier { unsigned* bar; unsigned x; volatile LAS unsigned* st; };
__device__ __forceinline__ XcdBarrier xcd_barrier_post(unsigned* bar, volatile LAS unsigned* st) {
    XcdBarrier b; b.bar = bar; b.x = xb_xcc_id(); b.st = st;
    if (threadIdx.x == 0) (void)xb_add(&bar[XB_XCNT(b.x)], 1u);
    return b;
}
__device__ __forceinline__ void xcd_barrier_complete(unsigned* bar, unsigned x, unsigned& nloc, unsigned& nx) {
    const unsigned G = gridDim.x * gridDim.y * gridDim.z;
    unsigned sum, cnt, mine, sp = 0u;
    for (;;) {
        sum = 0u; cnt = 0u; mine = 0u;
#pragma unroll
        for (unsigned j = 0; j < 16; ++j) { const unsigned c = xb_ld(&bar[XB_XCNT(j)]); sum += c; cnt += (c > 0u) ? 1u : 0u; mine = (j == x) ? c : mine; }
        if (sum == G) break;
        __builtin_amdgcn_s_sleep(1);
        if ((++sp & 255u) == 0u) { if (xb_ld(&bar[XB_TMO])) break; if (sp > XB_SPIN_CAP) { atomicAdd(&bar[XB_TMO], 1u); break; } }
    }
    nloc = mine > 0u ? mine : 1u; nx = cnt > 0u ? cnt : 1u;
}
__device__ __forceinline__ void xcd_barrier(const XcdBarrier& b) {
    asm volatile("s_waitcnt vmcnt(0)" ::: "memory");
    __syncthreads();
    if (threadIdx.x == 0) {
        unsigned* bar = b.bar;
        __builtin_amdgcn_s_waitcnt(0);
        unsigned nloc = b.st[0], nx = b.st[1];
        if (nloc == 0u) { xcd_barrier_complete(bar, b.x, nloc, nx); b.st[0] = nloc; b.st[1] = nx; }
        const unsigned old = xb_add(&bar[XB_XSUB(b.x)], 1u);
        const unsigned gen = old / nloc;
        if (old + 1u == (gen + 1u) * nloc) {
            __builtin_amdgcn_fence(__ATOMIC_RELEASE, "agent");
            asm volatile("s_waitcnt vmcnt(0)" ::: "memory");
            const unsigned og = xb_add(&bar[XB_TOP], 1u);
            const unsigned tg = og / nx;
            if (og + 1u == (tg + 1u) * nx) xb_add(&bar[XB_TOPGEN], 1u);
            else XB_SPIN(xb_ld(&bar[XB_TOPGEN]) == tg, bar);
            __builtin_amdgcn_fence(__ATOMIC_ACQUIRE, "agent");
            xb_add(&bar[XB_XGEN(b.x)], 1u);
            asm volatile("s_waitcnt vmcnt(0)" ::: "memory");
        } else {
            XB_SPIN(xb_ld(&bar[XB_XGEN(b.x)]) == gen, bar);
            __builtin_amdgcn_fence(__ATOMIC_ACQUIRE, "agent");
            asm volatile("s_waitcnt vmcnt(0)" ::: "memory");
        }
    }
    __syncthreads();
}

namespace pg8 {
constexpr int BM = 256, BK = 64, HALF = 128, HTB = HALF * BK * 2, STAGE_BYTES = 8 * HTB;
__host__ __device__ __forceinline__ int lds_byte(int r, int c) { const int st = (r >> 4) * 2 + (c >> 5), rr = r & 15, cc = c & 31, ob = rr * 64 + cc * 2; return st * 1024 + (ob ^ (((ob >> 9) & 1) << 5)); }
__host__ __device__ __forceinline__ void stage_rc(int b, int& R, int& C) { const int st = b / 1024, sb = b % 1024, swz = sb ^ (((sb >> 9) & 1) << 5); R = (st >> 1) * 16 + swz / 64; C = (st & 1) * 32 + (swz % 64) / 2; }
__host__ __device__ __forceinline__ int perm_slot32(int c) { return 16 * ((c >> 2) & 1) + 4 * ((c >> 3) & 3) + (c & 3); }

__host__ __device__ __forceinline__ int perm_slot256(int c) { return 128 * ((c >> 3) & 1) + 32 * (c >> 6) + 16 * ((c >> 2) & 1) + 4 * ((c >> 4) & 3) + (c & 3); }
template <int N> struct IntC { static constexpr int value = N; };
struct Unit { const char* a; const char* b; int pm, pn, aux0, aux1, nt; };

template <class Epi, class Sched, bool ALIGN_EPI, bool GATHER, bool F8 = false, int SCW = 0x7f7f7f7f>
__device__ __forceinline__ void gemm_phase(LAS unsigned char* lds, const int nt_, const unsigned lda_b, const unsigned ldb_b, Sched& S, const Epi& E) {
    int nt = nt_; asm volatile("" : "+s"(nt));
    int tid_ = threadIdx.x; asm volatile("" : "+v"(tid_));
    const int tid = tid_, wid = __builtin_amdgcn_readfirstlane(tid >> 6), lane = tid & 63, wr = wid >> 2, wc = wid & 3, fr = lane & 15, fq = lane >> 4;
    unsigned voffA[2][2], voffB[2][2], cbyte[2]; int Rr[2];
#pragma unroll
    for (int i = 0; i < 2; ++i) { int R, C; stage_rc(tid * 16 + i * 8192, R, C); Rr[i] = R; cbyte[i] = (unsigned)C * 2u;
#pragma unroll
        for (int h = 0; h < 2; ++h) { voffB[h][i] = (unsigned)(R + HALF * h) * ldb_b + (unsigned)C * 2u; voffA[h][i] = (unsigned)Epi::a_row(h, R) * lda_b + (unsigned)C * 2u; } }
    const unsigned ldsw = (unsigned)wid * 1024u;
    const int aoff = lds_byte(wr * 64 + fr, fq * 8), boff = lds_byte(wc * 32 + fr, fq * 8);
#define PG8_SA(b, h) (((b) * 2 + (h)) * HTB)
#define PG8_SB(b, h) ((4 + (b) * 2 + (h)) * HTB)
#define PG8_STAGE(bufoff, gbase, voff) do { _Pragma("unroll") for (int _i = 0; _i < 2; ++_i) \
        __builtin_amdgcn_global_load_lds((const unsigned*)((const char*)(gbase) + (voff)[_i]), (LAS unsigned*)(lds + (bufoff) + ldsw + _i * 8192), 16, 0, 0); } while (0)
#define PG8_LDA(dst, b, h) do { _Pragma("unroll") for (int m = 0; m < 4; ++m) _Pragma("unroll") for (int k = 0; k < 2; ++k) dst[m][k] = *(const LAS v4i*)(lds + PG8_SA(b, h) + aoff + m * 2048 + k * 1024); } while (0)
#define PG8_LDB(dst, b, h) do { _Pragma("unroll") for (int n = 0; n < 2; ++n) _Pragma("unroll") for (int k = 0; k < 2; ++k) dst[n][k] = *(const LAS v4i*)(lds + PG8_SB(b, h) + boff + n * 2048 + k * 1024); } while (0)
#define PG8_CAT(x) __builtin_shufflevector((x)[0], (x)[1], 0, 1, 2, 3, 4, 5, 6, 7)
#define PG8_MMA(ai, bj, At, Bt) do { __builtin_amdgcn_s_setprio(1); _Pragma("unroll") for (int m = 0; m < 4; ++m) _Pragma("unroll") for (int n = 0; n < 2; ++n) { \
        if constexpr (F8) { const v8i b8_ = PG8_CAT(Bt[n]), a8_ = PG8_CAT(At[m]);   \
            asm volatile("v_mfma_scale_f32_16x16x128_f8f6f4 %0, %1, %2, %0, %3, %4 op_sel_hi:[0,0,0]" : "+v"(acc[ai][bj][m][n]) : "v"(b8_), "v"(a8_), "v"(scw_), "v"(sca_)); } \
        else { _Pragma("unroll") for (int k = 0; k < 2; ++k) acc[ai][bj][m][n] = __builtin_amdgcn_mfma_f32_16x16x32_bf16(__builtin_bit_cast(bf16x8, Bt[n][k]), __builtin_bit_cast(bf16x8, At[m][k]), acc[ai][bj][m][n], 0, 0, 0); } } \
        __builtin_amdgcn_s_setprio(0); } while (0)
#define PG8_WAIT_V(n) asm volatile("s_waitcnt vmcnt(" #n ")" ::: "memory")
#define PG8_WAIT_VN(n) asm volatile("s_waitcnt vmcnt(%0)" :: "n"(n) : "memory")
#define PG8_WAIT_RLX(rlx, n) asm volatile("s_cmp_lg_u32 %0, 0\n\ts_cbranch_scc1 .Lrx%=\n\ts_waitcnt vmcnt(8)\n.Lrx%=:\n\ts_waitcnt vmcnt(%1)" :: "s"(rlx), "n"(n) : "scc", "memory")
#define PG8_WAIT_L(n) asm volatile("s_waitcnt lgkmcnt(" #n ")" ::: "memory")
#define PG8_BAR __builtin_amdgcn_s_barrier()
#define PG8_SCHED __builtin_amdgcn_sched_barrier(0)
    int scw_ = SCW, sca_ = 0x7f7f7f7f; asm volatile("" : "+v"(scw_), "+v"(sca_));
    Unit cur, nxt; int ui = 0;
    if (!S.next(0, cur)) return;
    f32x4 acc[2][2][4][2];
#pragma unroll
    for (int a = 0; a < 2; ++a)
#pragma unroll
        for (int b = 0; b < 2; ++b)
#pragma unroll
            for (int m = 0; m < 4; ++m)
#pragma unroll
                for (int n = 0; n < 2; ++n) acc[a][b][m][n] = (f32x4){0.f, 0.f, 0.f, 0.f};
    v4i At[4][2], B0[2][2], B1[2][2];
    const char* cA = cur.a; const char* cB = cur.b;
    if constexpr (Sched::DSTPF) S.prefetch_dst(cur, 0, wid, lane);
    if constexpr (GATHER) {
#pragma unroll
        for (int h = 0; h < 2; ++h)
#pragma unroll
            for (int i = 0; i < 2; ++i) voffA[h][i] = S.row_off_global(cur, HALF * h + Rr[i]) + cbyte[i];
    }
    PG8_STAGE(PG8_SB(0, 0), cB, voffB[0]); PG8_STAGE(PG8_SB(0, 1), cB, voffB[1]); PG8_STAGE(PG8_SA(0, 0), cA, voffA[0]); PG8_STAGE(PG8_SA(0, 1), cA, voffA[1]);
    if (wr == 1) PG8_BAR;
    PG8_WAIT_V(2); PG8_BAR;
    PG8_STAGE(PG8_SB(1, 0), cB + 128, voffB[0]); PG8_STAGE(PG8_SA(1, 0), cA + 128, voffA[0]); PG8_STAGE(PG8_SB(1, 1), cB + 128, voffB[1]);
    PG8_WAIT_V(6); PG8_BAR;
    for (;;) {
        const bool has_next = S.next(ui + 1, nxt);
        const char* nA = has_next ? nxt.a : cA; const char* nB = has_next ? nxt.b : cB;
        if constexpr (GATHER) { if (has_next) S.prefetch_rows(nxt, ui + 1, lds, wid, lane); }
        if constexpr (Sched::DSTPF) { if (has_next) S.prefetch_dst(nxt, ui + 1, wid, lane); }
        const int ntu = (cur.nt > 0) ? cur.nt : nt;
        asm volatile(".p2align 8" ::: "memory");
        for (int t = 0; t < ntu; t += 2) {
            const bool rlx = (Epi::NST > 0) && t == 0 && ui > 0;
            int rlxs = 0; if constexpr (!F8 && Epi::NST > 0) { rlxs = __builtin_amdgcn_readfirstlane(rlx ? 1 : 0); asm volatile("" : "+s"(rlxs)); }
            const bool last = (t == ntu - 2);
            const char* a1 = cA + (size_t)(t + 1) * 128;
            const char* a2 = last ? nA : cA + (size_t)(t + 2) * 128; const char* b2 = last ? nB : cB + (size_t)(t + 2) * 128;
            const char* a3 = a2 + 128; const char* b3 = b2 + 128;
            unsigned oa[2][2];
#pragma unroll
            for (int h = 0; h < 2; ++h)
#pragma unroll
                for (int i = 0; i < 2; ++i) oa[h][i] = voffA[h][i];
            if constexpr (GATHER) { if (last && has_next) {
#pragma unroll
                for (int h = 0; h < 2; ++h)
#pragma unroll
                    for (int i = 0; i < 2; ++i) oa[h][i] = S.row_off_lds(ui + 1, HALF * h + Rr[i], lds) + cbyte[i]; } }
            PG8_LDB(B0, 0, 0); PG8_LDB(B1, 0, 1); PG8_SCHED; PG8_LDA(At, 0, 0); PG8_STAGE(PG8_SA(1, 1), a1, voffA[1]);
            if constexpr (F8) { if (rlx) PG8_WAIT_VN(8 + Epi::NST); else PG8_WAIT_V(8); } else if constexpr (Epi::NST > 0) PG8_WAIT_RLX(rlxs, 8 + Epi::NST); else PG8_WAIT_V(8); PG8_WAIT_L(0); PG8_BAR; PG8_MMA(0, 0, At, B0); PG8_MMA(0, 1, At, B1); PG8_BAR; PG8_SCHED;
            PG8_LDA(At, 0, 1); PG8_STAGE(PG8_SB(0, 0), b2, voffB[0]); PG8_STAGE(PG8_SB(0, 1), b2, voffB[1]); PG8_STAGE(PG8_SA(0, 0), a2, oa[0]);
            if constexpr (F8) { if (rlx) PG8_WAIT_VN(8 + Epi::NST); else PG8_WAIT_V(8); } else if constexpr (Epi::NST > 0) PG8_WAIT_RLX(rlxs, 8 + Epi::NST); else PG8_WAIT_V(8); PG8_WAIT_L(0); PG8_BAR; PG8_MMA(1, 0, At, B0); PG8_MMA(1, 1, At, B1); PG8_BAR; PG8_SCHED;
            PG8_LDB(B0, 1, 0); PG8_LDB(B1, 1, 1); PG8_SCHED; PG8_LDA(At, 1, 0); PG8_STAGE(PG8_SA(0, 1), a2, oa[1]);
            PG8_WAIT_V(8); PG8_WAIT_L(0); PG8_BAR; PG8_MMA(0, 0, At, B0); PG8_MMA(0, 1, At, B1); PG8_BAR; PG8_SCHED;
            PG8_LDA(At, 1, 1); PG8_STAGE(PG8_SB(1, 0), b3, voffB[0]); PG8_STAGE(PG8_SB(1, 1), b3, voffB[1]); PG8_STAGE(PG8_SA(1, 0), a3, oa[0]);
            PG8_WAIT_V(8); PG8_WAIT_L(0); PG8_BAR; PG8_MMA(1, 0, At, B0); PG8_MMA(1, 1, At, B1); PG8_BAR; PG8_SCHED;
            if constexpr (GATHER) { if (last) {
#pragma unroll
                for (int h = 0; h < 2; ++h)
#pragma unroll
                    for (int i = 0; i < 2; ++i) voffA[h][i] = oa[h][i]; } }
        }
        if constexpr (ALIGN_EPI) { if (wr == 0) PG8_BAR; }
        if constexpr (F8) asm volatile("s_nop 15\n\ts_nop 15" ::: "memory");
        E(acc, cur, wr, wc, fr, fq, lds);
        if (!has_next) break;
#pragma unroll
        for (int a = 0; a < 2; ++a)
#pragma unroll
            for (int b = 0; b < 2; ++b)
#pragma unroll
                for (int m = 0; m < 4; ++m)
#pragma unroll
                    for (int n = 0; n < 2; ++n) acc[a][b][m][n] = (f32x4){0.f, 0.f, 0.f, 0.f};
        cur = nxt; cA = nA; cB = nB; ++ui;
        if constexpr (ALIGN_EPI) { if (wr == 1) PG8_BAR; }
    }
    PG8_WAIT_V(0);
    if constexpr (!ALIGN_EPI) { if (wr == 0) PG8_BAR; }
    PG8_BAR;
#undef PG8_SA
#undef PG8_SB
#undef PG8_STAGE
#undef PG8_LDA
#undef PG8_LDB
#undef PG8_MMA
#undef PG8_CAT
#undef PG8_WAIT_V
#undef PG8_WAIT_VN
#undef PG8_WAIT_RLX
#undef PG8_WAIT_L
#undef PG8_BAR
#undef PG8_SCHED
}
}
}
namespace mk {
struct Args { const float* in[29]; float* out; unsigned char* ws; int ph_lo, ph_hi, li, pad; };
static_assert(sizeof(Args) == 31 * 8 + 16, "Args has no padding");

__device__ __forceinline__ void tile_order(int L, int nM, int nN, int& pm, int& pn) {
    const int nwg = nM * nN; int wgid = L;
    { const int q = nwg / 8, r = nwg % 8, xcd = wgid % 8, off = wgid / 8; wgid = (xcd < r ? xcd * (q + 1) : r * (q + 1) + (xcd - r) * q) + off; }
    const int nig = 8 * nN, gid = wgid / nig, fm = gid * 8, gsz = (nM - fm) < 8 ? (nM - fm) : 8;
    pm = fm + ((wgid % nig) % gsz); pn = (wgid % nig) / gsz;
}

__device__ __forceinline__ void p0_adaln(const Args& A, LAS unsigned char* lds, int tid, int G) {
    LAS float* st = (LAS float*)lds;
    const float* c = A.in[1]; const float* cc = A.in[3]; const float* w = A.in[4]; const float* bias = A.in[5];
    float* mod = (float*)(A.ws + WS_MOD);
    const int cg = tid % 12, kg = tid / 12;
    __syncthreads();
    for (int cb = blockIdx.x; cb < 256; cb += G) {
        for (int i = tid; i < 9 * D; i += NTHR) { const float v = (i < 8 * D) ? c[i] : cc[i - 8 * D]; st[i] = v / (1.0f + __expf(-v)); }
        __syncthreads();
        float acc[9][4];
#pragma unroll
        for (int r = 0; r < 9; ++r)
#pragma unroll
            for (int j = 0; j < 4; ++j) acc[r][j] = 0.f;
        const int col0 = cb * 48 + cg * 4;
        if (kg < 42) {
            for (int k = kg; k < D; k += 42) {
                const f32x4 wv = *(const f32x4*)(w + (size_t)k * MODW + col0);
#pragma unroll
                for (int r = 0; r < 9; ++r) { const float s = st[r * D + k];
#pragma unroll
                    for (int j = 0; j < 4; ++j) acc[r][j] += s * wv[j]; }
            }
        }
        __syncthreads();
        if (kg < 42) {
#pragma unroll
            for (int r = 0; r < 9; ++r)
#pragma unroll
                for (int j = 0; j < 4; ++j) st[(kg * 12 + cg) * 36 + r * 4 + j] = acc[r][j];
        }
        __syncthreads();
        if (tid < 432) { const int ocg = tid / 36, rj = tid % 36, r = rj >> 2, j = rj & 3; float s = 0.f;
            for (int q = 0; q < 42; ++q) s += st[(q * 12 + ocg) * 36 + rj];
            const int col = cb * 48 + ocg * 4 + j; mod[(size_t)r * MODW + col] = s + bias[col]; }
        __syncthreads();
    }
}

__device__ __forceinline__ void tr_item(const float* W, int ldw, int k0, int n0, bf16* WT, size_t dst_row0, int ldk, bool perm, LAS float* scr, int lane) {
#pragma unroll 8
    for (int i = 0; i < 32; ++i) { const int kk = 2 * i + (lane >> 5); scr[kk * 33 + (lane & 31)] = W[(size_t)(k0 + kk) * ldw + n0 + (lane & 31)]; }
    LDS_WAIT(); asm volatile("" ::: "memory");
    const int c = lane & 7;
#pragma unroll
    for (int j = 0; j < 4; ++j) { const int n = (lane >> 3) + 8 * j; const LAS float* s = scr + (8 * c) * 33 + n;
        v4u o; o.x = pk2(s[0 * 33], s[1 * 33]); o.y = pk2(s[2 * 33], s[3 * 33]); o.z = pk2(s[4 * 33], s[5 * 33]); o.w = pk2(s[6 * 33], s[7 * 33]);
        const int slot = perm ? pg8::perm_slot32(n) : n;
        *(GAS v4u*)(WT + (dst_row0 + slot) * (size_t)ldk + k0 + 8 * c) = o; }
    LDS_WAIT(); asm volatile("" ::: "memory");
}
__device__ __forceinline__ void tr_item_f8(const float* W, int ldw, int k0, int n0, unsigned char* WT, size_t dst_row0, int ldk, int mode256, LAS float* scr, int lane) {
#pragma unroll 8
    for (int i = 0; i < 32; ++i) { const int kk = 2 * i + (lane >> 5); scr[kk * 33 + (lane & 31)] = __builtin_nontemporal_load(W + (size_t)(k0 + kk) * ldw + n0 + (lane & 31)); }
    LDS_WAIT(); asm volatile("" ::: "memory");
    const int c = lane & 7;
#pragma unroll
    for (int j = 0; j < 4; ++j) { const int n = (lane >> 3) + 8 * j; const LAS float* s = scr + (8 * c) * 33 + n;
        v2u o; o.x = pk4_fp8(s[0 * 33] * 64.f, s[1 * 33] * 64.f, s[2 * 33] * 64.f, s[3 * 33] * 64.f); o.y = pk4_fp8(s[4 * 33] * 64.f, s[5 * 33] * 64.f, s[6 * 33] * 64.f, s[7 * 33] * 64.f);
        const int slot = mode256 ? pg8::perm_slot256((n0 & 255) + n) : pg8::perm_slot32(n);
        *(GAS v2u*)(WT + (dst_row0 + slot) * (size_t)ldk + k0 + 8 * c) = o; }
    LDS_WAIT(); asm volatile("" ::: "memory");
}
__device__ __forceinline__ void tr_item_hilo(const float* W, int ldw, int k0, int n0, bf16* WT, int ldk, LAS float* scr, int lane) {
#pragma unroll 8
    for (int i = 0; i < 32; ++i) { const int kk = 2 * i + (lane >> 5); scr[kk * 33 + (lane & 31)] = W[(size_t)(k0 + kk) * ldw + n0 + (lane & 31)]; }
    LDS_WAIT(); asm volatile("" ::: "memory");
    const int c = lane & 7;
#pragma unroll
    for (int j = 0; j < 4; ++j) { const int n = (lane >> 3) + 8 * j; const LAS float* s = scr + (8 * c) * 33 + n;
        float v[8]; unsigned hb[8], lb[8];
#pragma unroll
        for (int q = 0; q < 8; ++q) { v[q] = s[q * 33]; hb[q] = f2bf(v[q]); lb[q] = f2bf(v[q] - __builtin_bit_cast(float, hb[q] << 16)); }
        v4u oh, ol; oh.x = hb[0] | (hb[1] << 16); oh.y = hb[2] | (hb[3] << 16); oh.z = hb[4] | (hb[5] << 16); oh.w = hb[6] | (hb[7] << 16);
        ol.x = lb[0] | (lb[1] << 16); ol.y = lb[2] | (lb[3] << 16); ol.z = lb[4] | (lb[5] << 16); ol.w = lb[6] | (lb[7] << 16);
        *(GAS v4u*)(WT + (size_t)(n0 + n) * ldk + k0 + 8 * c) = oh;
        *(GAS v4u*)(WT + (size_t)(NE + n0 + n) * ldk + k0 + 8 * c) = ol; }
    LDS_WAIT(); asm volatile("" ::: "memory");
}

template <int PART = 7>
__device__ __forceinline__ void p0_weights(const Args& A, LAS unsigned char* lds, int tid, int lane, int wave, int vcu, int G) {
    LAS float* scr = (LAS float*)(lds + wave * 16384);
    const int gw = vcu * NWAVES + wave, NGW = G * NWAVES;
    bf16* WIN = (bf16*)(A.ws + WS_WIN); bf16* WOUT = (bf16*)(A.ws + WS_WOUT); unsigned char* WGU = A.ws + WS_WGU; unsigned char* WD = A.ws + WS_WD; bf16* WR = (bf16*)(A.ws + WS_WR);
    constexpr int I_IN = 32 * 64, I_OUT = 32 * 64, I_GU = 32 * 16, I_D = 8 * 64, I_R = 32 * 2;
    constexpr int NITEMS = I_IN + I_OUT + NEX * (2 * I_GU + I_D) + I_R;
    if (PART & 3)
    for (int it = gw; it < NITEMS; it += NGW) {
        int r = it;
        if (r < I_IN) { const int kb = r / 64, nb = r % 64; tr_item_f8(A.in[6], DIN, 64 * kb, 32 * nb, (unsigned char*)WIN, (size_t)32 * nb, D, 0, scr, lane); continue; } r -= I_IN;
        if (r < I_OUT) { const int kb = r / 64, nb = r % 64; tr_item_f8(A.in[16], D, 64 * kb, 32 * nb, (unsigned char*)WOUT, (size_t)32 * nb, D, 0, scr, lane); continue; } r -= I_OUT;
        if (r < NEX * 2 * I_GU) { const int e = r / (2 * I_GU); int q = r % (2 * I_GU); const int bj = q / I_GU; q %= I_GU; const int kb = q / 16, nb = q % 16;
            const float* W = (e < NE) ? A.in[bj ? 22 : 21] + (size_t)e * D * DE : A.in[bj ? 25 : 24];
            const int n0 = 32 * nb, ct = n0 >> 7, wcg = (n0 >> 5) & 3;
            tr_item_f8(W, DE, 64 * kb, n0, WGU, (size_t)e * 1024 + ct * 256 + bj * 128 + wcg * 32, D, 0, scr, lane); continue; } r -= NEX * 2 * I_GU;
        if (r < NEX * I_D) { const int e = r / I_D, q = r % I_D, kb = q / 64, nb = q % 64;
            const float* W = (e < NE) ? A.in[23] + (size_t)e * DE * D : A.in[26];
            tr_item_f8(W, D, 64 * kb, 32 * nb, WD, (size_t)e * D + ((32 * nb) & ~255), DE, 1, scr, lane); continue; } r -= NEX * I_D;
        { const int kb = r / 2, nb = r % 2; tr_item_hilo(A.in[19], NE, 64 * kb, 32 * nb, WR, D, scr, lane); }
    }
    if (!(PART & 4)) return;
    { float* misc = (float*)(A.ws + WS_MISC); const int i = gw * 64 + lane;
      if (i < 2 * DL) { const float l = -A.in[13][i]; misc[MS_SP + i] = -8.0f * 1.4426950408889634f * ((l > 20.f) ? l : log1pf(expf(l)));
          const int d = i >> 10, ch = i & 1023; misc[MS_GB + d * 2 * DL + ch] = -1.4426950408889634f * A.in[10][i]; misc[MS_GB + d * 2 * DL + DL + ch] = -1.4426950408889634f * A.in[12][i]; } }
    {   bf16* WG4 = (bf16*)(A.ws + WS_WG4);
        for (int it = gw; it < 4 * 4 * 4 * 32; it += NGW) {
            const int k8 = it & 31, gt = (it >> 5) & 3, q = (it >> 7) & 3, h = it >> 9, cl = lane;
            const float* src = ((gt & 1) ? A.in[11] : A.in[9]) + ((size_t)(gt >> 1) * 4 + h) * 65536 + q * 64 + cl;
            float v[8];
#pragma unroll
            for (int j = 0; j < 8; ++j) v[j] = -1.4426950408889634f * src[(size_t)(k8 * 8 + j) * 256];
            const int rho = (gt >> 1) * 128 + (cl >> 4) * 32 + (gt & 1) * 16 + ((cl >> 2) & 3) * 4 + (cl & 3);
            v4u o; o.x = pk2(v[0], v[1]); o.y = pk2(v[2], v[3]); o.z = pk2(v[4], v[5]); o.w = pk2(v[6], v[7]);
            *(GAS v4u*)(WG4 + ((size_t)h * 1024 + q * 256 + rho) * 256 + k8 * 8) = o;
        }
    }
    {   bf16* CS = (bf16*)(A.ws + WS_CS);
        for (int it = gw; it < 2 * 2048 * 4; it += NGW) {
            const int nq = it & 3, k = (it >> 2) & 2047, ty = it >> 13, n0 = nq * 512 + lane * 8;
            float v[8];
#pragma unroll
            for (int j = 0; j < 8; ++j) { const float x = (float)((k * (n0 + j)) & 4095) * (1.0f / 4096.0f); v[j] = ty ? __builtin_amdgcn_sinf(x) : __builtin_amdgcn_cosf(x); }
            v4u o; o.x = pk2(v[0], v[1]); o.y = pk2(v[2], v[3]); o.z = pk2(v[4], v[5]); o.w = pk2(v[6], v[7]);
            *(GAS v4u*)(CS + ((size_t)ty * 2048 + k) * 2048 + n0) = o;
        }
    }
}
__device__ __forceinline__ void p0_fold(const Args& A, LAS unsigned char* lds, int tid, int G) {
    LAS float* wt = (LAS float*)lds;
    LAS float* tb = (LAS float*)(lds + 64 * 129 * 4);
    bf16* WIN = (bf16*)(A.ws + WS_WIN);
    const float scale = 1.0f / 724.0773439350247f;
    for (int it = blockIdx.x; it < 256; it += G) {
        const int kb = it >> 3, g = it & 7, k0 = kb * 64;
        __syncthreads();
        if (tid < 128) { tb[tid] = __builtin_amdgcn_cosf((float)tid * (1.0f / 128.0f)); tb[128 + tid] = __builtin_amdgcn_sinf((float)tid * (1.0f / 128.0f)); }
        for (int i = tid; i < 64 * 128; i += NTHR) { const int kk = i >> 7, c = i & 127; wt[kk * 129 + c] = A.in[6][(size_t)(k0 + kk) * DIN + 2 * DL + g * 128 + c]; }
        __syncthreads();
        const int j = tid & 127, kq = tid >> 7, jj = (j <= 64) ? j : j - 64; const bool isc = (j <= 64);
        float acc[16];
#pragma unroll
        for (int i = 0; i < 16; ++i) acc[i] = 0.f;
        for (int c = 0; c < 128; ++c) { const int ph = (c * jj) & 127; const float tv = isc ? tb[ph] : -tb[128 + ph];
#pragma unroll
            for (int i = 0; i < 16; ++i) acc[i] += wt[(kq * 16 + i) * 129 + c] * tv; }
        const int col = g * 128 + j, row = 2 * DL + (col & ~31) + pg8::perm_slot32(col & 31);
        const float s64 = scale * 64.f; v4u o0;
        o0.x = pk4_fp8(acc[0] * s64, acc[1] * s64, acc[2] * s64, acc[3] * s64); o0.y = pk4_fp8(acc[4] * s64, acc[5] * s64, acc[6] * s64, acc[7] * s64);
        o0.z = pk4_fp8(acc[8] * s64, acc[9] * s64, acc[10] * s64, acc[11] * s64); o0.w = pk4_fp8(acc[12] * s64, acc[13] * s64, acc[14] * s64, acc[15] * s64);
        *(GAS v4u*)((unsigned char*)WIN + (size_t)row * D + k0 + kq * 16) = o0;
    }
    __syncthreads();
}

__device__ __forceinline__ void p1_hnorm(const Args& A, int lane, int wave, int vcu, int G) {
    const int gw = vcu * NWAVES + wave, NGW = G * NWAVES;
    const float* mod = (const float*)(A.ws + WS_MOD); bf16* H = (bf16*)(A.ws + WS_H);
    for (int r0 = gw; r0 < TT; r0 += 2 * NGW) {
        const int r1 = r0 + NGW; const bool has1 = r1 < TT; const int r1c = has1 ? r1 : r0;
        const float* x0 = (r0 < T) ? A.in[0] + (size_t)r0 * D : A.in[2] + (size_t)(r0 - T) * D; const float* x1 = (r1c < T) ? A.in[0] + (size_t)r1c * D : A.in[2] + (size_t)(r1c - T) * D;
        const int b0 = (r0 < T) ? r0 / SEQ : 8, b1 = (r1c < T) ? r1c / SEQ : 8;
        const GAS f32x4* xr0 = (const GAS f32x4*)x0 + lane; const GAS f32x4* xr1 = (const GAS f32x4*)x1 + lane;
        f32x4 v[8], u[8]; float s = 0.f, q = 0.f;
#pragma unroll
        for (int j = 0; j < 8; ++j) { v[j] = __builtin_nontemporal_load(xr0 + 64 * j); u[j] = __builtin_nontemporal_load(xr1 + 64 * j); }
#pragma unroll
        for (int j = 0; j < 8; ++j) { s += (v[j].x + v[j].y) + (v[j].z + v[j].w); q += (u[j].x + u[j].y) + (u[j].z + u[j].w); }
        const float mean0 = wave_sum(s) * (1.f / D), mean1 = wave_sum(q) * (1.f / D); float s2 = 0.f, q2 = 0.f;
#pragma unroll
        for (int j = 0; j < 8; ++j) { v[j] = v[j] - mean0; u[j] = u[j] - mean1; s2 += (v[j].x * v[j].x + v[j].y * v[j].y) + (v[j].z * v[j].z + v[j].w * v[j].w); q2 += (u[j].x * u[j].x + u[j].y * u[j].y) + (u[j].z * u[j].z + u[j].w * u[j].w); }
        const float rstd0 = 1.f / sqrtf(wave_sum(s2) * (1.f / D) + EPS), rstd1 = 1.f / sqrtf(wave_sum(q2) * (1.f / D) + EPS);
        { const GAS f32x4* sh = (const GAS f32x4*)(mod + (size_t)b0 * MODW) + lane; const GAS f32x4* sc = (const GAS f32x4*)(mod + (size_t)b0 * MODW + D) + lane; GAS unsigned* o8 = (GAS unsigned*)((unsigned char*)H + (size_t)r0 * D) + lane;
#pragma unroll
          for (int j = 0; j < 8; ++j) { const f32x4 a = sh[64 * j], m = sc[64 * j]; const f32x4 y = (v[j] * rstd0 * (m + 1.0f) + a) * H_SCALE; o8[64 * j] = pk4_fp8(y.x, y.y, y.z, y.w); } }
        if (has1) { const GAS f32x4* sh = (const GAS f32x4*)(mod + (size_t)b1 * MODW) + lane; const GAS f32x4* sc = (const GAS f32x4*)(mod + (size_t)b1 * MODW + D) + lane; GAS unsigned* o8 = (GAS unsigned*)((unsigned char*)H + (size_t)r1 * D) + lane;
#pragma unroll
          for (int j = 0; j < 8; ++j) { const f32x4 a = sh[64 * j], m = sc[64 * j]; const f32x4 y = (u[j] * rstd1 * (m + 1.0f) + a) * H_SCALE; o8[64 * j] = pk4_fp8(y.x, y.y, y.z, y.w); } }
    }
}

struct SchedInproj {
    static constexpr bool DSTPF = false;
    const char* H; const char* W; int G, c;
    __device__ __forceinline__ bool next(int i, pg8::Unit& u) {
        int L = i * G + c;
        if (G == 256 && c < 128) { if (i > 6) return false; L = (i == 0) ? 1536 + c : (i - 1) * G + c; }
        if (L >= 1536 + 128) return false;
        if (L < 1536) { int pm, pn; tile_order(L, 128, 12, pm, pn);
            u.pm = pm; u.pn = pn; u.aux0 = 0; u.aux1 = 0; u.nt = 0; u.a = H + (size_t)pm * 256 * D; u.b = W + (size_t)pn * 256 * D; }
        else {
            const int x = L - 1536, tile = x >> 2, ks = x & 3, pm = 128 + (tile >> 2), pn = tile & 3;
            u.pm = pm; u.pn = pn; u.aux0 = 1 + ks; u.aux1 = 0; u.nt = 4; u.a = H + (size_t)pm * 256 * D + ks * 512; u.b = W + (size_t)pn * 256 * D + ks * 512; }
        return true;
    }
};
struct EpiInproj {
    static __device__ __forceinline__ int a_row(int h, int R) { return 128 * h + R; }
    static constexpr int NST = 16;
    bf16* U; bf16* UPART;
    __device__ __forceinline__ void operator()(const f32x4 (&acc)[2][2][4][2], const pg8::Unit& u, int wr, int wc, int fr, int fq, LAS unsigned char*) const {
        const int arr = u.pn >> 2; const size_t aoff = (arr >= 1 ? (size_t)TT * DL : 0) + (arr >= 2 ? (size_t)T * DL : 0);
        bf16* base = U + aoff;
        int rowsub = 0; if (u.aux0 > 0) { base = UPART + (size_t)(u.aux0 - 1) * TC * DL; rowsub = T; }
        const int row0 = u.pm * 256 + wr * 64 + fr - rowsub, col0 = (u.pn & 3) * 256 + wc * 32 + 8 * fq;
#pragma unroll
        for (int ai = 0; ai < 2; ++ai)
#pragma unroll
            for (int m = 0; m < 4; ++m) { bf16* rowp = base + (size_t)(row0 + ai * 128 + m * 16) * DL + col0;
#pragma unroll
                for (int bj = 0; bj < 2; ++bj) { const f32x4 v0 = acc[ai][bj][m][0], v1 = acc[ai][bj][m][1];
                    v4u w; w.x = cvt_pk_bf16(v0[0], v0[1]); w.y = cvt_pk_bf16(v0[2], v0[3]); w.z = cvt_pk_bf16(v1[0], v1[1]); w.w = cvt_pk_bf16(v1[2], v1[3]);
                    *(v4u*)(rowp + bj * 128) = w; } }
    }
};
}
namespace mk {
__device__ __forceinline__ void p3_conv(const Args& A, int lane, int wave, int vcu, int G) {
    const int gw = vcu * NWAVES + wave, NGW = G * NWAVES;
    const bf16* U = (const bf16*)(A.ws + WS_U); const bf16* UPART = (const bf16*)(A.ws + WS_UPART); bf16* UC = (bf16*)(A.ws + WS_UC);
    const float* cw = A.in[7]; const float* cb = A.in[8];
    const f32x4 z4 = (f32x4){0.f, 0.f, 0.f, 0.f};
    auto cvt = [&](v2u q) -> f32x4 { return (f32x4){bf_lo(q.x), bf_hi(q.x), bf_lo(q.y), bf_hi(q.y)}; };
    for (int it = gw; it < (TC / 4) * 4; it += NGW) {
        const int rq = it >> 2, cblk = it & 3, r0 = rq * 4, ch = cblk * 256 + lane * 4;
        const int slo = r0 & ~255, shi = slo + 256;
        const f32x4 w0 = *(const f32x4*)(cw + ch), w1 = *(const f32x4*)(cw + DL + ch), w2 = *(const f32x4*)(cw + 2 * DL + ch), w3 = *(const f32x4*)(cw + 3 * DL + ch), bb = *(const f32x4*)(cb + ch);
        f32x4 acc[7];
#pragma unroll
        for (int j = 0; j < 7; ++j) acc[j] = z4;
#pragma unroll
        for (int h = 0; h < 1; ++h) {
            v2u raw[7][4];
#pragma unroll
            for (int j = 0; j < 7; ++j) { int r = r0 - 2 + j; r = r < slo ? slo : (r >= shi ? shi - 1 : r);
#pragma unroll
                for (int ks = 0; ks < 4; ++ks) raw[j][ks] = *(const GAS v2u*)(UPART + ((size_t)(h * 4 + ks) * TC + r) * DL + ch); }
#pragma unroll
            for (int j = 0; j < 7; ++j) {
#pragma unroll
                for (int ks = 0; ks < 4; ++ks) acc[j] = acc[j] + cvt(raw[j][ks]); }
        }
#pragma unroll
        for (int j = 0; j < 7; ++j) { const int r = r0 - 2 + j; if (r < slo || r >= shi) acc[j] = z4; }
#pragma unroll
        for (int p = 0; p < 4; ++p) {
            const f32x4 y = bb + w0 * acc[p] + w1 * acc[p + 1] + w2 * acc[p + 2] + w3 * acc[p + 3];
            v2u o; o.x = pk2(y.x, y.y); o.y = pk2(y.z, y.w); *(GAS v2u*)(UC + (size_t)(T + r0 + p) * DL + ch) = o;
        }
    }
    for (int it = gw; it < (T / 64) * 4; it += NGW) {
        const int rb = it >> 2, cblk = it & 3, r0 = rb * 64, ch = cblk * 256 + lane * 4;
        const f32x4 w0 = *(const f32x4*)(cw + ch), w1 = *(const f32x4*)(cw + DL + ch), w2 = *(const f32x4*)(cw + 2 * DL + ch), w3 = *(const f32x4*)(cw + 3 * DL + ch), bb = *(const f32x4*)(cb + ch);
        const bf16* src = U + (size_t)r0 * DL + ch; bf16* dst = UC + (size_t)r0 * DL + ch;
        v2u raw[3][8];
        const v2u q0 = *(const GAS v2u*)src;
#pragma unroll
        for (int j = 0; j < 8; ++j) raw[0][j] = *(const GAS v2u*)(src + (size_t)(j + 1) * DL);
#pragma unroll
        for (int j = 0; j < 8; ++j) raw[1][j] = *(const GAS v2u*)(src + (size_t)(j + 9) * DL);
        f32x4 um2 = z4, um1 = z4, u0 = cvt(q0);
#pragma unroll
        for (int bq = 0; bq < 8; ++bq) {
            if (bq + 2 < 8) {
#pragma unroll
                for (int j = 0; j < 8; ++j) { const int r = (bq + 2) * 8 + j + 1; if (r < 64) raw[(bq + 2) % 3][j] = *(const GAS v2u*)(src + (size_t)r * DL); }
            }
#pragma unroll
            for (int j = 0; j < 8; ++j) {
                const int p = bq * 8 + j;
                const f32x4 up1 = (p < 63) ? cvt(raw[bq % 3][j]) : z4;
                const f32x4 y = bb + w0 * um2 + w1 * um1 + w2 * u0 + w3 * up1;
                v2u o; o.x = pk2(y.x, y.y); o.y = pk2(y.z, y.w); *(GAS v2u*)(dst + (size_t)p * DL) = o;
                um2 = um1; um1 = u0; u0 = up1;
            }
        }
    }
}
__device__ __forceinline__ void p3_fold(const Args& A, LAS unsigned char* lds, int lane, int wave, int vcu, int G) {
    const int gw = vcu * NWAVES + wave, NGW = G * NWAVES;
    const bf16* FOUR = (const bf16*)(A.ws + WS_FOUR); bf16* PQT = (bf16*)(A.ws + WS_PQT); float* misc = (float*)(A.ws + WS_MISC);
    LAS bf16* scr = (LAS bf16*)(lds + wave * 16384);
    const int c8 = lane & 7, rr = lane >> 3;
    for (int it = gw; it < NB * 16 * 32; it += NGW) {
        const int nb = it & 31, cblk = (it >> 5) & 15, b = it >> 9, g = cblk >> 1, half = cblk & 1, n0 = nb * 64;
        const bf16* base = FOUR + (size_t)b * SEQ * DF + g * 128 + half * 64 + c8 * 8;
#pragma unroll
        for (int s = 0; s < 8; ++s) {
            const int nn = s * 8 + rr, n = n0 + nn;
            const v4u x = *(const GAS v4u*)(base + (size_t)n * DF);
            v4u xm = (v4u){0u, 0u, 0u, 0u}; if (n >= 1) xm = *(const GAS v4u*)(base + (size_t)(SEQ - n) * DF);
            float v[8], vm[8];
            v[0] = bf_lo(x.x); v[1] = bf_hi(x.x); v[2] = bf_lo(x.y); v[3] = bf_hi(x.y); v[4] = bf_lo(x.z); v[5] = bf_hi(x.z); v[6] = bf_lo(x.w); v[7] = bf_hi(x.w);
            vm[0] = bf_lo(xm.x); vm[1] = bf_hi(xm.x); vm[2] = bf_lo(xm.y); vm[3] = bf_hi(xm.y); vm[4] = bf_lo(xm.z); vm[5] = bf_hi(xm.z); vm[6] = bf_lo(xm.w); vm[7] = bf_hi(xm.w);
#pragma unroll
            for (int j = 0; j < 8; ++j) {
                float p;
                if (half == 0) p = v[j] + vm[j];
                else if (c8 == 0 && j == 0) { const float pn = v[0] + vm[0]; misc[MS_P64 + (b * 8 + g) * P64_LD + n] = pn; ((bf16*)(misc + MS_P64B))[(b * 8 + g) * 2048 + n] = (bf16)f2bf(pn); p = 0.f; }
                else p = (n >= 1) ? v[j] - vm[j] : 0.f;
                scr[(c8 * 8 + j) * 66 + nn] = (bf16)f2bf(p);
            }
        }
        LDS_WAIT(); asm volatile("" ::: "memory");
        bf16* dst = PQT + (((size_t)b * 2 + half) * 512 + g * 64) * 2048 + n0 + c8 * 8;
#pragma unroll
        for (int s = 0; s < 8; ++s) {
            const int jj = s * 8 + rr; const LAS bf16* q = scr + jj * 66 + c8 * 8;
            const unsigned a0 = q[0] | ((unsigned)q[1] << 16), a1 = q[2] | ((unsigned)q[3] << 16), a2 = q[4] | ((unsigned)q[5] << 16), a3 = q[6] | ((unsigned)q[7] << 16);
            *(GAS v4u*)(dst + (size_t)jj * 2048) = (v4u){a0, a1, a2, a3};
            if (half == 0) {
                float ps = (bf_lo(a0) - bf_hi(a0)) + (bf_lo(a1) - bf_hi(a1)) + (bf_lo(a2) - bf_hi(a2)) + (bf_lo(a3) - bf_hi(a3));
                ps += __shfl_xor(ps, 1); ps += __shfl_xor(ps, 2); ps += __shfl_xor(ps, 4);
                if (c8 == 0) misc[MS_ALT + (b * 32 + nb) * 512 + g * 64 + jj] = ps;
            }
        }
        LDS_WAIT(); asm volatile("" ::: "memory");
    }
    if (gw < NB * 8) { const int b = gw >> 3, g = gw & 7; if (lane == 0) misc[MS_P64 + (b * 8 + g) * P64_LD + 2048] = bf2f(FOUR[((size_t)b * SEQ + 2048) * DF + g * 128 + 64]); }
}

struct SchedDft {
    static constexpr bool DSTPF = false;
    const char* CS; const char* PQT; int G, c;
    __device__ __forceinline__ bool next(int i, pg8::Unit& u) {
        const int L = i * G + c; if (L >= 256) return false;
        const int b = L >> 5, kt = (L >> 2) & 7, ct = L & 3, type = ct >> 1;
        u.pm = kt; u.pn = ct; u.aux0 = b; u.aux1 = 0; u.nt = 0;
        u.a = CS + ((size_t)type * 2048 + kt * 256) * 4096; u.b = PQT + (((size_t)b * 2 + type) * 512 + (ct & 1) * 256) * 4096; return true;
    }
};
struct EpiDft {
    static constexpr int NST = 0;
    static __device__ __forceinline__ int a_row(int h, int R) { return 128 * h + R; }
    bf16* AB;
    __device__ __forceinline__ void operator()(f32x4 (&acc)[2][2][4][2], const pg8::Unit& u, int wr, int wc, int fr, int fq, LAS unsigned char*) const {
        const int row0 = u.pm * 256 + wr * 64 + fr, col0 = u.pn * 256 + wc * 32 + 4 * fq;
        bf16* base = AB + (size_t)u.aux0 * 2048 * 1024;
#pragma unroll
        for (int ai = 0; ai < 2; ++ai)
#pragma unroll
            for (int m = 0; m < 4; ++m) { bf16* rowp = base + (size_t)(row0 + ai * 128 + m * 16) * 1024 + col0;
#pragma unroll
                for (int bj = 0; bj < 2; ++bj)
#pragma unroll
                    for (int n = 0; n < 2; ++n) { const f32x4 v = acc[ai][bj][m][n]; v2u w; w.x = cvt_pk_bf16(v[0], v[1]); w.y = cvt_pk_bf16(v[2], v[3]); *(v2u*)(rowp + bj * 128 + n * 16) = w; } }
    }
};

struct SchedGates {
    static constexpr bool DSTPF = false;
    const char* UC; const char* WG4; int G, c;
    __device__ __forceinline__ bool next(int i, pg8::Unit& u) {
        const int L = i * G + c; if (L >= (TT / 256) * 16) return false;
        const int st = L >> 4, hq = L & 15;
        u.pm = st; u.pn = hq; u.aux0 = st; u.aux1 = hq; u.nt = 0;
        u.a = UC + (size_t)st * 256 * (DL * 2) + (hq >> 2) * 512; u.b = WG4 + (size_t)hq * 256 * 512; return true;
    }
};
template <int CTRL> __device__ __forceinline__ float dpp_f(float oldv, float src) {
    return __builtin_bit_cast(float, __builtin_amdgcn_update_dpp(__builtin_bit_cast(int, oldv), __builtin_bit_cast(int, src), CTRL, 0xF, 0xF, false));
}
template <int DIR, int DIST> __device__ __forceinline__ void scan_step(float& a, float& b) {
    const float ap = dpp_f<(DIR ? 0x100 : 0x110) + DIST>(1.0f, a), bp = dpp_f<(DIR ? 0x100 : 0x110) + DIST>(0.0f, b);
    b = a * bp + b; a = ap * a;
}
struct EpiLru {
    static constexpr int NST = 14;
    static __device__ __forceinline__ int a_row(int h, int R) { return 128 * (R >> 6) + 8 * (R & 15) + 4 * h + ((R >> 4) & 3); }
    const bf16* UC; const float* ba; const float* bx; bf16* S; bf16* PF; bf16* PB; float* misc;
    __device__ __forceinline__ void operator()(f32x4 (&acc)[2][2][4][2], const pg8::Unit& u, int wr, int wc, int fr, int fq, LAS unsigned char*) const {
        int tz = threadIdx.x; asm volatile("" : "+v"(tz));
        fr = tz & 15; fq = (tz >> 4) & 3;
        const int st = u.aux0, hq = u.aux1, ch0 = hq * 64 + wc * 16 + fq * 4;
        const int row0 = st * 256 + wr * 128 + fr * 8;
        v2u ucp[2][4];
#pragma unroll
        for (int ai = 0; ai < 2; ++ai)
#pragma unroll
            for (int m = 0; m < 4; ++m) ucp[ai][m] = *(const GAS v2u*)((const GAS char*)UC + ((unsigned)(row0 + 4 * ai + m) * DL + ch0) * 2u);
#pragma unroll
        for (int d = 0; d < 2; ++d) {
            const f32x4 bav = *(const f32x4*)(misc + MS_GB + d * 2 * DL + ch0), bxv = *(const f32x4*)(misc + MS_GB + d * 2 * DL + DL + ch0), spv = *(const f32x4*)(misc + MS_SP + d * DL + ch0);
            f32x4 c = (f32x4){1.f, 1.f, 1.f, 1.f}, h = (f32x4){0.f, 0.f, 0.f, 0.f};
#pragma unroll
            for (int ii = 0; ii < 8; ++ii) { const int i = d ? 7 - ii : ii, ai = i >> 2, m = i & 3;
                const f32x4 x = (f32x4){bf_lo(ucp[ai][m].x), bf_hi(ucp[ai][m].x), bf_lo(ucp[ai][m].y), bf_hi(ucp[ai][m].y)};
                const f32x4 p0 = acc[ai][d][m][0] + bav, p1 = acc[ai][d][m][1] + bxv;
                f32x4 a, b;
#pragma unroll
                for (int e = 0; e < 4; ++e) { const float r = __builtin_amdgcn_rcpf(1.0f + __builtin_amdgcn_exp2f(p0[e])), q = 1.0f + __builtin_amdgcn_exp2f(p1[e]); const float av = __builtin_amdgcn_exp2f(r * spv[e]); a[e] = av;
                    const float om = fmaxf(1.0f - av * av, 0.f); b[e] = om * __builtin_amdgcn_rsqf(fmaxf(om * q * q, 1e-30f)); }
                h = a * h + b * x; c = c * a; acc[ai][d][m][0] = c; acc[ai][d][m][1] = h;
                if (ii & 1) __builtin_amdgcn_sched_barrier(0); }
            f32x4 cin, hin;
#pragma unroll
            for (int e = 0; e < 4; ++e) { float ta = c[e], tb = h[e];
                if (d == 0) { scan_step<0, 1>(ta, tb); scan_step<0, 2>(ta, tb); scan_step<0, 4>(ta, tb); scan_step<0, 8>(ta, tb); }
                else        { scan_step<1, 1>(ta, tb); scan_step<1, 2>(ta, tb); scan_step<1, 4>(ta, tb); scan_step<1, 8>(ta, tb); }
                cin[e] = d ? dpp_f<0x101>(1.0f, ta) : dpp_f<0x111>(1.0f, ta); hin[e] = d ? dpp_f<0x101>(0.0f, tb) : dpp_f<0x111>(0.0f, tb); }
#pragma unroll
            for (int i = 0; i < 8; ++i) { const int ai = i >> 2, m = i & 3; const f32x4 cl = acc[ai][d][m][0]; acc[ai][d][m][1] = acc[ai][d][m][1] + cl * hin; acc[ai][d][m][0] = cl * cin; }
            __builtin_amdgcn_sched_barrier(0);
        }
        const int sub = st * 2 + wr;
#pragma unroll
        for (int ai = 0; ai < 2; ++ai)
#pragma unroll
            for (int m = 0; m < 4; ++m) {
                const f32x4 pf = acc[ai][0][m][0], hf = acc[ai][0][m][1], pb = acc[ai][1][m][0], hb = acc[ai][1][m][1];
                const unsigned off = ((unsigned)(row0 + 4 * ai + m) * DL + ch0) * 2u;
                if (st < T / 256) {
                    v2u o; o.x = cvt_pk_bf16(hf[0] + hb[0], hf[1] + hb[1]); o.y = cvt_pk_bf16(hf[2] + hb[2], hf[3] + hb[3]); *(GAS v2u*)((GAS char*)S + off) = o;
                    o.x = cvt_pk_bf16(pf[0], pf[1]); o.y = cvt_pk_bf16(pf[2], pf[3]); *(GAS v2u*)((GAS char*)PF + off) = o;
                    o.x = cvt_pk_bf16(pb[0], pb[1]); o.y = cvt_pk_bf16(pb[2], pb[3]); *(GAS v2u*)((GAS char*)PB + off) = o;
                }
                if (ai == 1 && m == 3 && fr == 15) { *(f32x4*)(misc + MS_SUMA + ((size_t)sub * 2 + 0) * DL + ch0) = pf; *(f32x4*)(misc + MS_SUMB + ((size_t)sub * 2 + 0) * DL + ch0) = hf; }
                if (ai == 0 && m == 0 && fr == 0) { *(f32x4*)(misc + MS_SUMA + ((size_t)sub * 2 + 1) * DL + ch0) = pb; *(f32x4*)(misc + MS_SUMB + ((size_t)sub * 2 + 1) * DL + ch0) = hb; }
            }
    }
};

template <int PART = 3>
__device__ __forceinline__ void p5a_fix(const Args& A, LAS unsigned char* lds, int tid, int lane, int wave, int vcu, int G, int wg0 = 0, int nwg = 0) {
    const int gw = vcu * NWAVES + wave, NGW = G * NWAVES;
    const float* misc = (const float*)(A.ws + WS_MISC);
    const bf16* Sb = (const bf16*)(A.ws + WS_S); const bf16* PF = (const bf16*)(A.ws + WS_PF); const bf16* PB = (const bf16*)(A.ws + WS_PB); const bf16* GATE = (const bf16*)(A.ws + WS_GATE);
    bf16* YMIX = (bf16*)(A.ws + WS_YMIX); const float* gl = A.in[14];
    if ((PART & 1) && vcu >= wg0) {
        const int NP = nwg > 0 ? nwg : G, pw = vcu - wg0;
        float* nyq = (float*)(A.ws + WS_MISC) + MS_NYQ;
        const bf16* CSm = (const bf16*)(A.ws + WS_CS); const bf16* P64B = (const bf16*)(misc + MS_P64B);
        const int arow = lane & 15, akq = lane >> 4;
        LAS f32x4* red = (LAS f32x4*)lds;
        for (int base = 0; base < 128 * 4; base += 2 * NP) {
            const int it = base + (wave & 1) * NP + pw, kq = wave >> 1;
            const bool act = it < 128 * 4;
            const int k0 = (it >> 2) * 16, bg0 = (it & 3) * 16;
            f32x4 acc = (f32x4){0.f, 0.f, 0.f, 0.f};
            if (act) {
                const bf16* ap = CSm + (size_t)(k0 + arow) * 2048 + kq * 512 + akq * 8; const bf16* bp = P64B + (size_t)(bg0 + arow) * 2048 + kq * 512 + akq * 8;
                bf16x8 af[16], bq[16];
#pragma unroll
                for (int ks = 0; ks < 16; ++ks) { af[ks] = *(const GAS bf16x8*)(ap + ks * 32); bq[ks] = *(const GAS bf16x8*)(bp + ks * 32); }
#pragma unroll
                for (int ks = 0; ks < 16; ++ks) acc = __builtin_amdgcn_mfma_f32_16x16x32_bf16(af[ks], bq[ks], acc, 0, 0, 0);
            }
            __syncthreads();
            red[wave * 64 + lane] = acc;
            __syncthreads();
            if (act && kq == 0) {
                acc = acc + red[(wave + 2) * 64 + lane] + red[(wave + 4) * 64 + lane] + red[(wave + 6) * 64 + lane];
                const int bg = bg0 + arow; const float p2048 = misc[MS_P64 + (size_t)bg * P64_LD + 2048];
                f32x4 o;
#pragma unroll
                for (int r = 0; r < 4; ++r) o[r] = acc[r] + (((4 * akq + r) & 1) ? -p2048 : p2048);
                *(f32x4*)(nyq + (size_t)bg * P64_LD + k0 + 4 * akq) = o;
            }
        }
        for (int bg = pw * NWAVES + wave; bg < 64; bg += NP * NWAVES) { const float* src = misc + MS_P64 + (size_t)bg * P64_LD; float a = 0.f;
#pragma unroll 8
            for (int n = lane; n < 2048; n += 64) a += (n & 1) ? -src[n] : src[n];
            a = wave_sum(a) + src[2048]; if (lane == 0) nyq[(size_t)bg * P64_LD + 2048] = a; }
    }
    if (PART & 2)
    for (int sc = vcu; sc < T / 128; sc += G) {
        const int it = sc * 8 + wave;
        const int t0 = it * 16, b = t0 / SEQ, c = (t0 % SEQ) / 128, ch = lane * 16;
        LAS float* cl = (LAS float*)lds;
        __syncthreads();
        {   const int c2 = tid * 2, cs0 = T / 128 + 2 * b;
            typedef float v2f __attribute__((ext_vector_type(2)));
            auto LA = [&](int sub, int d) -> v2f { return *(const v2f*)(misc + MS_SUMA + ((size_t)sub * 2 + d) * DL + c2); };
            auto LB = [&](int sub, int d) -> v2f { return *(const v2f*)(misc + MS_SUMB + ((size_t)sub * 2 + d) * DL + c2); };
            v2f f = LA(cs0 + 1, 0) * LB(cs0, 0) + LB(cs0 + 1, 0), r = LA(cs0, 1) * LB(cs0 + 1, 1) + LB(cs0, 1);
            for (int cc0 = 0; cc0 < c; cc0 += 8) { v2f a[8], q[8];
#pragma unroll
                for (int k = 0; k < 8; ++k) { const int cc = (cc0 + k < c) ? cc0 + k : c - 1; a[k] = LA(b * NSUB + cc, 0); q[k] = LB(b * NSUB + cc, 0); }
#pragma unroll
                for (int k = 0; k < 8; ++k) if (cc0 + k < c) f = a[k] * f + q[k]; }
            for (int cc0 = NSUB - 1; cc0 > c; cc0 -= 8) { v2f a[8], q[8];
#pragma unroll
                for (int k = 0; k < 8; ++k) { const int cc = (cc0 - k > c) ? cc0 - k : c + 1; a[k] = LA(b * NSUB + cc, 1); q[k] = LB(b * NSUB + cc, 1); }
#pragma unroll
                for (int k = 0; k < 8; ++k) if (cc0 - k > c) r = a[k] * r + q[k]; }
            *(LAS v2f*)(cl + c2) = f; *(LAS v2f*)(cl + 1024 + c2) = r;
        }
        __syncthreads();
        float cf[16], cbk[16];
#pragma unroll
        for (int q = 0; q < 4; ++q) { const f32x4 vf = *(const LAS f32x4*)(cl + ch + 4 * q), vb = *(const LAS f32x4*)(cl + 1024 + ch + 4 * q);
#pragma unroll
            for (int e = 0; e < 4; ++e) { cf[4 * q + e] = vf[e]; cbk[4 * q + e] = vb[e]; } }
        v4u nx[2][4];
        { const size_t off = (size_t)t0 * DL + ch;
#pragma unroll
          for (int hh = 0; hh < 2; ++hh) { nx[hh][0] = *(const GAS v4u*)(Sb + off + 8 * hh); nx[hh][1] = *(const GAS v4u*)(PF + off + 8 * hh); nx[hh][2] = *(const GAS v4u*)(PB + off + 8 * hh); nx[hh][3] = *(const GAS v4u*)(GATE + off + 8 * hh); } }
        for (int tt = 0; tt < 16; ++tt) {
            v4u cu[2][4];
#pragma unroll
            for (int hh = 0; hh < 2; ++hh)
#pragma unroll
                for (int a4 = 0; a4 < 4; ++a4) cu[hh][a4] = nx[hh][a4];
            if (tt < 15) { const size_t off = (size_t)(t0 + tt + 1) * DL + ch;
#pragma unroll
                for (int hh = 0; hh < 2; ++hh) { nx[hh][0] = *(const GAS v4u*)(Sb + off + 8 * hh); nx[hh][1] = *(const GAS v4u*)(PF + off + 8 * hh); nx[hh][2] = *(const GAS v4u*)(PB + off + 8 * hh); nx[hh][3] = *(const GAS v4u*)(GATE + off + 8 * hh); } }
            float y[16]; float ss = 0.f;
#pragma unroll
            for (int hh = 0; hh < 2; ++hh) {
                const v4u s4 = cu[hh][0], f4 = cu[hh][1], b4 = cu[hh][2], g4 = cu[hh][3];
                const unsigned sw[4] = {s4.x, s4.y, s4.z, s4.w}, fw[4] = {f4.x, f4.y, f4.z, f4.w}, bw[4] = {b4.x, b4.y, b4.z, b4.w}, gw4[4] = {g4.x, g4.y, g4.z, g4.w};
#pragma unroll
                for (int q = 0; q < 4; ++q) { const int i0 = 8 * hh + 2 * q;
                    const float v0 = (bf_lo(sw[q]) + bf_lo(fw[q]) * cf[i0] + bf_lo(bw[q]) * cbk[i0]) * gelu_tanh_f(bf_lo(gw4[q]));
                    const float v1 = (bf_hi(sw[q]) + bf_hi(fw[q]) * cf[i0 + 1] + bf_hi(bw[q]) * cbk[i0 + 1]) * gelu_tanh_f(bf_hi(gw4[q]));
                    y[i0] = v0; y[i0 + 1] = v1; ss += v0 * v0 + v1 * v1; }
            }
            const float r = 1.0f / sqrtf(wave_sum(ss) * (1.0f / DL) + EPS);
            float gn[16];
#pragma unroll
            for (int q = 0; q < 4; ++q) { const f32x4 v = *(const f32x4*)(gl + ch + 4 * q);
#pragma unroll
                for (int e = 0; e < 4; ++e) gn[4 * q + e] = v[e]; }
            const float r8 = r * YMIX_SCALE; v4u o0;
            o0.x = pk4_fp8(y[0] * r8 * gn[0], y[1] * r8 * gn[1], y[2] * r8 * gn[2], y[3] * r8 * gn[3]); o0.y = pk4_fp8(y[4] * r8 * gn[4], y[5] * r8 * gn[5], y[6] * r8 * gn[6], y[7] * r8 * gn[7]);
            o0.z = pk4_fp8(y[8] * r8 * gn[8], y[9] * r8 * gn[9], y[10] * r8 * gn[10], y[11] * r8 * gn[11]); o0.w = pk4_fp8(y[12] * r8 * gn[12], y[13] * r8 * gn[13], y[14] * r8 * gn[14], y[15] * r8 * gn[15]);
            *(GAS v4u*)((unsigned char*)YMIX + (size_t)(t0 + tt) * D + ch) = o0;
        }
    }
}

__device__ __forceinline__ void p5b_four(const Args& A, LAS unsigned char* lds, int lane, int wave, int vcu, int G) {
    const int gw = vcu * NWAVES + wave, NGW = G * NWAVES;
    const float* misc = (const float*)(A.ws + WS_MISC); const bf16* AB = (const bf16*)(A.ws + WS_AB); const bf16* FOUR = (const bf16*)(A.ws + WS_FOUR);
    bf16* YMIX = (bf16*)(A.ws + WS_YMIX); const float* gf = A.in[15];
    const int g = lane >> 3, jl = lane & 7, nbl = (lane & ~7) | ((lane + 1) & 7);
    float gf0[8], gf1[8];
#pragma unroll
    for (int q = 0; q < 2; ++q) { const f32x4 v0 = *(const f32x4*)(gf + g * 128 + 8 * jl + 4 * q), v1 = *(const f32x4*)(gf + g * 128 + 8 * (15 - jl) + 4 * q);
#pragma unroll
        for (int e = 0; e < 4; ++e) { gf0[4 * q + e] = v0[e]; gf1[4 * q + e] = v1[e]; } }
    auto unpack = [&](const v4u a, float* o) { o[0] = bf_lo(a.x); o[1] = bf_hi(a.x); o[2] = bf_lo(a.y); o[3] = bf_hi(a.y); o[4] = bf_lo(a.z); o[5] = bf_hi(a.z); o[6] = bf_lo(a.w); o[7] = bf_hi(a.w); };
    auto put = [&](int t, const float* c0, float nb, const float* c1, float r) {
        const float r8 = r * YMIX_SCALE; v2u o0, o1;
        o0.x = pk4_fp8(c0[0] * r8 * gf0[0], c0[1] * r8 * gf0[1], c0[2] * r8 * gf0[2], c0[3] * r8 * gf0[3]); o0.y = pk4_fp8(c0[4] * r8 * gf0[4], c0[5] * r8 * gf0[5], c0[6] * r8 * gf0[6], c0[7] * r8 * gf0[7]);
        o1.x = pk4_fp8(nb * r8 * gf1[0], c1[7] * r8 * gf1[1], c1[6] * r8 * gf1[2], c1[5] * r8 * gf1[3]); o1.y = pk4_fp8(c1[4] * r8 * gf1[4], c1[3] * r8 * gf1[5], c1[2] * r8 * gf1[6], c1[1] * r8 * gf1[7]);
        unsigned char* dst = (unsigned char*)YMIX + (size_t)t * D + DL + g * 128;
        *(GAS v2u*)(dst + 8 * jl) = o0; *(GAS v2u*)(dst + 8 * (15 - jl)) = o1; };
    for (int it0 = gw * 8; it0 < NB * 2048; it0 += NGW * 8) {
        const int b = it0 >> 11, kp0 = it0 & 2047;
        float wv[8]; unpack(*(const GAS v4u*)(FOUR + ((size_t)b * SEQ + 2048) * DF + g * 128 + jl * 8), wv);
        v4u ra[8], rb[8]; float nq[8];
#pragma unroll
        for (int j = 0; j < 8; ++j) { const bf16* row = AB + ((size_t)b * 2048 + kp0 + j) * 1024 + g * 64 + jl * 8;
            ra[j] = *(const GAS v4u*)row; rb[j] = *(const GAS v4u*)(row + 512); nq[j] = misc[MS_NYQ + (size_t)(b * 8 + g) * P64_LD + kp0 + j]; }
#pragma unroll
        for (int j = 0; j < 8; ++j) {
            const int kp = kp0 + j; const float sk = (kp & 1) ? -1.0f : 1.0f;
            float av[8], bv[8], y0[8], y1[8]; unpack(ra[j], av); unpack(rb[j], bv);
            float ss = 0.f;
#pragma unroll
            for (int i = 0; i < 8; ++i) { const float a = av[i] + sk * wv[i]; y0[i] = a + bv[i]; y1[i] = a - bv[i]; }
            if (jl == 0) { y0[0] = av[0] + sk * wv[0]; y1[0] = nq[j]; }
#pragma unroll
            for (int i = 0; i < 8; ++i) ss += y0[i] * y0[i] + y1[i] * y1[i];
            const float r = 1.0f / sqrtf(wave_sum(ss) * (1.0f / DF) + EPS);
            put(b * SEQ + kp, y0, __shfl(y1[0], nbl), y1, r);
            if (kp >= 1) {
                const float e2 = (jl == 0) ? y1[0] : y0[0];
                if (jl != 0) y0[0] = y1[0];
                float m0[8]; m0[0] = y0[0];
#pragma unroll
                for (int i = 1; i < 8; ++i) m0[i] = y1[i];
                put(b * SEQ + SEQ - kp, m0, __shfl(e2, nbl), y0, r);
            }
        }
        if (kp0 == 0) {
            float av[8];
#pragma unroll
            for (int i = 0; i < 8; ++i) av[i] = wv[i];
#pragma unroll 8
            for (int nb = 0; nb < 32; ++nb) { const float* p = misc + MS_ALT + ((size_t)b * 32 + nb) * 512 + g * 64 + jl * 8; const f32x4 p0 = *(const f32x4*)p, p1 = *(const f32x4*)(p + 4);
                av[0] += p0[0]; av[1] += p0[1]; av[2] += p0[2]; av[3] += p0[3]; av[4] += p1[0]; av[5] += p1[1]; av[6] += p1[2]; av[7] += p1[3]; }
            float y1[8];
#pragma unroll
            for (int i = 0; i < 8; ++i) y1[i] = av[i];
            if (jl == 0) y1[0] = misc[MS_NYQ + (size_t)(b * 8 + g) * P64_LD + 2048];
            float ss = 0.f;
#pragma unroll
            for (int i = 0; i < 8; ++i) ss += av[i] * av[i] + y1[i] * y1[i];
            const float r = 1.0f / sqrtf(wave_sum(ss) * (1.0f / DF) + EPS);
            put(b * SEQ + 2048, av, __shfl(y1[0], nbl), y1, r);
        }
    }
}
}
namespace mk {
struct SchedTiles {      static constexpr bool DSTPF = false;
    const char* Abase; const char* Bbase; int nM, nN, G, c; unsigned lda_b, ldb_b;
    __device__ __forceinline__ bool next(int i, pg8::Unit& u) {
        const int L = i * G + c; if (L >= nM * nN) return false;
        int pm, pn; tile_order(L, nM, nN, pm, pn);
        u.pm = pm; u.pn = pn; u.aux0 = 0; u.aux1 = 0; u.nt = 0; u.a = Abase + (size_t)pm * 256 * lda_b; u.b = Bbase + (size_t)pn * 256 * ldb_b; return true;
    }
};
struct EpiBf16 {
    static constexpr int NST = 16;
    static __device__ __forceinline__ int a_row(int h, int R) { return 128 * h + R; }
    bf16* O; int ldc;
    __device__ __forceinline__ void operator()(f32x4 (&acc)[2][2][4][2], const pg8::Unit& u, int wr, int wc, int fr, int fq, LAS unsigned char*) const {
        const int row0 = u.pm * 256 + wr * 64 + fr, col0 = u.pn * 256 + wc * 32 + 8 * fq;
#pragma unroll
        for (int ai = 0; ai < 2; ++ai)
#pragma unroll
            for (int m = 0; m < 4; ++m) { const unsigned off = ((unsigned)(row0 + ai * 128 + m * 16) * (unsigned)ldc + col0) * 2u;
#pragma unroll
                for (int bj = 0; bj < 2; ++bj) { const f32x4 v0 = acc[ai][bj][m][0], v1 = acc[ai][bj][m][1];
                    v4u w; w.x = cvt_pk_bf16(v0[0], v0[1]); w.y = cvt_pk_bf16(v0[2], v0[3]); w.z = cvt_pk_bf16(v1[0], v1[1]); w.w = cvt_pk_bf16(v1[2], v1[3]);
                    *(GAS v4u*)((GAS char*)O + off + bj * 256) = w; } }
    }
};

constexpr int P8_BPITCH = 264;
template <int PART = 3>
__device__ __forceinline__ void p8_ln_router(const Args& A, LAS unsigned char* lds, int tid, int lane, int wave, int vcu, int G) {
    const float* mod = (const float*)(A.ws + WS_MOD); const bf16* MIX = (const bf16*)(A.ws + WS_MIX);
    bf16* H2LO = (bf16*)(A.ws + WS_H2LO); unsigned* H2F8 = (unsigned*)(A.ws + WS_H2F8); const bf16* WR = (const bf16*)(A.ws + WS_WR);
    int* cnt = (int*)(A.ws + WS_CTL) + CW_CNT; int* rt_tok = (int*)(A.ws + WS_ROUTE + RT_TOK); int* rt_dst = (int*)(A.ws + WS_ROUTE + RT_DST); float* rt_w = (float*)(A.ws + WS_ROUTE + RT_W);
    LAS bf16* bl = (LAS bf16*)lds;
    LAS float* lg = (LAS float*)(lds + 2 * 64 * P8_BPITCH * 2) + wave * (16 * 65);
    { const int gw = vcu * NWAVES + wave, NGW = G * NWAVES;
      for (int i = gw * 64 + lane; i < T; i += NGW * 64) { const int s = i / TS, tl = i % TS; rt_tok[((size_t)s * NEX + NE) * TS + tl] = tl; rt_dst[((size_t)s * NEX + NE) * TS + tl] = tl * 9 + 8; } }
    for (int tb = vcu; tb < T / 128; tb += G) {
        const int t0 = tb * 128 + wave * 16;
        LAS f32x4* pv = (LAS f32x4*)lds;
        {   const int b = (tb * 128) / SEQ; __syncthreads();
            const f32x4* s0 = (const f32x4*)(mod + (size_t)b * MODW + 2 * D); const f32x4* s1 = (const f32x4*)A.in[17]; const f32x4* s2 = (const f32x4*)A.in[18];
            const f32x4* s3 = (const f32x4*)(mod + (size_t)b * MODW + 3 * D); const f32x4* s4 = (const f32x4*)(mod + (size_t)b * MODW + 4 * D);
            pv[tid] = s0[tid]; pv[512 + tid] = s1[tid]; pv[1024 + tid] = s2[tid]; pv[1536 + tid] = s3[tid]; pv[2048 + tid] = s4[tid];
            __syncthreads(); }
        f32x4 lacc[4]; const int arow = lane & 15, akq = lane >> 4;
        if (PART & 1)
        for (int i = 0; i < 16; i += 2) {
            asm volatile("" ::: "memory");
            const int t = t0 + i;
            const GAS f32x4* xr = (const GAS f32x4*)(A.in[0] + (size_t)t * D) + lane; const GAS v2u* mr = (const GAS v2u*)(MIX + (size_t)t * D) + lane;
            const LAS f32x4* g1 = pv + lane;
            f32x4 v[8], u[8]; float s = 0.f, q = 0.f;
#pragma unroll
            for (int j = 0; j < 8; ++j) { const f32x4 xv = __builtin_nontemporal_load(xr + 64 * j), xw = __builtin_nontemporal_load(xr + 64 * j + 512), gv = g1[64 * j]; const v2u mv = __builtin_nontemporal_load(mr + 64 * j), mw = __builtin_nontemporal_load(mr + 64 * j + 512);
                v[j] = xv * ALPHA + gv * (f32x4){bf_lo(mv.x), bf_hi(mv.x), bf_lo(mv.y), bf_hi(mv.y)}; s += (v[j].x + v[j].y) + (v[j].z + v[j].w);
                u[j] = xw * ALPHA + gv * (f32x4){bf_lo(mw.x), bf_hi(mw.x), bf_lo(mw.y), bf_hi(mw.y)}; q += (u[j].x + u[j].y) + (u[j].z + u[j].w); }
            float mean = wave_sum(s) * (1.f / D), meanu = wave_sum(q) * (1.f / D), s2 = 0.f, q2 = 0.f;
#pragma unroll
            for (int j = 0; j < 8; ++j) { v[j] = v[j] - mean; u[j] = u[j] - meanu; s2 += (v[j].x * v[j].x + v[j].y * v[j].y) + (v[j].z * v[j].z + v[j].w * v[j].w); q2 += (u[j].x * u[j].x + u[j].y * u[j].y) + (u[j].z * u[j].z + u[j].w * u[j].w); }
            float rstd = 1.f / sqrtf(wave_sum(s2) * (1.f / D) + EPS), rstdu = 1.f / sqrtf(wave_sum(q2) * (1.f / D) + EPS);
            const LAS f32x4* lg1 = pv + 512 + lane; const LAS f32x4* lb1 = pv + 1024 + lane; GAS v2u* xo = (GAS v2u*)(A.out + (size_t)t * D) + lane;
            s = 0.f; q = 0.f;
#pragma unroll
            for (int j = 0; j < 8; ++j) { const f32x4 lg = lg1[64 * j], lb = lb1[64 * j]; v[j] = v[j] * rstd * lg + lb; u[j] = u[j] * rstdu * lg + lb; { v2u o; o.x = pk2(v[j].x, v[j].y); o.y = pk2(v[j].z, v[j].w); xo[64 * j] = o; o.x = pk2(u[j].x, u[j].y); o.y = pk2(u[j].z, u[j].w); xo[64 * j + 1024] = o; }
                s += (v[j].x + v[j].y) + (v[j].z + v[j].w); q += (u[j].x + u[j].y) + (u[j].z + u[j].w); }
            mean = wave_sum(s) * (1.f / D); meanu = wave_sum(q) * (1.f / D); s2 = 0.f; q2 = 0.f;
#pragma unroll
            for (int j = 0; j < 8; ++j) { v[j] = v[j] - mean; u[j] = u[j] - meanu; s2 += (v[j].x * v[j].x + v[j].y * v[j].y) + (v[j].z * v[j].z + v[j].w * v[j].w); q2 += (u[j].x * u[j].x + u[j].y * u[j].y) + (u[j].z * u[j].z + u[j].w * u[j].w); }
            rstd = 1.f / sqrtf(wave_sum(s2) * (1.f / D) + EPS); rstdu = 1.f / sqrtf(wave_sum(q2) * (1.f / D) + EPS);
            const LAS f32x4* sh2 = pv + 1536 + lane; const LAS f32x4* sc2 = pv + 2048 + lane;
#pragma unroll
            for (int tt = 0; tt < 2; ++tt) {
                GAS v2u* ol = (GAS v2u*)(H2LO + (size_t)(t + tt) * D) + lane; GAS unsigned* o8 = (GAS unsigned*)(H2F8 + (size_t)(t + tt) * (D / 4)) + lane;
#pragma unroll
                for (int j = 0; j < 8; ++j) { const f32x4 y = (tt ? u[j] * rstdu : v[j] * rstd) * (sc2[64 * j] + 1.0f) + sh2[64 * j];
                    const unsigned p8 = pk4_fp8(y.x, y.y, y.z, y.w); o8[64 * j] = p8; const f32x4 yq = fp8x4_to_f32(p8);
                    v2u o; o.x = pk2(y.x - yq.x, y.y - yq.y); o.y = pk2(y.z - yq.z, y.w - yq.w); ol[64 * j] = o; }
            }
        }
        VM_WAIT();
        if (!(PART & 2)) continue;
#pragma unroll
        for (int n = 0; n < 4; ++n) lacc[n] = (f32x4){0.f, 0.f, 0.f, 0.f};
        v4u wreg[8]; v2u araw[2][8]; bf16x8 areg[2][8];
        auto ldw = [&](int kc) {
#pragma unroll
            for (int q = 0; q < 8; ++q) { const int p = q * NTHR + tid, rowi = p >> 5, piece = p & 31; wreg[q] = *(const GAS v4u*)(WR + (size_t)rowi * D + kc * 256 + piece * 8); } };
        auto lda = [&](int kc, int buf) {
#pragma unroll
            for (int ks = 0; ks < 8; ++ks) { const size_t aoff = (size_t)(t0 + arow) * D + kc * 256 + ks * 32 + akq * 8;
                araw[buf][ks] = *(const GAS v2u*)((const unsigned char*)H2F8 + aoff); areg[buf][ks] = __builtin_nontemporal_load((const GAS bf16x8*)(H2LO + aoff)); } };
        ldw(0); lda(0, 0);
#pragma unroll
        for (int kc = 0; kc < 8; ++kc) {
            __syncthreads();
#pragma unroll
            for (int q = 0; q < 8; ++q) { const int p = q * NTHR + tid, rowi = p >> 5, piece = p & 31; *(LAS v4u*)(bl + rowi * P8_BPITCH + piece * 8) = wreg[q]; }
            __syncthreads();
            if (kc + 1 < 8) { ldw(kc + 1); lda(kc + 1, (kc + 1) & 1); }
#pragma unroll
            for (int ks = 0; ks < 8; ++ks) {
                const bf16x8 al = areg[kc & 1][ks]; bf16x8 ah;
                {   const v2u q = araw[kc & 1][ks]; v4u hb; hb.x = fp8x2_to_bf16x2(q.x, false); hb.y = fp8x2_to_bf16x2(q.x, true); hb.z = fp8x2_to_bf16x2(q.y, false); hb.w = fp8x2_to_bf16x2(q.y, true);
                    ah = __builtin_bit_cast(bf16x8, hb); }
#pragma unroll
                for (int n = 0; n < 4; ++n) {
                    const bf16x8 bh = *(const LAS bf16x8*)(bl + (n * 16 + arow) * P8_BPITCH + ks * 32 + akq * 8);
                    const bf16x8 blo = *(const LAS bf16x8*)(bl + (64 + n * 16 + arow) * P8_BPITCH + ks * 32 + akq * 8);
                    lacc[n] = __builtin_amdgcn_mfma_f32_16x16x32_bf16(ah, bh, lacc[n], 0, 0, 0);
                    lacc[n] = __builtin_amdgcn_mfma_f32_16x16x32_bf16(al, bh, lacc[n], 0, 0, 0);
                    lacc[n] = __builtin_amdgcn_mfma_f32_16x16x32_bf16(ah, blo, lacc[n], 0, 0, 0);
                }
            }
        }
#pragma unroll
        for (int n = 0; n < 4; ++n)
#pragma unroll
            for (int r = 0; r < 4; ++r) lg[(4 * akq + r) * 65 + 16 * n + arow] = lacc[n][r];
        LDS_WAIT(); asm volatile("" ::: "memory");
        const float rb = A.in[20][lane];
        unsigned cmask = 0u;
#pragma unroll 2
        for (int i = 0; i < 16; ++i) {
            const float z = lg[i * 65 + lane]; const float sc = 1.0f / (1.0f + expf(-z)); const float sel = sc + rb;
            const float m1 = group8_max(sel);
            const unsigned long long eq = __ballot(sel == m1); const unsigned grp = (unsigned)(eq >> (lane & ~7)) & 0xffu; const int first = __builtin_ctz(grp | 0x100u);
            const float m2 = group8_max(((lane & 7) == first) ? -1e30f : sel);
            const float gs = m1 + m2; const int g = lane >> 3;
            int grank = 0;
#pragma unroll
            for (int qq = 0; qq < 8; ++qq) { const float o = __builtin_bit_cast(float, __builtin_amdgcn_readlane(__builtin_bit_cast(int, gs), qq * 8)); grank += (o > gs || (o == gs && qq < g)) ? 1 : 0; }
            const bool allowed = grank < 4;
            const float msel = allowed ? sel : -1e30f;
            int kb = __builtin_bit_cast(int, msel); kb ^= (kb >> 31) & 0x7fffffff; const int key = (kb & ~63) | (63 - lane);
            int rank = 0;
#pragma unroll
            for (int qq = 0; qq < 64; ++qq) { const int o = __builtin_amdgcn_readlane(key, qq); rank += (o > key) ? 1 : 0; }
            const bool chosen = allowed && rank < 8;
            const float wsum = wave_sum(chosen ? sc : 0.f);
            cmask |= (chosen ? 1u : 0u) << i;
            lg[i * 65 + lane] = sc; if (lane == 0) lg[i * 65 + 64] = 2.5f / (wsum + 1e-20f);
        }
        {   const int sl = t0 / TS, ncho = __builtin_popcount(cmask);
            int base = 0; if (ncho) base = atomicAdd(&cnt[sl * 64 + lane], ncho);
            for (int i = 0; i < 16; ++i) {
                const bool chosen = (cmask >> i) & 1u; const unsigned long long cm = __ballot(chosen);
                if (chosen) {
                    const int t = t0 + i, tl = t % TS, j = __builtin_popcountll(cm & ((1ull << lane) - 1ull)), pos = base + __builtin_popcount(cmask & ((1u << i) - 1u));
                    rt_tok[((size_t)sl * NEX + lane) * TS + pos] = tl; rt_dst[((size_t)sl * NEX + lane) * TS + pos] = tl * 9 + j;
                    rt_w[(size_t)t * 8 + j] = lg[i * 65 + lane] * lg[i * 65 + 64];
                }
            }
        }
    }
}

struct MoeTab { LAS int* ucum; LAS int* segoff; LAS int* cnt; LAS int* idbuf; LAS int* myexp; };
__device__ __forceinline__ MoeTab moe_tab(LAS unsigned char* lds) { MoeTab m; m.ucum = (LAS int*)(lds + SCR_OFF); m.segoff = m.ucum + 72; m.cnt = m.segoff + 72; m.idbuf = m.cnt + 72; m.myexp = m.idbuf + 768; return m; }
__device__ __forceinline__ void moe_tables(const Args& A, LAS unsigned char* lds, int s, int ctiles, int tid, int G, int c) {
    MoeTab m = moe_tab(lds); const int* cnt = (const int*)(A.ws + WS_CTL) + CW_CNT + s * 64;
    __syncthreads();
    if (tid < 64) m.cnt[tid] = __hip_atomic_load(cnt + tid, RLX_AGENT);
    if (tid == 64) m.cnt[64] = TS;
    __syncthreads();
    if (tid == 0) { int u = 0, r = 0; for (int e = 0; e < NEX; ++e) { m.ucum[e] = u; m.segoff[e] = r; const int tl = (m.cnt[e] + 255) >> 8; u += tl * ctiles; r += tl * 256; } m.ucum[NEX] = u; }
    __syncthreads();
    if (tid < 256) { const int L = tid * G + c; int e = -1; if (L < m.ucum[NEX]) { e = 0; for (int q = 1; q < NEX; ++q) e += (m.ucum[q] <= L) ? 1 : 0; } m.myexp[tid] = e; }
    __syncthreads();
}
template <bool DSTPF_> struct SchedMoe {
    static constexpr bool DSTPF = DSTPF_;
    const int* dsts;
    MoeTab tb; const char* Abase; const char* Bbase; const int* lists; int G, c, ctiles; unsigned a_pitch, bexp_bytes, btile_bytes; bool gather;
    __device__ __forceinline__ bool next(int i, pg8::Unit& u) {
        if (i >= 256) return false; const int e = tb.myexp[i]; if (e < 0) return false; const int L = i * G + c;
        const int r = L - tb.ucum[e], rt = r / ctiles, ct = r % ctiles;
        u.pm = rt; u.pn = ct | ((i % 3) << 8); u.aux0 = e; u.aux1 = tb.segoff[e] + rt * 256; u.nt = 0;
        u.a = gather ? Abase : Abase + (size_t)u.aux1 * a_pitch; u.b = Bbase + (size_t)e * bexp_bytes + (size_t)ct * btile_bytes; return true;
    }
    __device__ __forceinline__ unsigned row_off_global(const pg8::Unit& u, int row) const {
        const int n = tb.cnt[u.aux0]; int idx = u.pm * 256 + row; idx = idx < n ? idx : n - 1;
        return (unsigned)lists[(size_t)u.aux0 * TS + idx] * a_pitch;
    }
    __device__ __forceinline__ void prefetch_rows(const pg8::Unit& u, int ui, LAS unsigned char* lds, int wid, int lane) const {
        if (wid < 4) { const int n = tb.cnt[u.aux0]; int idx = u.pm * 256 + wid * 64 + lane; idx = idx < n ? idx : n - 1;
            __builtin_amdgcn_global_load_lds((const unsigned*)(lists + (size_t)u.aux0 * TS + idx), (LAS unsigned*)(tb.idbuf + (ui & 1) * 256 + wid * 64), 4, 0, 0); }
    }
    __device__ __forceinline__ void prefetch_dst(const pg8::Unit& u, int ui, int wid, int lane) const {
        if (wid < 4) { const int n = tb.cnt[u.aux0]; int idx = u.pm * 256 + wid * 64 + lane; idx = idx < n ? idx : n - 1;
            __builtin_amdgcn_global_load_lds((const unsigned*)(dsts + (size_t)u.aux0 * TS + idx), (LAS unsigned*)(tb.idbuf + (ui % 3) * 256 + wid * 64), 4, 0, 0); }
    }
    __device__ __forceinline__ unsigned row_off_lds(int ui, int row, LAS unsigned char*) const { return (unsigned)tb.idbuf[(ui & 1) * 256 + row] * a_pitch; }
};
struct EpiGU {
#if defined(GU_DRY)
    static constexpr int NST = 0;
#else
    static constexpr int NST = 8;
#endif
    static __device__ __forceinline__ int a_row(int h, int R) { return 128 * h + R; }
    unsigned char* ACT; bool dry;
    __device__ __forceinline__ void operator()(f32x4 (&acc)[2][2][4][2], const pg8::Unit& u, int wr, int wc, int fr, int fq, LAS unsigned char*) const {
        if (dry) { float s = 0.f;
#pragma unroll
            for (int ai = 0; ai < 2; ++ai)
#pragma unroll
                for (int bj = 0; bj < 2; ++bj)
#pragma unroll
                    for (int m = 0; m < 4; ++m)
#pragma unroll
                        for (int n2 = 0; n2 < 2; ++n2) s += acc[ai][bj][m][n2][0] + acc[ai][bj][m][n2][1] + acc[ai][bj][m][n2][2] + acc[ai][bj][m][n2][3];
            if (s == 1.2345e-30f) ACT[0] = 0; return; }
        const int row0 = u.aux1 + wr * 64 + fr, col0 = (u.pn & 255) * 128 + wc * 32 + 8 * fq;
#pragma unroll
        for (int ai = 0; ai < 2; ++ai)
#pragma unroll
            for (int m = 0; m < 4; ++m) { const unsigned off = (unsigned)(row0 + ai * 128 + m * 16) * DE + col0;
                f32x4 a0, a1;
#pragma unroll
                for (int e = 0; e < 4; ++e) { a0[e] = silu_f(acc[ai][0][m][0][e]) * acc[ai][1][m][0][e]; a1[e] = silu_f(acc[ai][0][m][1][e]) * acc[ai][1][m][1][e]; }
                v2u w; w.x = pk4_fp8(a0[0], a0[1], a0[2], a0[3]); w.y = pk4_fp8(a1[0], a1[1], a1[2], a1[3]);
                *(GAS v2u*)((GAS char*)ACT + off) = w; }
    }
};
struct EpiDN {
#if defined(DN_DRY)
    static constexpr int NST = 0;
#else
    static constexpr int NST = 8;
#endif
    static __device__ __forceinline__ int a_row(int h, int R) { return 128 * h + R; }
    unsigned char* OUTTOK; LAS int* idbuf; LAS int* cnt; bool dry;
    __device__ __forceinline__ void operator()(f32x4 (&acc)[2][2][4][2], const pg8::Unit& u, int wr, int wc, int fr, int fq, LAS unsigned char*) const {
        if (dry) { float s = 0.f;
#pragma unroll
            for (int ai = 0; ai < 2; ++ai)
#pragma unroll
                for (int bj = 0; bj < 2; ++bj)
#pragma unroll
                    for (int m = 0; m < 4; ++m)
#pragma unroll
                        for (int n2 = 0; n2 < 2; ++n2) s += acc[ai][bj][m][n2][0] + acc[ai][bj][m][n2][1] + acc[ai][bj][m][n2][2] + acc[ai][bj][m][n2][3];
            if (s == 1.2345e-30f) OUTTOK[0] = 0; return; }
        int tz = threadIdx.x; asm volatile("" : "+v"(tz)); fr = tz & 15; fq = (tz >> 4) & 3;
        const int n = cnt[u.aux0], rl0 = u.pm * 256 + wr * 64 + fr, col0 = (u.pn & 255) * 256 + wc * 64 + 16 * fq;
        const LAS int* dl = idbuf + (u.pn >> 8) * 256 - u.pm * 256;
#pragma unroll
        for (int ai = 0; ai < 2; ++ai)
#pragma unroll
            for (int m = 0; m < 4; ++m) { const int rl = rl0 + ai * 128 + m * 16;
                {
                    const unsigned off = (rl < n) ? (unsigned)dl[rl] * D + col0 : (unsigned)(WS_H2F8 - WS_OUTTOK) + (unsigned)(tz & 511) * 16u;
                    const f32x4 v0 = acc[ai][0][m][0], v1 = acc[ai][0][m][1], v2 = acc[ai][1][m][0], v3 = acc[ai][1][m][1];
                    v4u w; w.x = pk4_fp8(v0[0], v0[1], v0[2], v0[3]); w.y = pk4_fp8(v1[0], v1[1], v1[2], v1[3]); w.z = pk4_fp8(v2[0], v2[1], v2[2], v2[3]); w.w = pk4_fp8(v3[0], v3[1], v3[2], v3[3]);
                    *(GAS v4u*)((GAS char*)OUTTOK + off) = w; } }
    }
};
__device__ __forceinline__ void moe_combine(const Args& A, LAS unsigned char* lds, int s, int tid, int lane, int wave, int vcu, int G, float* wout, float oscale = 1.0f, float oadd = 0.0f, int tmask = 0x7fffffff) {
    const int gw = vcu * NWAVES + wave, NGW = G * NWAVES;
    const float* mod = (const float*)(A.ws + WS_MOD); const unsigned char* OT = A.ws + WS_OUTTOK; const float* rt_w = (const float*)(A.ws + WS_ROUTE + RT_W);
    LAS f32x4* pv = (LAS f32x4*)lds;
    for (int tb = vcu; tb < TS / 128; tb += G) {
      { const int b = (s * TS + tb * 128) / SEQ; __syncthreads();
        pv[tid] = ((const f32x4*)(mod + (size_t)b * MODW + 5 * D))[tid]; pv[512 + tid] = ((const f32x4*)A.in[27])[tid]; pv[1024 + tid] = ((const f32x4*)A.in[28])[tid];
        __syncthreads(); }
      for (int i = 0; i < 16; ++i) {
        asm volatile("" ::: "memory");
        const int tl = tb * 128 + wave * 16 + i, t = s * TS + tl;
        const GAS v4u* xb = (const GAS v4u*)(A.out + (size_t)t * D) + 2 * lane; GAS f32x4* yo = (GAS f32x4*)(wout + (size_t)(t & tmask) * D) + 4 * lane;
        const LAS f32x4* g2 = pv + 4 * lane;
        const GAS v4u* rows = (const GAS v4u*)(OT + (size_t)tl * 9 * D) + lane;
        float w[8];
        { const f32x4 w0 = *(const GAS f32x4*)(rt_w + (size_t)t * 8), w1 = *(const GAS f32x4*)(rt_w + (size_t)t * 8 + 4); w[0] = w0[0]; w[1] = w0[1]; w[2] = w0[2]; w[3] = w0[3]; w[4] = w1[0]; w[5] = w1[1]; w[6] = w1[2]; w[7] = w1[3]; }
        v4u q[9][2];
#pragma unroll
        for (int k = 0; k < 9; ++k)
#pragma unroll
            for (int j = 0; j < 2; ++j) q[k][j] = __builtin_nontemporal_load(rows + k * 128 + 64 * j);
        v4u xq[2][2];
#pragma unroll
        for (int j = 0; j < 2; ++j) { xq[j][0] = xb[128 * j]; xq[j][1] = xb[128 * j + 1]; }
        f32x4 f[8]; float sm = 0.f;
#pragma unroll
        for (int j = 0; j < 2; ++j) {
            f32x4 a[4];
            a[0] = fp8x4_to_f32(q[8][j].x); a[1] = fp8x4_to_f32(q[8][j].y); a[2] = fp8x4_to_f32(q[8][j].z); a[3] = fp8x4_to_f32(q[8][j].w);
#pragma unroll
            for (int k = 0; k < 8; ++k) { a[0] = a[0] + w[k] * fp8x4_to_f32(q[k][j].x); a[1] = a[1] + w[k] * fp8x4_to_f32(q[k][j].y); a[2] = a[2] + w[k] * fp8x4_to_f32(q[k][j].z); a[3] = a[3] + w[k] * fp8x4_to_f32(q[k][j].w); }
#pragma unroll
            for (int i = 0; i < 4; ++i) { const unsigned x0 = (i < 2) ? ((i & 1) ? xq[j][0].z : xq[j][0].x) : ((i & 1) ? xq[j][1].z : xq[j][1].x), x1 = (i < 2) ? ((i & 1) ? xq[j][0].w : xq[j][0].y) : ((i & 1) ? xq[j][1].w : xq[j][1].y);
                const f32x4 y = (f32x4){bf_lo(x0), bf_hi(x0), bf_lo(x1), bf_hi(x1)} * ALPHA + g2[256 * j + i] * (a[i] * 0.0625f); f[4 * j + i] = y; sm += (y.x + y.y) + (y.z + y.w); }
        }
        const float mean = wave_sum(sm) * (1.f / D); float s2 = 0.f;
#pragma unroll
        for (int j = 0; j < 8; ++j) { f[j] = f[j] - mean; s2 += (f[j].x * f[j].x + f[j].y * f[j].y) + (f[j].z * f[j].z + f[j].w * f[j].w); }
        const float rstd = 1.f / sqrtf(wave_sum(s2) * (1.f / D) + EPS);
        const LAS f32x4* lg2 = pv + 512 + 4 * lane; const LAS f32x4* lb2 = pv + 1024 + 4 * lane;
#pragma unroll
        for (int j = 0; j < 2; ++j)
#pragma unroll
            for (int i = 0; i < 4; ++i) {
#if defined(MK_STAMP_A)
                f32x4 o = (f[4 * j + i] * rstd * lg2[256 * j + i] + lb2[256 * j + i]) * oscale; if (t == 0 && lane == 0 && j == 0 && i == 0) o.x += oadd; yo[256 * j + i] = o;
#else
                yo[256 * j + i] = f[4 * j + i] * rstd * lg2[256 * j + i] + lb2[256 * j + i];
#endif
            }
      }
    }
}
}
namespace mk {
#ifndef GU_DRY
#define GU_DRY 0
#endif
#ifndef DN_DRY
#define DN_DRY 0
#endif
#ifndef DBL_MASK
#define DBL_MASK 0
#endif
#define REPS(k) for (int rep_ = 0; rep_ < (((DBL_MASK) >> (k)) & 1) + 1; ++rep_)
#ifndef MK_LAST_PHASE
#define MK_LAST_PHASE 2
#endif
__global__ void __launch_bounds__(NTHR, 2) mk_fwd(Args args) {
    extern __shared__ __attribute__((aligned(16))) unsigned char lds_raw[];
    LAS unsigned char* lds = (LAS unsigned char*)lds_raw;
    volatile LAS unsigned* MISC = (volatile LAS unsigned*)(lds + LDSCTL_OFF);
    const int tid = threadIdx.x, lane = tid & 63, wave = __builtin_amdgcn_readfirstlane(tid >> 6);
    const int G = gridDim.x; const int bx = blockIdx.x; const int vcu = (G % 8 == 0) ? (bx % 8) * (G / 8) + bx / 8 : bx;
    unsigned* ctl = (unsigned*)(args.ws + WS_CTL);
    for (int u = tid; u < (LDS_BYTES - LDSCTL_OFF) / 4; u += NTHR) ((LAS unsigned*)(lds + LDSCTL_OFF))[u] = 0u;
    __syncthreads();
    XcdBarrier bar = xcd_barrier_post(ctl + CW_BAR + args.li * XCD_BAR_WORDS, MISC + 8);
    const int lo = args.ph_lo, hi = args.ph_hi;
    float g_oscale = 1.0f, g_oadd = 0.0f;
#define IN(k) (lo <= (k) && (k) < hi)
#define BOTH(k) (IN(k) && IN((k) + 1))
#ifndef MK_STAMP_OFF
#define MK_STAMP_OFF 0.f
#endif
#ifndef MK_STAMP_BIN
#define MK_STAMP_BIN 20.f
#endif
#if defined(MK_STAMP_A)
#ifndef MK_STAMP_AE
#define MK_STAMP_AE (MK_STAMP_A + 1)
#endif
    volatile unsigned long long* stamps = (volatile unsigned long long*)(ctl + 16384); int nst = 1;
    if (bx == 0 && tid == 0) stamps[0] = __builtin_amdgcn_s_memrealtime();
#define GRID_BAR() do { xcd_barrier(bar); if (bx == 0 && tid == 0) stamps[nst] = __builtin_amdgcn_s_memrealtime(); ++nst; } while (0)
#else
#define GRID_BAR() xcd_barrier(bar)
#endif
#define OPQ() int tq = threadIdx.x; asm volatile("" : "+v"(tq)); const int tidq = tq, laneq = tq & 63

#if defined(MK_SPLIT_P0)
    if (IN(0)) { { OPQ(); p0_adaln(args, lds, tidq, G); } GRID_BAR(); { OPQ(); p0_fold(args, lds, tidq, G); } GRID_BAR(); { OPQ(); p0_weights<1>(args, lds, tidq, laneq, wave, vcu, G); } GRID_BAR();
        { OPQ(); p0_weights<2>(args, lds, tidq, laneq, wave, vcu, G); } GRID_BAR(); { OPQ(); p0_weights<4>(args, lds, tidq, laneq, wave, vcu, G); } if (BOTH(0)) GRID_BAR(); }
#else
    if (IN(0)) { REPS(0) { OPQ(); p0_adaln(args, lds, tidq, G); p0_fold(args, lds, tidq, G); p0_weights(args, lds, tidq, laneq, wave, vcu, G); } if (BOTH(0)) GRID_BAR(); }
#endif
    if (IN(1)) { REPS(1) { OPQ(); p1_hnorm(args, laneq, wave, vcu, G); } if (BOTH(1)) GRID_BAR(); }
    if (IN(2)) { REPS(2) {
        SchedInproj S{(const char*)(args.ws + WS_H), (const char*)(args.ws + WS_WIN), G, bx};
        static_assert(WS_GATE == WS_U + (size_t)TT * DL * 2 && WS_FOUR == WS_GATE + (size_t)T * DL * 2, "U|GATE|FOUR contiguous");
        EpiInproj E{(bf16*)(args.ws + WS_U), (bf16*)(args.ws + WS_UPART)};
        pg8::gemm_phase<EpiInproj, SchedInproj, true, false, true, 0x75757575>(lds, D / 128, D, D, S, E); }
        if (BOTH(2)) GRID_BAR();
    }
#ifndef SKIP_P3
    #if defined(MK_SPLIT_P3)
    if (IN(3)) { { OPQ(); p3_conv(args, laneq, wave, vcu, G); } GRID_BAR(); { OPQ(); p3_fold(args, lds, laneq, wave, vcu, G); } if (BOTH(3)) GRID_BAR(); }
#else
    if (IN(3)) { REPS(3) { OPQ(); p3_conv(args, laneq, wave, vcu, G); p3_fold(args, lds, laneq, wave, vcu, G); } if (BOTH(3)) GRID_BAR(); }
#endif
#endif
    if (IN(4)) { REPS(4) {
#ifndef SKIP_DFT
        { SchedDft S{(const char*)(args.ws + WS_CS), (const char*)(args.ws + WS_PQT), G, vcu}; EpiDft E{(bf16*)(args.ws + WS_AB)};
          pg8::gemm_phase<EpiDft, SchedDft, true, false>(lds, 2048 / 64, 4096, 4096, S, E); }
#endif
#if defined(MK_SPLIT_P4)
        GRID_BAR();
#endif
#ifndef SKIP_LRU
        { SchedGates S{(const char*)(args.ws + WS_UC), (const char*)(args.ws + WS_WG4), G, vcu};
          EpiLru E{(const bf16*)(args.ws + WS_UC), args.in[10], args.in[12], (bf16*)(args.ws + WS_S), (bf16*)(args.ws + WS_PF), (bf16*)(args.ws + WS_PB), (float*)(args.ws + WS_MISC)};
          pg8::gemm_phase<EpiLru, SchedGates, false, false>(lds, 256 / 64, DL * 2, 512, S, E); }
#endif
#if !defined(MK_SPLIT_P5)
        { OPQ(); p5a_fix<1>(args, lds, tidq, laneq, wave, vcu, G, G / 2, G - G / 2); }
#endif
        }
        if (BOTH(4)) GRID_BAR();
    }
#ifndef SKIP_P5
#if defined(MK_SPLIT_P5)
    if (IN(5)) { { OPQ(); p5a_fix<1>(args, lds, tidq, laneq, wave, vcu, G); } GRID_BAR(); { OPQ(); p5a_fix<2>(args, lds, tidq, laneq, wave, vcu, G); } if (BOTH(5)) GRID_BAR(); }
#else
    if (IN(5)) { { OPQ(); p5a_fix<2>(args, lds, tidq, laneq, wave, vcu, G); } { OPQ(); p5b_four(args, lds, laneq, wave, vcu, G); } if (BOTH(5)) GRID_BAR(); }
#endif
#if defined(MK_SPLIT_P5)
    if (IN(6)) { REPS(6) { OPQ(); p5b_four(args, lds, laneq, wave, vcu, G); } if (BOTH(6)) GRID_BAR(); }
#endif
#endif
#ifndef SKIP_P7
    if (IN(7)) { REPS(7) {
        SchedTiles S{(const char*)(args.ws + WS_YMIX), (const char*)(args.ws + WS_WOUT), T / 256, D / 256, G, bx, D, D};
        EpiBf16 E{(bf16*)(args.ws + WS_MIX), D};
        pg8::gemm_phase<EpiBf16, SchedTiles, true, false, true, 0x76767676>(lds, D / 128, D, D, S, E); }
        if (BOTH(7)) GRID_BAR();
    }
#endif
#ifndef SKIP_P8
#if defined(MK_SPLIT_P8)
    if (IN(8)) { { OPQ(); p8_ln_router<1>(args, lds, tidq, laneq, wave, vcu, G); } GRID_BAR(); { OPQ(); p8_ln_router<2>(args, lds, tidq, laneq, wave, vcu, G); } if (BOTH(8)) GRID_BAR(); }
#else
    if (IN(8)) { OPQ(); p8_ln_router(args, lds, tidq, laneq, wave, vcu, G); if (BOTH(8)) GRID_BAR(); }
#endif
#endif
#pragma unroll
    for (int s = 0; s < NSLICE; ++s) {
        const int p0 = 9 + 3 * s;
#ifndef SKIP_GU
        if (IN(p0)) { REPS(9) {
            { OPQ(); moe_tables(args, lds, s, 4, tidq, G, vcu); }
            SchedMoe<false> S{nullptr, moe_tab(lds), (const char*)(args.ws + WS_H2F8) + (size_t)s * TS * D, (const char*)(args.ws + WS_WGU), (const int*)(args.ws + WS_ROUTE + RT_TOK) + (size_t)s * NEX * TS, G, vcu, 4, (unsigned)D, 1024u * D, 256u * D, true};
            EpiGU E{args.ws + WS_ACT, (GU_DRY) && rep_ == 0};
            pg8::gemm_phase<EpiGU, SchedMoe<false>, true, true, true, 0x79797979>(lds, D / 128, D, D, S, E); }
            if (BOTH(p0)) GRID_BAR();
        }
#endif
#ifndef SKIP_DN
        if (IN(p0 + 1)) { REPS(10) {
            { OPQ(); moe_tables(args, lds, s, 8, tidq, G, vcu); }
            SchedMoe<true> S{(const int*)(args.ws + WS_ROUTE + RT_DST) + (size_t)s * NEX * TS, moe_tab(lds), (const char*)(args.ws + WS_ACT), (const char*)(args.ws + WS_WD), nullptr, G, vcu, 8, (unsigned)DE, 2048u * DE, 256u * DE, false};
            EpiDN E{args.ws + WS_OUTTOK, moe_tab(lds).idbuf, moe_tab(lds).cnt, (DN_DRY) && rep_ == 0};
            pg8::gemm_phase<EpiDN, SchedMoe<true>, false, false, true, 0x7d7d7d7d>(lds, DE / 128, DE, DE, S, E); }
            if (BOTH(p0 + 1)) GRID_BAR();
        }
#endif
#ifndef SKIP_CB
#if defined(MK_STAMP_A)
        if (IN(p0 + 2)) { xcd_barrier(bar);
            const unsigned long long sa0 = __hip_atomic_load((unsigned long long*)&stamps[MK_STAMP_A], RLX_AGENT), sa1 = __hip_atomic_load((unsigned long long*)&stamps[MK_STAMP_AE], RLX_AGENT);
            const unsigned long long sb0 = __hip_atomic_load((unsigned long long*)&stamps[MK_STAMP_B], RLX_AGENT), sb1 = __hip_atomic_load((unsigned long long*)&stamps[MK_STAMP_B + 1], RLX_AGENT);
            const float ta = floorf(((float)(sa1 - sa0) * 0.01f + (MK_STAMP_OFF)) / (MK_STAMP_BIN)) * (MK_STAMP_BIN), tb = floorf(((float)(sb1 - sb0) * 0.01f + (MK_STAMP_OFF)) / (MK_STAMP_BIN)) * (MK_STAMP_BIN);
            g_oscale = 1.0f + sqrtf(ta * 1e-4f); g_oadd = 1.0f + tb * 0.1f; }
#endif
        if (IN(p0 + 2)) { REPS(11) { OPQ(); moe_combine(args, lds, s, tidq, laneq, wave, vcu, G, (((DBL_MASK >> 11) & 1) && rep_ == 0) ? (float*)(args.ws + WS_ACT) : args.out, g_oscale, g_oadd, (((DBL_MASK >> 11) & 1) && rep_ == 0) ? 16383 : 0x7fffffff); } if (BOTH(p0 + 2)) GRID_BAR(); }
#endif
    }
#undef IN
#undef BOTH
}
}
static int g_grid = 0;
static void mk_launch(void* const* d_in, void* d_out, void* d_ws, hipStream_t stream, int lo, int hi, int li) {
    if (g_grid == 0) {
        int dev = 0, cus = 0; hipGetDevice(&dev); hipDeviceGetAttribute(&cus, hipDeviceAttributeMultiprocessorCount, dev);
        if (hipFuncSetAttribute((const void*)mk::mk_fwd, hipFuncAttributeMaxDynamicSharedMemorySize, mk::LDS_BYTES) != hipSuccess) { fprintf(stderr, "hipFuncSetAttribute failed\n"); g_grid = -1; return; }
        int per_cu = 0; (void)hipOccupancyMaxActiveBlocksPerMultiprocessor(&per_cu, (const void*)mk::mk_fwd, mk::NTHR, mk::LDS_BYTES); (void)hipGetLastError();
        if (per_cu < 1) fprintf(stderr, "occupancy query says %d\n", per_cu);
        g_grid = cus > 0 ? cus : 256;
    }
    if (g_grid < 0) return;
    mk::Args a{}; for (int i = 0; i < 29; ++i) a.in[i] = (const float*)d_in[i];
    a.out = (float*)d_out; a.ws = (unsigned char*)d_ws; a.ph_lo = lo; a.ph_hi = hi; a.li = li; a.pad = 0;
    hipLaunchKernelGGL(mk::mk_fwd, dim3(g_grid), dim3(mk::NTHR), mk::LDS_BYTES, stream, a);
}
extern "C" void kernel_launch(void* const* d_in, const int* in_sizes, int n_in, void* d_out, int out_size, void* d_ws, size_t ws_size, hipStream_t stream) {
    if (ws_size < mk::WS_END) { fprintf(stderr, "workspace too small\n"); return; }
    (void)hipMemsetAsync((unsigned char*)d_ws + mk::WS_CTL, 0, mk::CTL_ZERO_BYTES, stream);
    constexpr int NPH = 9 + 3 * mk::NSLICE;
#if MK_SPLIT
    for (int p = 0; p < NPH; ++p) mk_launch(d_in, d_out, d_ws, stream, p, p + 1, 0);
#else
    mk_launch(d_in, d_out, d_ws, stream, 0, NPH, 0);
#endif
}
```

```cpp
#include <hip/hip_runtime.h>
#include <cstdio>
#include <cstdint>
#define MK_SPLIT 0
#define GAS __attribute__((address_space(1)))
#define LAS __attribute__((address_space(3)))
namespace mk {
constexpr int D = 2048, NB = 8, SEQ = 4096, T = NB * SEQ, CTX = 256, TC = NB * CTX, TT = T + TC;
constexpr int DL = 1024, DF = 1024, DIN = 3072, NE = 64, NEX = 65, DE = 512;
constexpr int MODW = 6 * D;
constexpr float ALPHA = 1.189207115002721f, EPS = 1e-6f, PI2 = 6.283185307179586f;
constexpr int NWAVES = 8, NTHR = 512;
constexpr int NSLICE = 1, TS = T / NSLICE;
constexpr int SLOT_ROWS = TS * 8 + NE * 256 + TS;

typedef unsigned short bf16;
typedef unsigned v4u __attribute__((ext_vector_type(4)));
typedef unsigned v2u __attribute__((ext_vector_type(2)));
typedef float f32x4 __attribute__((ext_vector_type(4)));
typedef float f32x2 __attribute__((ext_vector_type(2)));
typedef short bf16x8 __attribute__((ext_vector_type(8)));
typedef int v8i __attribute__((ext_vector_type(8)));
typedef int v4i __attribute__((ext_vector_type(4)));

constexpr size_t MiB = 1u << 20;
constexpr size_t WS_CTL = 0, CTL_ZERO_BYTES = 1 * MiB;
constexpr size_t WS_MOD = 1 * MiB;
constexpr size_t WS_MISC = 2 * MiB;
constexpr size_t WS_WIN = 10 * MiB;
constexpr size_t WS_WOUT = 22 * MiB;
constexpr size_t WS_WG4 = 30 * MiB;
constexpr size_t WS_WR = 32 * MiB;
constexpr size_t WS_CS = 34 * MiB;
constexpr size_t WS_WGU = 50 * MiB;
constexpr size_t WS_WD = 180 * MiB;
constexpr size_t WS_DYN = 245 * MiB;
constexpr size_t WS_H = WS_DYN;
constexpr size_t WS_PF = WS_DYN, WS_PB = WS_DYN + 64 * MiB;
constexpr size_t WS_MIX = WS_DYN;
constexpr size_t WS_U = WS_DYN + 136 * MiB;
constexpr size_t WS_GATE = WS_U + 68 * MiB;
constexpr size_t WS_FOUR = WS_GATE + 64 * MiB;
constexpr size_t WS_UC = WS_FOUR + 64 * MiB;
constexpr size_t WS_S = WS_UC + 68 * MiB;
constexpr size_t WS_UPART = WS_S;
constexpr size_t WS_YMIX = WS_S + 64 * MiB;
constexpr float YMIX_SCALE = 8.0f, H_SCALE = 16.0f;
constexpr size_t WS_PQT = WS_YMIX + 128 * MiB;
constexpr size_t WS_AB = WS_PQT + 32 * MiB;
constexpr size_t WS_END_MIXER = WS_AB + 32 * MiB;
constexpr size_t WS_H2HI = WS_YMIX;
constexpr size_t WS_H2LO = WS_U;
constexpr size_t WS_OUTTOK = WS_DYN;
constexpr size_t OUTTOK_BYTES = (size_t)TS * 9 * D;
constexpr size_t WS_ACT = WS_OUTTOK + OUTTOK_BYTES;
constexpr size_t ACT_BYTES = (size_t)SLOT_ROWS * DE;
constexpr size_t WS_H2F8 = WS_OUTTOK + 736 * MiB;
constexpr size_t WS_ROUTE = WS_H2F8 + 64 * MiB;
constexpr size_t WS_END = WS_ROUTE + 24 * MiB;
static_assert(WS_H2F8 >= WS_END_MIXER, "H2F8 clear of the mixer buffers");
static_assert(WS_ACT + ACT_BYTES <= WS_H2F8, "MoE overlay map");
static_assert(WS_END <= 1150 * MiB, "workspace budget");
constexpr size_t RT_TOK = 0;
constexpr size_t RT_DST = RT_TOK + (size_t)NSLICE * NEX * TS * 4;
constexpr size_t RT_W = RT_DST + (size_t)NSLICE * NEX * TS * 4;
static_assert(RT_W + (size_t)T * 8 * 4 <= 24 * MiB, "routing tables");
constexpr int MS_SUMA = 0;
constexpr int NSUB = SEQ / 128;
constexpr int MS_SUMB = MS_SUMA + (TT / 128) * 2 * DL;
constexpr int MS_P64 = MS_SUMB + (TT / 128) * 2 * DL;
constexpr int P64_LD = 2112;
constexpr int MS_ALT = MS_P64 + NB * 8 * P64_LD;
constexpr int MS_NYQ = MS_ALT + NB * 32 * 512;
constexpr int MS_SP = MS_NYQ + NB * 8 * P64_LD;
constexpr int MS_GB = MS_SP + 2 * DL;
constexpr int MS_P64B = MS_GB + 4 * DL;
constexpr int MS_END = MS_P64B + 64 * 1024;
static_assert((size_t)MS_END * 4 <= 8 * MiB, "MISC region");
constexpr int CW_TMO = 0, CW_CODE = 1, CW_BAR = 4096, CW_CNT = 8192;

constexpr int RING_BYTES = 131072, LDSCTL_OFF = RING_BYTES, SCR_OFF = LDSCTL_OFF + 512, LDS_BYTES = 147456;

#define RLX_AGENT __ATOMIC_RELAXED, __HIP_MEMORY_SCOPE_AGENT
#define LDS_WAIT() asm volatile("s_waitcnt lgkmcnt(0)" ::: "memory")
#define VM_WAIT() asm volatile("s_waitcnt vmcnt(0)" ::: "memory")
__device__ __forceinline__ unsigned f2bf(float f) { unsigned u = __builtin_bit_cast(unsigned, f); return (u + 0x7fffu + ((u >> 16) & 1u)) >> 16; }
__device__ __forceinline__ unsigned pk2(float lo, float hi) { return f2bf(lo) | (f2bf(hi) << 16); }
__device__ __forceinline__ unsigned cvt_pk_bf16(float lo, float hi) { unsigned r; asm volatile("v_cvt_pk_bf16_f32 %0, %1, %2" : "=v"(r) : "v"(lo), "v"(hi)); return r; }
__device__ __forceinline__ unsigned pk4_fp8(float a, float b, float c, float d) {
    a = __builtin_amdgcn_fmed3f(a, -448.f, 448.f); b = __builtin_amdgcn_fmed3f(b, -448.f, 448.f); c = __builtin_amdgcn_fmed3f(c, -448.f, 448.f); d = __builtin_amdgcn_fmed3f(d, -448.f, 448.f);
    int r = __builtin_amdgcn_cvt_pk_fp8_f32(a, b, 0, false); r = __builtin_amdgcn_cvt_pk_fp8_f32(c, d, r, true); return (unsigned)r; }
__device__ __forceinline__ f32x4 fp8x4_to_f32(unsigned w) { const f32x2 lo = __builtin_amdgcn_cvt_pk_f32_fp8((int)w, false), hi = __builtin_amdgcn_cvt_pk_f32_fp8((int)w, true); return (f32x4){lo.x, lo.y, hi.x, hi.y}; }
__device__ __forceinline__ unsigned fp8x2_to_bf16x2(unsigned w, bool hiword) {
    unsigned long long r;
    if (hiword) asm volatile("v_cvt_pk_f32_fp8_sdwa %0, %1 src0_sel:WORD_1" : "=&v"(r) : "v"(w));
    else        asm volatile("v_cvt_pk_f32_fp8_e32 %0, %1" : "=&v"(r) : "v"(w));
    unsigned lo = (unsigned)r, hi = (unsigned)(r >> 32);
    asm volatile("" : "+v"(lo), "+v"(hi));
    return __builtin_amdgcn_perm(hi, lo, 0x07060302u);
}
__device__ __forceinline__ float bf_lo(unsigned w) { return __builtin_bit_cast(float, w << 16); }
__device__ __forceinline__ float bf_hi(unsigned w) { return __builtin_bit_cast(float, w & 0xffff0000u); }
__device__ __forceinline__ float bf2f(bf16 h) { return __builtin_bit_cast(float, (unsigned)h << 16); }
template <int CTRL> __device__ __forceinline__ float dppx(float v) {
    return __builtin_bit_cast(float, __builtin_amdgcn_update_dpp(0, __builtin_bit_cast(int, v), CTRL, 0xF, 0xF, true));
}
__device__ __forceinline__ float wave_sum(float v) {
    v += dppx<0xB1>(v);
    v += dppx<0x4E>(v);
    v += dppx<0x141>(v);
    v += dppx<0x140>(v);
    const int iv = __builtin_bit_cast(int, v);
    const float r0 = __builtin_bit_cast(float, __builtin_amdgcn_readlane(iv, 0)), r1 = __builtin_bit_cast(float, __builtin_amdgcn_readlane(iv, 16));
    const float r2 = __builtin_bit_cast(float, __builtin_amdgcn_readlane(iv, 32)), r3 = __builtin_bit_cast(float, __builtin_amdgcn_readlane(iv, 48));
    return (r0 + r1) + (r2 + r3);
}
__device__ __forceinline__ float group8_max(float v) {
    v = fmaxf(v, dppx<0xB1>(v)); v = fmaxf(v, dppx<0x4E>(v)); v = fmaxf(v, dppx<0x141>(v)); return v;
}
__device__ __forceinline__ float sigmoid_f(float x) { return __builtin_amdgcn_rcpf(1.0f + __expf(-x)); }
__device__ __forceinline__ float silu_f(float x) { return x * sigmoid_f(x); }
__device__ __forceinline__ float gelu_tanh_f(float x) { const float u = 0.7978845608028654f * (x + 0.044715f * x * x * x); const float e = __expf(2.0f * u); const float th = 1.0f - 2.0f * __builtin_amdgcn_rcpf(e + 1.0f); return 0.5f * x * (1.0f + th); }

#define XB_TMO      128
#define XB_XCNT(j)  (256  + 64 * (j))
#define XB_XSUB(j)  (1280 + 64 * (j))
#define XB_XGEN(j)  (2304 + 64 * (j))
#define XB_TOP      3328
#define XB_TOPGEN   3392
#define XCD_BAR_WORDS 3456
#define XB_SPIN_CAP (1u << 18)
__device__ __forceinline__ unsigned xb_ld(unsigned* p)              { return __hip_atomic_load(p, __ATOMIC_RELAXED, __HIP_MEMORY_SCOPE_AGENT); }
__device__ __forceinline__ unsigned xb_add(unsigned* p, unsigned v) { return __hip_atomic_fetch_add(p, v, __ATOMIC_RELAXED, __HIP_MEMORY_SCOPE_AGENT); }
__device__ __forceinline__ unsigned xb_xcc_id() { return (unsigned)__builtin_amdgcn_s_getreg((3 << 11) | 20) & 0xFu; }
#define XB_SPIN(cond, bar) do { unsigned _sp = 0; while (cond) { __builtin_amdgcn_s_sleep(1); \
    if ((++_sp & 255u) == 0u) { if (xb_ld(&(bar)[XB_TMO])) break; if (_sp > XB_SPIN_CAP) { atomicAdd(&(bar)[XB_TMO], 1u); break; } } } } while (0)
struct XcdBarrier { unsigned* bar; unsigned x; volatile LAS unsigned* st; };
__device__ __forceinline__ XcdBarrier xcd_barrier_post(unsigned* bar, volatile LAS unsigned* st) {
    XcdBarrier b; b.bar = bar; b.x = xb_xcc_id(); b.st = st;
    if (threadIdx.x == 0) (void)xb_add(&bar[XB_XCNT(b.x)], 1u);
    return b;
}
__device__ __forceinline__ void xcd_barrier_complete(unsigned* bar, unsigned x, unsigned& nloc, unsigned& nx) {
    const unsigned G = gridDim.x * gridDim.y * gridDim.z;
    unsigned sum, cnt, mine, sp = 0u;
    for (;;) {
        sum = 0u; cnt = 0u; mine = 0u;
#pragma unroll
        for (unsigned j = 0; j < 16; ++j) { const unsigned c = xb_ld(&bar[XB_XCNT(j)]); sum += c; cnt += (c > 0u) ? 1u : 0u; mine = (j == x) ? c : mine; }
        if (sum == G) break;
        __builtin_amdgcn_s_sleep(1);
        if ((++sp & 255u) == 0u) { if (xb_ld(&bar[XB_TMO])) break; if (sp > XB_SPIN_CAP) { atomicAdd(&bar[XB_TMO], 1u); break; } }
    }
    nloc = mine > 0u ? mine : 1u; nx = cnt > 0u ? cnt : 1u;
}
__device__ __forceinline__ void xcd_barrier(const XcdBarrier& b) {
    asm volatile("s_waitcnt vmcnt(0)" ::: "memory");
    __syncthreads();
    if (threadIdx.x == 0) {
        unsigned* bar = b.bar;
        __builtin_amdgcn_s_waitcnt(0);
        unsigned nloc = b.st[0], nx = b.st[1];
        if (nloc == 0u) { xcd_barrier_complete(bar, b.x, nloc, nx); b.st[0] = nloc; b.st[1] = nx; }
        const unsigned old = xb_add(&bar[XB_XSUB(b.x)], 1u);
        const unsigned gen = old / nloc;
        if (old + 1u == (gen + 1u) * nloc) {
            __builtin_amdgcn_fence(__ATOMIC_RELEASE, "agent");
            asm volatile("s_waitcnt vmcnt(0)" ::: "memory");
            const unsigned og = xb_add(&bar[XB_TOP], 1u);
            const unsigned tg = og / nx;
            if (og + 1u == (tg + 1u) * nx) xb_add(&bar[XB_TOPGEN], 1u);
            else XB_SPIN(xb_ld(&bar[XB_TOPGEN]) == tg, bar);
            __builtin_amdgcn_fence(__ATOMIC_ACQUIRE, "agent");
            xb_add(&bar[XB_XGEN(b.x)], 1u);
            asm volatile("s_waitcnt vmcnt(0)" ::: "memory");
        } else {
            XB_SPIN(xb_ld(&bar[XB_XGEN(b.x)]) == gen, bar);
            __builtin_amdgcn_fence(__ATOMIC_ACQUIRE, "agent");
            asm volatile("s_waitcnt vmcnt(0)" ::: "memory");
        }
    }
    __syncthreads();
}

namespace pg8 {
constexpr int BM = 256, BK = 64, HALF = 128, HTB = HALF * BK * 2, STAGE_BYTES = 8 * HTB;
__host__ __device__ __forceinline__ int lds_byte(int r, int c) { const int st = (r >> 4) * 2 + (c >> 5), rr = r & 15, cc = c & 31, ob = rr * 64 + cc * 2; return st * 1024 + (ob ^ (((ob >> 9) & 1) << 5)); }
__host__ __device__ __forceinline__ void stage_rc(int b, int& R, int& C) { const int st = b / 1024, sb = b % 1024, swz = sb ^ (((sb >> 9) & 1) << 5); R = (st >> 1) * 16 + swz / 64; C = (st & 1) * 32 + (swz % 64) / 2; }
__host__ __device__ __forceinline__ int perm_slot32(int c) { return 16 * ((c >> 2) & 1) + 4 * ((c >> 3) & 3) + (c & 3); }

__host__ __device__ __forceinline__ int perm_slot256(int c) { return 128 * ((c >> 3) & 1) + 32 * (c >> 6) + 16 * ((c >> 2) & 1) + 4 * ((c >> 4) & 3) + (c & 3); }
template <int N> struct IntC { static constexpr int value = N; };
struct Unit { const char* a; const char* b; int pm, pn, aux0, aux1, nt; };

template <class Epi, class Sched, bool ALIGN_EPI, bool GATHER, bool F8 = false, int SCW = 0x7f7f7f7f>
__device__ __forceinline__ void gemm_phase(LAS unsigned char* lds, const int nt_, const unsigned lda_b, const unsigned ldb_b, Sched& S, const Epi& E) {
    int nt = nt_; asm volatile("" : "+s"(nt));
    int tid_ = threadIdx.x; asm volatile("" : "+v"(tid_));
    const int tid = tid_, wid = __builtin_amdgcn_readfirstlane(tid >> 6), lane = tid & 63, wr = wid >> 2, wc = wid & 3, fr = lane & 15, fq = lane >> 4;
    unsigned voffA[2][2], voffB[2][2], cbyte[2]; int Rr[2];
#pragma unroll
    for (int i = 0; i < 2; ++i) { int R, C; stage_rc(tid * 16 + i * 8192, R, C); Rr[i] = R; cbyte[i] = (unsigned)C * 2u;
#pragma unroll
        for (int h = 0; h < 2; ++h) { voffB[h][i] = (unsigned)(R + HALF * h) * ldb_b + (unsigned)C * 2u; voffA[h][i] = (unsigned)Epi::a_row(h, R) * lda_b + (unsigned)C * 2u; } }
    const unsigned ldsw = (unsigned)wid * 1024u;
    const int aoff = lds_byte(wr * 64 + fr, fq * 8), boff = lds_byte(wc * 32 + fr, fq * 8);
#define PG8_SA(b, h) (((b) * 2 + (h)) * HTB)
#define PG8_SB(b, h) ((4 + (b) * 2 + (h)) * HTB)
#define PG8_STAGE(bufoff, gbase, voff) do { _Pragma("unroll") for (int _i = 0; _i < 2; ++_i) \
        __builtin_amdgcn_global_load_lds((const unsigned*)((const char*)(gbase) + (voff)[_i]), (LAS unsigned*)(lds + (bufoff) + ldsw + _i * 8192), 16, 0, 0); } while (0)
#define PG8_LDA(dst, b, h) do { _Pragma("unroll") for (int m = 0; m < 4; ++m) _Pragma("unroll") for (int k = 0; k < 2; ++k) dst[m][k] = *(const LAS v4i*)(lds + PG8_SA(b, h) + aoff + m * 2048 + k * 1024); } while (0)
#define PG8_LDB(dst, b, h) do { _Pragma("unroll") for (int n = 0; n < 2; ++n) _Pragma("unroll") for (int k = 0; k < 2; ++k) dst[n][k] = *(const LAS v4i*)(lds + PG8_SB(b, h) + boff + n * 2048 + k * 1024); } while (0)
#define PG8_CAT(x) __builtin_shufflevector((x)[0], (x)[1], 0, 1, 2, 3, 4, 5, 6, 7)
#define PG8_MMA(ai, bj, At, Bt) do { __builtin_amdgcn_s_setprio(1); _Pragma("unroll") for (int m = 0; m < 4; ++m) _Pragma("unroll") for (int n = 0; n < 2; ++n) { \
        if constexpr (F8) { const v8i b8_ = PG8_CAT(Bt[n]), a8_ = PG8_CAT(At[m]);   \
            asm volatile("v_mfma_scale_f32_16x16x128_f8f6f4 %0, %1, %2, %0, %3, %4 op_sel_hi:[0,0,0]" : "+v"(acc[ai][bj][m][n]) : "v"(b8_), "v"(a8_), "v"(scw_), "v"(sca_)); } \
        else { _Pragma("unroll") for (int k = 0; k < 2; ++k) acc[ai][bj][m][n] = __builtin_amdgcn_mfma_f32_16x16x32_bf16(__builtin_bit_cast(bf16x8, Bt[n][k]), __builtin_bit_cast(bf16x8, At[m][k]), acc[ai][bj][m][n], 0, 0, 0); } } \
        __builtin_amdgcn_s_setprio(0); } while (0)
#define PG8_WAIT_V(n) asm volatile("s_waitcnt vmcnt(" #n ")" ::: "memory")
#define PG8_WAIT_VN(n) asm volatile("s_waitcnt vmcnt(%0)" :: "n"(n) : "memory")
#define PG8_WAIT_RLX(rlx, n) asm volatile("s_cmp_lg_u32 %0, 0\n\ts_cbranch_scc1 .Lrx%=\n\ts_waitcnt vmcnt(8)\n.Lrx%=:\n\ts_waitcnt vmcnt(%1)" :: "s"(rlx), "n"(n) : "scc", "memory")
#define PG8_WAIT_L(n) asm volatile("s_waitcnt lgkmcnt(" #n ")" ::: "memory")
#define PG8_BAR __builtin_amdgcn_s_barrier()
#define PG8_SCHED __builtin_amdgcn_sched_barrier(0)
    int scw_ = SCW, sca_ = 0x7f7f7f7f; asm volatile("" : "+v"(scw_), "+v"(sca_));
    Unit cur, nxt; int ui = 0;
    if (!S.next(0, cur)) return;
    f32x4 acc[2][2][4][2];
#pragma unroll
    for (int a = 0; a < 2; ++a)
#pragma unroll
        for (int b = 0; b < 2; ++b)
#pragma unroll
            for (int m = 0; m < 4; ++m)
#pragma unroll
                for (int n = 0; n < 2; ++n) acc[a][b][m][n] = (f32x4){0.f, 0.f, 0.f, 0.f};
    v4i At[4][2], B0[2][2], B1[2][2];
    const char* cA = cur.a; const char* cB = cur.b;
    if constexpr (Sched::DSTPF) S.prefetch_dst(cur, 0, wid, lane);
    if constexpr (GATHER) {
#pragma unroll
        for (int h = 0; h < 2; ++h)
#pragma unroll
            for (int i = 0; i < 2; ++i) voffA[h][i] = S.row_off_global(cur, HALF * h + Rr[i]) + cbyte[i];
    }
    PG8_STAGE(PG8_SB(0, 0), cB, voffB[0]); PG8_STAGE(PG8_SB(0, 1), cB, voffB[1]); PG8_STAGE(PG8_SA(0, 0), cA, voffA[0]); PG8_STAGE(PG8_SA(0, 1), cA, voffA[1]);
    if (wr == 1) PG8_BAR;
    PG8_WAIT_V(2); PG8_BAR;
    PG8_STAGE(PG8_SB(1, 0), cB + 128, voffB[0]); PG8_STAGE(PG8_SA(1, 0), cA + 128, voffA[0]); PG8_STAGE(PG8_SB(1, 1), cB + 128, voffB[1]);
    PG8_WAIT_V(6); PG8_BAR;
    for (;;) {
        const bool has_next = S.next(ui + 1, nxt);
        const char* nA = has_next ? nxt.a : cA; const char* nB = has_next ? nxt.b : cB;
        if constexpr (GATHER) { if (has_next) S.prefetch_rows(nxt, ui + 1, lds, wid, lane); }
        if constexpr (Sched::DSTPF) { if (has_next) S.prefetch_dst(nxt, ui + 1, wid, lane); }
        const int ntu = (cur.nt > 0) ? cur.nt : nt;
        asm volatile(".p2align 8" ::: "memory");
        for (int t = 0; t < ntu; t += 2) {
            const bool rlx = (Epi::NST > 0) && t == 0 && ui > 0;
            int rlxs = 0; if constexpr (!F8 && Epi::NST > 0) { rlxs = __builtin_amdgcn_readfirstlane(rlx ? 1 : 0); asm volatile("" : "+s"(rlxs)); }
            const bool last = (t == ntu - 2);
            const char* a1 = cA + (size_t)(t + 1) * 128;
            const char* a2 = last ? nA : cA + (size_t)(t + 2) * 128; const char* b2 = last ? nB : cB + (size_t)(t + 2) * 128;
            const char* a3 = a2 + 128; const char* b3 = b2 + 128;
            unsigned oa[2][2];
#pragma unroll
            for (int h = 0; h < 2; ++h)
#pragma unroll
                for (int i = 0; i < 2; ++i) oa[h][i] = voffA[h][i];
            if constexpr (GATHER) { if (last && has_next) {
#pragma unroll
                for (int h = 0; h < 2; ++h)
#pragma unroll
                    for (int i = 0; i < 2; ++i) oa[h][i] = S.row_off_lds(ui + 1, HALF * h + Rr[i], lds) + cbyte[i]; } }
            PG8_LDB(B0, 0, 0); PG8_LDB(B1, 0, 1); PG8_SCHED; PG8_LDA(At, 0, 0); PG8_STAGE(PG8_SA(1, 1), a1, voffA[1]);
            if constexpr (F8) { if (rlx) PG8_WAIT_VN(8 + Epi::NST); else PG8_WAIT_V(8); } else if constexpr (Epi::NST > 0) PG8_WAIT_RLX(rlxs, 8 + Epi::NST); else PG8_WAIT_V(8); PG8_WAIT_L(0); PG8_BAR; PG8_MMA(0, 0, At, B0); PG8_MMA(0, 1, At, B1); PG8_BAR; PG8_SCHED;
            PG8_LDA(At, 0, 1); PG8_STAGE(PG8_SB(0, 0), b2, voffB[0]); PG8_STAGE(PG8_SB(0, 1), b2, voffB[1]); PG8_STAGE(PG8_SA(0, 0), a2, oa[0]);
            if constexpr (F8) { if (rlx) PG8_WAIT_VN(8 + Epi::NST); else PG8_WAIT_V(8); } else if constexpr (Epi::NST > 0) PG8_WAIT_RLX(rlxs, 8 + Epi::NST); else PG8_WAIT_V(8); PG8_WAIT_L(0); PG8_BAR; PG8_MMA(1, 0, At, B0); PG8_MMA(1, 1, At, B1); PG8_BAR; PG8_SCHED;
            PG8_LDB(B0, 1, 0); PG8_LDB(B1, 1, 1); PG8_SCHED; PG8_LDA(At, 1, 0); PG8_STAGE(PG8_SA(0, 1), a2, oa[1]);
            PG8_WAIT_V(8); PG8_WAIT_L(0); PG8_BAR; PG8_MMA(0, 0, At, B0); PG8_MMA(0, 1, At, B1); PG8_BAR; PG8_SCHED;
            PG8_LDA(At, 1, 1); PG8_STAGE(PG8_SB(1, 0), b3, voffB[0]); PG8_STAGE(PG8_SB(1, 1), b3, voffB[1]); PG8_STAGE(PG8_SA(1, 0), a3, oa[0]);
            PG8_WAIT_V(8); PG8_WAIT_L(0); PG8_BAR; PG8_MMA(1, 0, At, B0); PG8_MMA(1, 1, At, B1); PG8_BAR; PG8_SCHED;
            if constexpr (GATHER) { if (last) {
#pragma unroll
                for (int h = 0; h < 2; ++h)
#pragma unroll
                    for (int i = 0; i < 2; ++i) voffA[h][i] = oa[h][i]; } }
        }
        if constexpr (ALIGN_EPI) { if (wr == 0) PG8_BAR; }
        if constexpr (F8) asm volatile("s_nop 15\n\ts_nop 15" ::: "memory");
        E(acc, cur, wr, wc, fr, fq, lds);
        if (!has_next) break;
#pragma unroll
        for (int a = 0; a < 2; ++a)
#pragma unroll
            for (int b = 0; b < 2; ++b)
#pragma unroll
                for (int m = 0; m < 4; ++m)
#pragma unroll
                    for (int n = 0; n < 2; ++n) acc[a][b][m][n] = (f32x4){0.f, 0.f, 0.f, 0.f};
        cur = nxt; cA = nA; cB = nB; ++ui;
        if constexpr (ALIGN_EPI) { if (wr == 1) PG8_BAR; }
    }
    PG8_WAIT_V(0);
    if constexpr (!ALIGN_EPI) { if (wr == 0) PG8_BAR; }
    PG8_BAR;
#undef PG8_SA
#undef PG8_SB
#undef PG8_STAGE
#undef PG8_LDA
#undef PG8_LDB
#undef PG8_MMA
#undef PG8_CAT
#undef PG8_WAIT_V
#undef PG8_WAIT_VN
#undef PG8_WAIT_RLX
#undef PG8_WAIT_L
#undef PG8_BAR
#undef PG8_SCHED
}
}
}
namespace mk {
struct Args { const float* in[29]; float* out; unsigned char* ws; int ph_lo, ph_hi, li, pad; };
static_assert(sizeof(Args) == 31 * 8 + 16, "Args has no padding");

__device__ __forceinline__ void tile_order(int L, int nM, int nN, int& pm, int& pn) {
    const int nwg = nM * nN; int wgid = L;
    { const int q = nwg / 8, r = nwg % 8, xcd = wgid % 8, off = wgid / 8; wgid = (xcd < r ? xcd * (q + 1) : r * (q + 1) + (xcd - r) * q) + off; }
    const int nig = 8 * nN, gid = wgid / nig, fm = gid * 8, gsz = (nM - fm) < 8 ? (nM - fm) : 8;
    pm = fm + ((wgid % nig) % gsz); pn = (wgid % nig) / gsz;
}

__device__ __forceinline__ void p0_adaln(const Args& A, LAS unsigned char* lds, int tid, int G) {
    LAS float* st = (LAS float*)lds;
    const float* c = A.in[1]; const float* cc = A.in[3]; const float* w = A.in[4]; const float* bias = A.in[5];
    float* mod = (float*)(A.ws + WS_MOD);
    const int cg = tid % 12, kg = tid / 12;
    __syncthreads();
    for (int cb = blockIdx.x; cb < 256; cb += G) {
        for (int i = tid; i < 9 * D; i += NTHR) { const float v = (i < 8 * D) ? c[i] : cc[i - 8 * D]; st[i] = v / (1.0f + __expf(-v)); }
        __syncthreads();
        float acc[9][4];
#pragma unroll
        for (int r = 0; r < 9; ++r)
#pragma unroll
            for (int j = 0; j < 4; ++j) acc[r][j] = 0.f;
        const int col0 = cb * 48 + cg * 4;
        if (kg < 42) {
            for (int k = kg; k < D; k += 42) {
                const f32x4 wv = *(const f32x4*)(w + (size_t)k * MODW + col0);
#pragma unroll
                for (int r = 0; r < 9; ++r) { const float s = st[r * D + k];
#pragma unroll
                    for (int j = 0; j < 4; ++j) acc[r][j] += s * wv[j]; }
            }
        }
        __syncthreads();
        if (kg < 42) {
#pragma unroll
            for (int r = 0; r < 9; ++r)
#pragma unroll
                for (int j = 0; j < 4; ++j) st[(kg * 12 + cg) * 36 + r * 4 + j] = acc[r][j];
        }
        __syncthreads();
        if (tid < 432) { const int ocg = tid / 36, rj = tid % 36, r = rj >> 2, j = rj & 3; float s = 0.f;
            for (int q = 0; q < 42; ++q) s += st[(q * 12 + ocg) * 36 + rj];
            const int col = cb * 48 + ocg * 4 + j; mod[(size_t)r * MODW + col] = s + bias[col]; }
        __syncthreads();
    }
}

__device__ __forceinline__ void tr_item(const float* W, int ldw, int k0, int n0, bf16* WT, size_t dst_row0, int ldk, bool perm, LAS float* scr, int lane) {
#pragma unroll 8
    for (int i = 0; i < 32; ++i) { const int kk = 2 * i + (lane >> 5); scr[kk * 33 + (lane & 31)] = W[(size_t)(k0 + kk) * ldw + n0 + (lane & 31)]; }
    LDS_WAIT(); asm volatile("" ::: "memory");
    const int c = lane & 7;
#pragma unroll
    for (int j = 0; j < 4; ++j) { const int n = (lane >> 3) + 8 * j; const LAS float* s = scr + (8 * c) * 33 + n;
        v4u o; o.x = pk2(s[0 * 33], s[1 * 33]); o.y = pk2(s[2 * 33], s[3 * 33]); o.z = pk2(s[4 * 33], s[5 * 33]); o.w = pk2(s[6 * 33], s[7 * 33]);
        const int slot = perm ? pg8::perm_slot32(n) : n;
        *(GAS v4u*)(WT + (dst_row0 + slot) * (size_t)ldk + k0 + 8 * c) = o; }
    LDS_WAIT(); asm volatile("" ::: "memory");
}
__device__ __forceinline__ void tr_item_f8(const float* W, int ldw, int k0, int n0, unsigned char* WT, size_t dst_row0, int ldk, int mode256, LAS float* scr, int lane) {
#pragma unroll 8
    for (int i = 0; i < 32; ++i) { const int kk = 2 * i + (lane >> 5); scr[kk * 33 + (lane & 31)] = __builtin_nontemporal_load(W + (size_t)(k0 + kk) * ldw + n0 + (lane & 31)); }
    LDS_WAIT(); asm volatile("" ::: "memory");
    const int c = lane & 7;
#pragma unroll
    for (int j = 0; j < 4; ++j) { const int n = (lane >> 3) + 8 * j; const LAS float* s = scr + (8 * c) * 33 + n;
        v2u o; o.x = pk4_fp8(s[0 * 33] * 64.f, s[1 * 33] * 64.f, s[2 * 33] * 64.f, s[3 * 33] * 64.f); o.y = pk4_fp8(s[4 * 33] * 64.f, s[5 * 33] * 64.f, s[6 * 33] * 64.f, s[7 * 33] * 64.f);
        const int slot = mode256 ? pg8::perm_slot256((n0 & 255) + n) : pg8::perm_slot32(n);
        *(GAS v2u*)(WT + (dst_row0 + slot) * (size_t)ldk + k0 + 8 * c) = o; }
    LDS_WAIT(); asm volatile("" ::: "memory");
}
__device__ __forceinline__ void tr_item_hilo(const float* W, int ldw, int k0, int n0, bf16* WT, int ldk, LAS float* scr, int lane) {
#pragma unroll 8
    for (int i = 0; i < 32; ++i) { const int kk = 2 * i + (lane >> 5); scr[kk * 33 + (lane & 31)] = W[(size_t)(k0 + kk) * ldw + n0 + (lane & 31)]; }
    LDS_WAIT(); asm volatile("" ::: "memory");
    const int c = lane & 7;
#pragma unroll
    for (int j = 0; j < 4; ++j) { const int n = (lane >> 3) + 8 * j; const LAS float* s = scr + (8 * c) * 33 + n;
        float v[8]; unsigned hb[8], lb[8];
#pragma unroll
        for (int q = 0; q < 8; ++q) { v[q] = s[q * 33]; hb[q] = f2bf(v[q]); lb[q] = f2bf(v[q] - __builtin_bit_cast(float, hb[q] << 16)); }
        v4u oh, ol; oh.x = hb[0] | (hb[1] << 16); oh.y = hb[2] | (hb[3] << 16); oh.z = hb[4] | (hb[5] << 16); oh.w = hb[6] | (hb[7] << 16);
        ol.x = lb[0] | (lb[1] << 16); ol.y = lb[2] | (lb[3] << 16); ol.z = lb[4] | (lb[5] << 16); ol.w = lb[6] | (lb[7] << 16);
        *(GAS v4u*)(WT + (size_t)(n0 + n) * ldk + k0 + 8 * c) = oh;
        *(GAS v4u*)(WT + (size_t)(NE + n0 + n) * ldk + k0 + 8 * c) = ol; }
    LDS_WAIT(); asm volatile("" ::: "memory");
}

template <int PART = 7>
__device__ __forceinline__ void p0_weights(const Args& A, LAS unsigned char* lds, int tid, int lane, int wave, int vcu, int G) {
    LAS float* scr = (LAS float*)(lds + wave * 16384);
    const int gw = vcu * NWAVES + wave, NGW = G * NWAVES;
    bf16* WIN = (bf16*)(A.ws + WS_WIN); bf16* WOUT = (bf16*)(A.ws + WS_WOUT); unsigned char* WGU = A.ws + WS_WGU; unsigned char* WD = A.ws + WS_WD; bf16* WR = (bf16*)(A.ws + WS_WR);
    constexpr int I_IN = 32 * 64, I_OUT = 32 * 64, I_GU = 32 * 16, I_D = 8 * 64, I_R = 32 * 2;
    constexpr int NITEMS = I_IN + I_OUT + NEX * (2 * I_GU + I_D) + I_R;
    if (PART & 3)
    for (int it = gw; it < NITEMS; it += NGW) {
        int r = it;
        if (r < I_IN) { const int kb = r / 64, nb = r % 64; tr_item_f8(A.in[6], DIN, 64 * kb, 32 * nb, (unsigned char*)WIN, (size_t)32 * nb, D, 0, scr, lane); continue; } r -= I_IN;
        if (r < I_OUT) { const int kb = r / 64, nb = r % 64; tr_item_f8(A.in[16], D, 64 * kb, 32 * nb, (unsigned char*)WOUT, (size_t)32 * nb, D, 0, scr, lane); continue; } r -= I_OUT;
        if (r < NEX * 2 * I_GU) { const int e = r / (2 * I_GU); int q = r % (2 * I_GU); const int bj = q / I_GU; q %= I_GU; const int kb = q / 16, nb = q % 16;
            const float* W = (e < NE) ? A.in[bj ? 22 : 21] + (size_t)e * D * DE : A.in[bj ? 25 : 24];
            const int n0 = 32 * nb, ct = n0 >> 7, wcg = (n0 >> 5) & 3;
            tr_item_f8(W, DE, 64 * kb, n0, WGU, (size_t)e * 1024 + ct * 256 + bj * 128 + wcg * 32, D, 0, scr, lane); continue; } r -= NEX * 2 * I_GU;
        if (r < NEX * I_D) { const int e = r / I_D, q = r % I_D, kb = q / 64, nb = q % 64;
            const float* W = (e < NE) ? A.in[23] + (size_t)e * DE * D : A.in[26];
            tr_item_f8(W, D, 64 * kb, 32 * nb, WD, (size_t)e * D + ((32 * nb) & ~255), DE, 1, scr, lane); continue; } r -= NEX * I_D;
        { const int kb = r / 2, nb = r % 2; tr_item_hilo(A.in[19], NE, 64 * kb, 32 * nb, WR, D, scr, lane); }
    }
    if (!(PART & 4)) return;
    { float* misc = (float*)(A.ws + WS_MISC); const int i = gw * 64 + lane;
      if (i < 2 * DL) { const float l = -A.in[13][i]; misc[MS_SP + i] = -8.0f * 1.4426950408889634f * ((l > 20.f) ? l : log1pf(expf(l)));
          const int d = i >> 10, ch = i & 1023; misc[MS_GB + d * 2 * DL + ch] = -1.4426950408889634f * A.in[10][i]; misc[MS_GB + d * 2 * DL + DL + ch] = -1.4426950408889634f * A.in[12][i]; } }
    {   bf16* WG4 = (bf16*)(A.ws + WS_WG4);
        for (int it = gw; it < 4 * 4 * 4 * 32; it += NGW) {
            const int k8 = it & 31, gt = (it >> 5) & 3, q = (it >> 7) & 3, h = it >> 9, cl = lane;
            const float* src = ((gt & 1) ? A.in[11] : A.in[9]) + ((size_t)(gt >> 1) * 4 + h) * 65536 + q * 64 + cl;
            float v[8];
#pragma unroll
            for (int j = 0; j < 8; ++j) v[j] = -1.4426950408889634f * src[(size_t)(k8 * 8 + j) * 256];
            const int rho = (gt >> 1) * 128 + (cl >> 4) * 32 + (gt & 1) * 16 + ((cl >> 2) & 3) * 4 + (cl & 3);
            v4u o; o.x = pk2(v[0], v[1]); o.y = pk2(v[2], v[3]); o.z = pk2(v[4], v[5]); o.w = pk2(v[6], v[7]);
            *(GAS v4u*)(WG4 + ((size_t)h * 1024 + q * 256 + rho) * 256 + k8 * 8) = o;
        }
    }
    {   bf16* CS = (bf16*)(A.ws + WS_CS);
        for (int it = gw; it < 2 * 2048 * 4; it += NGW) {
            const int nq = it & 3, k = (it >> 2) & 2047, ty = it >> 13, n0 = nq * 512 + lane * 8;
            float v[8];
#pragma unroll
            for (int j = 0; j < 8; ++j) { const float x = (float)((k * (n0 + j)) & 4095) * (1.0f / 4096.0f); v[j] = ty ? __builtin_amdgcn_sinf(x) : __builtin_amdgcn_cosf(x); }
            v4u o; o.x = pk2(v[0], v[1]); o.y = pk2(v[2], v[3]); o.z = pk2(v[4], v[5]); o.w = pk2(v[6], v[7]);
            *(GAS v4u*)(CS + ((size_t)ty * 2048 + k) * 2048 + n0) = o;
        }
    }
}
__device__ __forceinline__ void p0_fold(const Args& A, LAS unsigned char* lds, int tid, int G) {
    LAS float* wt = (LAS float*)lds;
    LAS float* tb = (LAS float*)(lds + 64 * 129 * 4);
    bf16* WIN = (bf16*)(A.ws + WS_WIN);
    const float scale = 1.0f / 724.0773439350247f;
    for (int it = blockIdx.x; it < 256; it += G) {
        const int kb = it >> 3, g = it & 7, k0 = kb * 64;
        __syncthreads();
        if (tid < 128) { tb[tid] = __builtin_amdgcn_cosf((float)tid * (1.0f / 128.0f)); tb[128 + tid] = __builtin_amdgcn_sinf((float)tid * (1.0f / 128.0f)); }
        for (int i = tid; i < 64 * 128; i += NTHR) { const int kk = i >> 7, c = i & 127; wt[kk * 129 + c] = A.in[6][(size_t)(k0 + kk) * DIN + 2 * DL + g * 128 + c]; }
        __syncthreads();
        const int j = tid & 127, kq = tid >> 7, jj = (j <= 64) ? j : j - 64; const bool isc = (j <= 64);
        float acc[16];
#pragma unroll
        for (int i = 0; i < 16; ++i) acc[i] = 0.f;
        for (int c = 0; c < 128; ++c) { const int ph = (c * jj) & 127; const float tv = isc ? tb[ph] : -tb[128 + ph];
#pragma unroll
            for (int i = 0; i < 16; ++i) acc[i] += wt[(kq * 16 + i) * 129 + c] * tv; }
        const int col = g * 128 + j, row = 2 * DL + (col & ~31) + pg8::perm_slot32(col & 31);
        const float s64 = scale * 64.f; v4u o0;
        o0.x = pk4_fp8(acc[0] * s64, acc[1] * s64, acc[2] * s64, acc[3] * s64); o0.y = pk4_fp8(acc[4] * s64, acc[5] * s64, acc[6] * s64, acc[7] * s64);
        o0.z = pk4_fp8(acc[8] * s64, acc[9] * s64, acc[10] * s64, acc[11] * s64); o0.w = pk4_fp8(acc[12] * s64, acc[13] * s64, acc[14] * s64, acc[15] * s64);
        *(GAS v4u*)((unsigned char*)WIN + (size_t)row * D + k0 + kq * 16) = o0;
    }
    __syncthreads();
}

__device__ __forceinline__ void p1_hnorm(const Args& A, int lane, int wave, int vcu, int G) {
    const int gw = vcu * NWAVES + wave, NGW = G * NWAVES;
    const float* mod = (const float*)(A.ws + WS_MOD); bf16* H = (bf16*)(A.ws + WS_H);
    for (int r0 = gw; r0 < TT; r0 += 2 * NGW) {
        const int r1 = r0 + NGW; const bool has1 = r1 < TT; const int r1c = has1 ? r1 : r0;
        const float* x0 = (r0 < T) ? A.in[0] + (size_t)r0 * D : A.in[2] + (size_t)(r0 - T) * D; const float* x1 = (r1c < T) ? A.in[0] + (size_t)r1c * D : A.in[2] + (size_t)(r1c - T) * D;
        const int b0 = (r0 < T) ? r0 / SEQ : 8, b1 = (r1c < T) ? r1c / SEQ : 8;
        const GAS f32x4* xr0 = (const GAS f32x4*)x0 + lane; const GAS f32x4* xr1 = (const GAS f32x4*)x1 + lane;
        f32x4 v[8], u[8]; float s = 0.f, q = 0.f;
#pragma unroll
        for (int j = 0; j < 8; ++j) { v[j] = __builtin_nontemporal_load(xr0 + 64 * j); u[j] = __builtin_nontemporal_load(xr1 + 64 * j); }
#pragma unroll
        for (int j = 0; j < 8; ++j) { s += (v[j].x + v[j].y) + (v[j].z + v[j].w); q += (u[j].x + u[j].y) + (u[j].z + u[j].w); }
        const float mean0 = wave_sum(s) * (1.f / D), mean1 = wave_sum(q) * (1.f / D); float s2 = 0.f, q2 = 0.f;
#pragma unroll
        for (int j = 0; j < 8; ++j) { v[j] = v[j] - mean0; u[j] = u[j] - mean1; s2 += (v[j].x * v[j].x + v[j].y * v[j].y) + (v[j].z * v[j].z + v[j].w * v[j].w); q2 += (u[j].x * u[j].x + u[j].y * u[j].y) + (u[j].z * u[j].z + u[j].w * u[j].w); }
        const float rstd0 = 1.f / sqrtf(wave_sum(s2) * (1.f / D) + EPS), rstd1 = 1.f / sqrtf(wave_sum(q2) * (1.f / D) + EPS);
        { const GAS f32x4* sh = (const GAS f32x4*)(mod + (size_t)b0 * MODW) + lane; const GAS f32x4* sc = (const GAS f32x4*)(mod + (size_t)b0 * MODW + D) + lane; GAS unsigned* o8 = (GAS unsigned*)((unsigned char*)H + (size_t)r0 * D) + lane;
#pragma unroll
          for (int j = 0; j < 8; ++j) { const f32x4 a = sh[64 * j], m = sc[64 * j]; const f32x4 y = (v[j] * rstd0 * (m + 1.0f) + a) * H_SCALE; o8[64 * j] = pk4_fp8(y.x, y.y, y.z, y.w); } }
        if (has1) { const GAS f32x4* sh = (const GAS f32x4*)(mod + (size_t)b1 * MODW) + lane; const GAS f32x4* sc = (const GAS f32x4*)(mod + (size_t)b1 * MODW + D) + lane; GAS unsigned* o8 = (GAS unsigned*)((unsigned char*)H + (size_t)r1 * D) + lane;
#pragma unroll
          for (int j = 0; j < 8; ++j) { const f32x4 a = sh[64 * j], m = sc[64 * j]; const f32x4 y = (u[j] * rstd1 * (m + 1.0f) + a) * H_SCALE; o8[64 * j] = pk4_fp8(y.x, y.y, y.z, y.w); } }
    }
}

struct SchedInproj {
    static constexpr bool DSTPF = false;
    const char* H; const char* W; int G, c;
    __device__ __forceinline__ bool next(int i, pg8::Unit& u) {
        int L = i * G + c;
        if (G == 256 && c < 128) { if (i > 6) return false; L = (i == 0) ? 1536 + c : (i - 1) * G + c; }
        if (L >= 1536 + 128) return false;
        if (L < 1536) { int pm, pn; tile_order(L, 128, 12, pm, pn);
            u.pm = pm; u.pn = pn; u.aux0 = 0; u.aux1 = 0; u.nt = 0; u.a = H + (size_t)pm * 256 * D; u.b = W + (size_t)pn * 256 * D; }
        else {
            const int x = L - 1536, tile = x >> 2, ks = x & 3, pm = 128 + (tile >> 2), pn = tile & 3;
            u.pm = pm; u.pn = pn; u.aux0 = 1 + ks; u.aux1 = 0; u.nt = 4; u.a = H + (size_t)pm * 256 * D + ks * 512; u.b = W + (size_t)pn * 256 * D + ks * 512; }
        return true;
    }
};
struct EpiInproj {
    static __device__ __forceinline__ int a_row(int h, int R) { return 128 * h + R; }
    static constexpr int NST = 16;
    bf16* U; bf16* UPART;
    __device__ __forceinline__ void operator()(const f32x4 (&acc)[2][2][4][2], const pg8::Unit& u, int wr, int wc, int fr, int fq, LAS unsigned char*) const {
        const int arr = u.pn >> 2; const size_t aoff = (arr >= 1 ? (size_t)TT * DL : 0) + (arr >= 2 ? (size_t)T * DL : 0);
        bf16* base = U + aoff;
        int rowsub = 0; if (u.aux0 > 0) { base = UPART + (size_t)(u.aux0 - 1) * TC * DL; rowsub = T; }
        const int row0 = u.pm * 256 + wr * 64 + fr - rowsub, col0 = (u.pn & 3) * 256 + wc * 32 + 8 * fq;
#pragma unroll
        for (int ai = 0; ai < 2; ++ai)
#pragma unroll
            for (int m = 0; m < 4; ++m) { bf16* rowp = base + (size_t)(row0 + ai * 128 + m * 16) * DL + col0;
#pragma unroll
                for (int bj = 0; bj < 2; ++bj) { const f32x4 v0 = acc[ai][bj][m][0], v1 = acc[ai][bj][m][1];
                    v4u w; w.x = cvt_pk_bf16(v0[0], v0[1]); w.y = cvt_pk_bf16(v0[2], v0[3]); w.z = cvt_pk_bf16(v1[0], v1[1]); w.w = cvt_pk_bf16(v1[2], v1[3]);
                    *(v4u*)(rowp + bj * 128) = w; } }
    }
};
}
namespace mk {
__device__ __forceinline__ void p3_conv(const Args& A, int lane, int wave, int vcu, int G) {
    const int gw = vcu * NWAVES + wave, NGW = G * NWAVES;
    const bf16* U = (const bf16*)(A.ws + WS_U); const bf16* UPART = (const bf16*)(A.ws + WS_UPART); bf16* UC = (bf16*)(A.ws + WS_UC);
    const float* cw = A.in[7]; const float* cb = A.in[8];
    const f32x4 z4 = (f32x4){0.f, 0.f, 0.f, 0.f};
    auto cvt = [&](v2u q) -> f32x4 { return (f32x4){bf_lo(q.x), bf_hi(q.x), bf_lo(q.y), bf_hi(q.y)}; };
    for (int it = gw; it < (TC / 4) * 4; it += NGW) {
        const int rq = it >> 2, cblk = it & 3, r0 = rq * 4, ch = cblk * 256 + lane * 4;
        const int slo = r0 & ~255, shi = slo + 256;
        const f32x4 w0 = *(const f32x4*)(cw + ch), w1 = *(const f32x4*)(cw + DL + ch), w2 = *(const f32x4*)(cw + 2 * DL + ch), w3 = *(const f32x4*)(cw + 3 * DL + ch), bb = *(const f32x4*)(cb + ch);
        f32x4 acc[7];
#pragma unroll
        for (int j = 0; j < 7; ++j) acc[j] = z4;
#pragma unroll
        for (int h = 0; h < 1; ++h) {
            v2u raw[7][4];
#pragma unroll
            for (int j = 0; j < 7; ++j) { int r = r0 - 2 + j; r = r < slo ? slo : (r >= shi ? shi - 1 : r);
#pragma unroll
                for (int ks = 0; ks < 4; ++ks) raw[j][ks] = *(const GAS v2u*)(UPART + ((size_t)(h * 4 + ks) * TC + r) * DL + ch); }
#pragma unroll
            for (int j = 0; j < 7; ++j) {
#pragma unroll
                for (int ks = 0; ks < 4; ++ks) acc[j] = acc[j] + cvt(raw[j][ks]); }
        }
#pragma unroll
        for (int j = 0; j < 7; ++j) { const int r = r0 - 2 + j; if (r < slo || r >= shi) acc[j] = z4; }
#pragma unroll
        for (int p = 0; p < 4; ++p) {
            const f32x4 y = bb + w0 * acc[p] + w1 * acc[p + 1] + w2 * acc[p + 2] + w3 * acc[p + 3];
            v2u o; o.x = pk2(y.x, y.y); o.y = pk2(y.z, y.w); *(GAS v2u*)(UC + (size_t)(T + r0 + p) * DL + ch) = o;
        }
    }
    for (int it = gw; it < (T / 64) * 4; it += NGW) {
        const int rb = it >> 2, cblk = it & 3, r0 = rb * 64, ch = cblk * 256 + lane * 4;
        const f32x4 w0 = *(const f32x4*)(cw + ch), w1 = *(const f32x4*)(cw + DL + ch), w2 = *(const f32x4*)(cw + 2 * DL + ch), w3 = *(const f32x4*)(cw + 3 * DL + ch), bb = *(const f32x4*)(cb + ch);
        const bf16* src = U + (size_t)r0 * DL + ch; bf16* dst = UC + (size_t)r0 * DL + ch;
        v2u raw[3][8];
        const v2u q0 = *(const GAS v2u*)src;
#pragma unroll
        for (int j = 0; j < 8; ++j) raw[0][j] = *(const GAS v2u*)(src + (size_t)(j + 1) * DL);
#pragma unroll
        for (int j = 0; j < 8; ++j) raw[1][j] = *(const GAS v2u*)(src + (size_t)(j + 9) * DL);
        f32x4 um2 = z4, um1 = z4, u0 = cvt(q0);
#pragma unroll
        for (int bq = 0; bq < 8; ++bq) {
            if (bq + 2 < 8) {
#pragma unroll
                for (int j = 0; j < 8; ++j) { const int r = (bq + 2) * 8 + j + 1; if (r < 64) raw[(bq + 2) % 3][j] = *(const GAS v2u*)(src + (size_t)r * DL); }
            }
#pragma unroll
            for (int j = 0; j < 8; ++j) {
                const int p = bq * 8 + j;
                const f32x4 up1 = (p < 63) ? cvt(raw[bq % 3][j]) : z4;
                const f32x4 y = bb + w0 * um2 + w1 * um1 + w2 * u0 + w3 * up1;
                v2u o; o.x = pk2(y.x, y.y); o.y = pk2(y.z, y.w); *(GAS v2u*)(dst + (size_t)p * DL) = o;
                um2 = um1; um1 = u0; u0 = up1;
            }
        }
    }
}
__device__ __forceinline__ void p3_fold(const Args& A, LAS unsigned char* lds, int lane, int wave, int vcu, int G) {
    const int gw = vcu * NWAVES + wave, NGW = G * NWAVES;
    const bf16* FOUR = (const bf16*)(A.ws + WS_FOUR); bf16* PQT = (bf16*)(A.ws + WS_PQT); float* misc = (float*)(A.ws + WS_MISC);
    LAS bf16* scr = (LAS bf16*)(lds + wave * 16384);
    const int c8 = lane & 7, rr = lane >> 3;
    for (int it = gw; it < NB * 16 * 32; it += NGW) {
        const int nb = it & 31, cblk = (it >> 5) & 15, b = it >> 9, g = cblk >> 1, half = cblk & 1, n0 = nb * 64;
        const bf16* base = FOUR + (size_t)b * SEQ * DF + g * 128 + half * 64 + c8 * 8;
#pragma unroll
        for (int s = 0; s < 8; ++s) {
            const int nn = s * 8 + rr, n = n0 + nn;
            const v4u x = *(const GAS v4u*)(base + (size_t)n * DF);
            v4u xm = (v4u){0u, 0u, 0u, 0u}; if (n >= 1) xm = *(const GAS v4u*)(base + (size_t)(SEQ - n) * DF);
            float v[8], vm[8];
            v[0] = bf_lo(x.x); v[1] = bf_hi(x.x); v[2] = bf_lo(x.y); v[3] = bf_hi(x.y); v[4] = bf_lo(x.z); v[5] = bf_hi(x.z); v[6] = bf_lo(x.w); v[7] = bf_hi(x.w);
            vm[0] = bf_lo(xm.x); vm[1] = bf_hi(xm.x); vm[2] = bf_lo(xm.y); vm[3] = bf_hi(xm.y); vm[4] = bf_lo(xm.z); vm[5] = bf_hi(xm.z); vm[6] = bf_lo(xm.w); vm[7] = bf_hi(xm.w);
#pragma unroll
            for (int j = 0; j < 8; ++j) {
                float p;
                if (half == 0) p = v[j] + vm[j];
                else if (c8 == 0 && j == 0) { const float pn = v[0] + vm[0]; misc[MS_P64 + (b * 8 + g) * P64_LD + n] = pn; ((bf16*)(misc + MS_P64B))[(b * 8 + g) * 2048 + n] = (bf16)f2bf(pn); p = 0.f; }
                else p = (n >= 1) ? v[j] - vm[j] : 0.f;
                scr[(c8 * 8 + j) * 66 + nn] = (bf16)f2bf(p);
            }
        }
        LDS_WAIT(); asm volatile("" ::: "memory");
        bf16* dst = PQT + (((size_t)b * 2 + half) * 512 + g * 64) * 2048 + n0 + c8 * 8;
#pragma unroll
        for (int s = 0; s < 8; ++s) {
            const int jj = s * 8 + rr; const LAS bf16* q = scr + jj * 66 + c8 * 8;
            const unsigned a0 = q[0] | ((unsigned)q[1] << 16), a1 = q[2] | ((unsigned)q[3] << 16), a2 = q[4] | ((unsigned)q[5] << 16), a3 = q[6] | ((unsigned)q[7] << 16);
            *(GAS v4u*)(dst + (size_t)jj * 2048) = (v4u){a0, a1, a2, a3};
            if (half == 0) {
                float ps = (bf_lo(a0) - bf_hi(a0)) + (bf_lo(a1) - bf_hi(a1)) + (bf_lo(a2) - bf_hi(a2)) + (bf_lo(a3) - bf_hi(a3));
                ps += __shfl_xor(ps, 1); ps += __shfl_xor(ps, 2); ps += __shfl_xor(ps, 4);
                if (c8 == 0) misc[MS_ALT + (b * 32 + nb) * 512 + g * 64 + jj] = ps;
            }
        }
        LDS_WAIT(); asm volatile("" ::: "memory");
    }
    if (gw < NB * 8) { const int b = gw >> 3, g = gw & 7; if (lane == 0) misc[MS_P64 + (b * 8 + g) * P64_LD + 2048] = bf2f(FOUR[((size_t)b * SEQ + 2048) * DF + g * 128 + 64]); }
}

struct SchedDft {
    static constexpr bool DSTPF = false;
    const char* CS; const char* PQT; int G, c;
    __device__ __forceinline__ bool next(int i, pg8::Unit& u) {
        const int L = i * G + c; if (L >= 256) return false;
        const int b = L >> 5, kt = (L >> 2) & 7, ct = L & 3, type = ct >> 1;
        u.pm = kt; u.pn = ct; u.aux0 = b; u.aux1 = 0; u.nt = 0;
        u.a = CS + ((size_t)type * 2048 + kt * 256) * 4096; u.b = PQT + (((size_t)b * 2 + type) * 512 + (ct & 1) * 256) * 4096; return true;
    }
};
struct EpiDft {
    static constexpr int NST = 0;
    static __device__ __forceinline__ int a_row(int h, int R) { return 128 * h + R; }
    bf16* AB;
    __device__ __forceinline__ void operator()(f32x4 (&acc)[2][2][4][2], const pg8::Unit& u, int wr, int wc, int fr, int fq, LAS unsigned char*) const {
        const int row0 = u.pm * 256 + wr * 64 + fr, col0 = u.pn * 256 + wc * 32 + 4 * fq;
        bf16* base = AB + (size_t)u.aux0 * 2048 * 1024;
#pragma unroll
        for (int ai = 0; ai < 2; ++ai)
#pragma unroll
            for (int m = 0; m < 4; ++m) { bf16* rowp = base + (size_t)(row0 + ai * 128 + m * 16) * 1024 + col0;
#pragma unroll
                for (int bj = 0; bj < 2; ++bj)
#pragma unroll
                    for (int n = 0; n < 2; ++n) { const f32x4 v = acc[ai][bj][m][n]; v2u w; w.x = cvt_pk_bf16(v[0], v[1]); w.y = cvt_pk_bf16(v[2], v[3]); *(v2u*)(rowp + bj * 128 + n * 16) = w; } }
    }
};

struct SchedGates {
    static constexpr bool DSTPF = false;
    const char* UC; const char* WG4; int G, c;
    __device__ __forceinline__ bool next(int i, pg8::Unit& u) {
        const int L = i * G + c; if (L >= (TT / 256) * 16) return false;
        const int st = L >> 4, hq = L & 15;
        u.pm = st; u.pn = hq; u.aux0 = st; u.aux1 = hq; u.nt = 0;
        u.a = UC + (size_t)st * 256 * (DL * 2) + (hq >> 2) * 512; u.b = WG4 + (size_t)hq * 256 * 512; return true;
    }
};
template <int CTRL> __device__ __forceinline__ float dpp_f(float oldv, float src) {
    return __builtin_bit_cast(float, __builtin_amdgcn_update_dpp(__builtin_bit_cast(int, oldv), __builtin_bit_cast(int, src), CTRL, 0xF, 0xF, false));
}
template <int DIR, int DIST> __device__ __forceinline__ void scan_step(float& a, float& b) {
    const float ap = dpp_f<(DIR ? 0x100 : 0x110) + DIST>(1.0f, a), bp = dpp_f<(DIR ? 0x100 : 0x110) + DIST>(0.0f, b);
    b = a * bp + b; a = ap * a;
}
struct EpiLru {
    static constexpr int NST = 18;
    static __device__ __forceinline__ int a_row(int h, int R) { return 128 * (R >> 6) + 8 * (R & 15) + 4 * h + ((R >> 4) & 3); }
    const bf16* UC; const float* ba; const float* bx; bf16* S; bf16* PF; bf16* PB; float* misc;
    __device__ __forceinline__ void operator()(f32x4 (&acc)[2][2][4][2], const pg8::Unit& u, int wr, int wc, int fr, int fq, LAS unsigned char*) const {
        int tz = threadIdx.x; asm volatile("" : "+v"(tz));
        fr = tz & 15; fq = (tz >> 4) & 3;
        const int st = u.aux0, hq = u.aux1, ch0 = hq * 64 + wc * 16 + fq * 4;
        const int row0 = st * 256 + wr * 128 + fr * 8;
        v2u ucp[2][4];
#pragma unroll
        for (int ai = 0; ai < 2; ++ai)
#pragma unroll
            for (int m = 0; m < 4; ++m) ucp[ai][m] = *(const GAS v2u*)((const GAS char*)UC + ((unsigned)(row0 + 4 * ai + m) * DL + ch0) * 2u);
#pragma unroll
        for (int d = 0; d < 2; ++d) {
            const f32x4 bav = *(const f32x4*)(misc + MS_GB + d * 2 * DL + ch0), bxv = *(const f32x4*)(misc + MS_GB + d * 2 * DL + DL + ch0), spv = *(const f32x4*)(misc + MS_SP + d * DL + ch0);
            f32x4 c = (f32x4){1.f, 1.f, 1.f, 1.f}, h = (f32x4){0.f, 0.f, 0.f, 0.f};
#pragma unroll
            for (int ii = 0; ii < 8; ++ii) { const int i = d ? 7 - ii : ii, ai = i >> 2, m = i & 3;
                const f32x4 x = (f32x4){bf_lo(ucp[ai][m].x), bf_hi(ucp[ai][m].x), bf_lo(ucp[ai][m].y), bf_hi(ucp[ai][m].y)};
                const f32x4 p0 = acc[ai][d][m][0] + bav, p1 = acc[ai][d][m][1] + bxv;
                f32x4 a, b;
#pragma unroll
                for (int e = 0; e < 4; ++e) { const float r = __builtin_amdgcn_rcpf(1.0f + __builtin_amdgcn_exp2f(p0[e])), q = 1.0f + __builtin_amdgcn_exp2f(p1[e]); const float av = __builtin_amdgcn_exp2f(r * spv[e]); a[e] = av;
                    const float om = fmaxf(1.0f - av * av, 0.f); b[e] = om * __builtin_amdgcn_rsqf(fmaxf(om * q * q, 1e-30f)); }
                h = a * h + b * x; c = c * a; acc[ai][d][m][0] = c; acc[ai][d][m][1] = h;
                if (ii & 1) __builtin_amdgcn_sched_barrier(0); }
            f32x4 cin, hin;
#pragma unroll
            for (int e = 0; e < 4; ++e) { float ta = c[e], tb = h[e];
                if (d == 0) { scan_step<0, 1>(ta, tb); scan_step<0, 2>(ta, tb); scan_step<0, 4>(ta, tb); scan_step<0, 8>(ta, tb); }
                else        { scan_step<1, 1>(ta, tb); scan_step<1, 2>(ta, tb); scan_step<1, 4>(ta, tb); scan_step<1, 8>(ta, tb); }
                cin[e] = d ? dpp_f<0x101>(1.0f, ta) : dpp_f<0x111>(1.0f, ta); hin[e] = d ? dpp_f<0x101>(0.0f, tb) : dpp_f<0x111>(0.0f, tb); }
#pragma unroll
            for (int i = 0; i < 8; ++i) { const int ai = i >> 2, m = i & 3; const f32x4 cl = acc[ai][d][m][0]; acc[ai][d][m][1] = acc[ai][d][m][1] + cl * hin; acc[ai][d][m][0] = cl * cin; }
            __builtin_amdgcn_sched_barrier(0);
        }
        const int sub = st * 2 + wr;
#pragma unroll
        for (int ai = 0; ai < 2; ++ai)
#pragma unroll
            for (int m = 0; m < 4; ++m) {
                const f32x4 pf = acc[ai][0][m][0], hf = acc[ai][0][m][1], pb = acc[ai][1][m][0], hb = acc[ai][1][m][1];
                const unsigned off = ((unsigned)(row0 + 4 * ai + m) * DL + ch0) * 2u;
                if (st < T / 256) {
                    v2u o; o.x = cvt_pk_bf16(hf[0] + hb[0], hf[1] + hb[1]); o.y = cvt_pk_bf16(hf[2] + hb[2], hf[3] + hb[3]); *(GAS v2u*)((GAS char*)S + off) = o;
                    o.x = cvt_pk_bf16(pf[0], pf[1]); o.y = cvt_pk_bf16(pf[2], pf[3]); *(GAS v2u*)((GAS char*)PF + off) = o;
                    o.x = cvt_pk_bf16(pb[0], pb[1]); o.y = cvt_pk_bf16(pb[2], pb[3]); *(GAS v2u*)((GAS char*)PB + off) = o;
                }
                if (ai == 1 && m == 3 && fr == 15) { *(f32x4*)(misc + MS_SUMA + ((size_t)sub * 2 + 0) * DL + ch0) = pf; *(f32x4*)(misc + MS_SUMB + ((size_t)sub * 2 + 0) * DL + ch0) = hf; }
                if (ai == 0 && m == 0 && fr == 0) { *(f32x4*)(misc + MS_SUMA + ((size_t)sub * 2 + 1) * DL + ch0) = pb; *(f32x4*)(misc + MS_SUMB + ((size_t)sub * 2 + 1) * DL + ch0) = hb; }
            }
    }
};

template <int PART = 3>
__device__ __forceinline__ void p5a_fix(const Args& A, LAS unsigned char* lds, int tid, int lane, int wave, int vcu, int G, int wg0 = 0, int nwg = 0) {
    const int gw = vcu * NWAVES + wave, NGW = G * NWAVES;
    const float* misc = (const float*)(A.ws + WS_MISC);
    const bf16* Sb = (const bf16*)(A.ws + WS_S); const bf16* PF = (const bf16*)(A.ws + WS_PF); const bf16* PB = (const bf16*)(A.ws + WS_PB); const bf16* GATE = (const bf16*)(A.ws + WS_GATE);
    bf16* YMIX = (bf16*)(A.ws + WS_YMIX); const float* gl = A.in[14];
    if ((PART & 1) && vcu >= wg0) {
        const int NP = nwg > 0 ? nwg : G, pw = vcu - wg0;
        float* nyq = (float*)(A.ws + WS_MISC) + MS_NYQ;
        const bf16* CSm = (const bf16*)(A.ws + WS_CS); const bf16* P64B = (const bf16*)(misc + MS_P64B);
        const int arow = lane & 15, akq = lane >> 4;
        LAS f32x4* red = (LAS f32x4*)lds;
        for (int base = 0; base < 128 * 4; base += 2 * NP) {
            const int it = base + (wave & 1) * NP + pw, kq = wave >> 1;
            const bool act = it < 128 * 4;
            const int k0 = (it >> 2) * 16, bg0 = (it & 3) * 16;
            f32x4 acc = (f32x4){0.f, 0.f, 0.f, 0.f};
            if (act) {
                const bf16* ap = CSm + (size_t)(k0 + arow) * 2048 + kq * 512 + akq * 8; const bf16* bp = P64B + (size_t)(bg0 + arow) * 2048 + kq * 512 + akq * 8;
                bf16x8 af[16], bq[16];
#pragma unroll
                for (int ks = 0; ks < 16; ++ks) { af[ks] = *(const GAS bf16x8*)(ap + ks * 32); bq[ks] = *(const GAS bf16x8*)(bp + ks * 32); }
#pragma unroll
                for (int ks = 0; ks < 16; ++ks) acc = __builtin_amdgcn_mfma_f32_16x16x32_bf16(af[ks], bq[ks], acc, 0, 0, 0);
            }
            __syncthreads();
            red[wave * 64 + lane] = acc;
            __syncthreads();
            if (act && kq == 0) {
                acc = acc + red[(wave + 2) * 64 + lane] + red[(wave + 4) * 64 + lane] + red[(wave + 6) * 64 + lane];
                const int bg = bg0 + arow; const float p2048 = misc[MS_P64 + (size_t)bg * P64_LD + 2048];
                f32x4 o;
#pragma unroll
                for (int r = 0; r < 4; ++r) o[r] = acc[r] + (((4 * akq + r) & 1) ? -p2048 : p2048);
                *(f32x4*)(nyq + (size_t)bg * P64_LD + k0 + 4 * akq) = o;
            }
        }
        for (int bg = pw * NWAVES + wave; bg < 64; bg += NP * NWAVES) { const float* src = misc + MS_P64 + (size_t)bg * P64_LD; float a = 0.f;
#pragma unroll 8
            for (int n = lane; n < 2048; n += 64) a += (n & 1) ? -src[n] : src[n];
            a = wave_sum(a) + src[2048]; if (lane == 0) nyq[(size_t)bg * P64_LD + 2048] = a; }
    }
    if (PART & 2)
    for (int sc = vcu; sc < T / 128; sc += G) {
        const int it = sc * 8 + wave;
        const int t0 = it * 16, b = t0 / SEQ, c = (t0 % SEQ) / 128, ch = lane * 16;
        LAS float* cl = (LAS float*)lds;
        __syncthreads();
        {   const int c2 = tid * 2, cs0 = T / 128 + 2 * b;
            typedef float v2f __attribute__((ext_vector_type(2)));
            auto LA = [&](int sub, int d) -> v2f { return *(const v2f*)(misc + MS_SUMA + ((size_t)sub * 2 + d) * DL + c2); };
            auto LB = [&](int sub, int d) -> v2f { return *(const v2f*)(misc + MS_SUMB + ((size_t)sub * 2 + d) * DL + c2); };
            v2f f = LA(cs0 + 1, 0) * LB(cs0, 0) + LB(cs0 + 1, 0), r = LA(cs0, 1) * LB(cs0 + 1, 1) + LB(cs0, 1);
            for (int cc0 = 0; cc0 < c; cc0 += 8) { v2f a[8], q[8];
#pragma unroll
                for (int k = 0; k < 8; ++k) { const int cc = (cc0 + k < c) ? cc0 + k : c - 1; a[k] = LA(b * NSUB + cc, 0); q[k] = LB(b * NSUB + cc, 0); }
#pragma unroll
                for (int k = 0; k < 8; ++k) if (cc0 + k < c) f = a[k] * f + q[k]; }
            for (int cc0 = NSUB - 1; cc0 > c; cc0 -= 8) { v2f a[8], q[8];
#pragma unroll
                for (int k = 0; k < 8; ++k) { const int cc = (cc0 - k > c) ? cc0 - k : c + 1; a[k] = LA(b * NSUB + cc, 1); q[k] = LB(b * NSUB + cc, 1); }
#pragma unroll
                for (int k = 0; k < 8; ++k) if (cc0 - k > c) r = a[k] * r + q[k]; }
            *(LAS v2f*)(cl + c2) = f; *(LAS v2f*)(cl + 1024 + c2) = r;
        }
        __syncthreads();
        float cf[16], cbk[16];
#pragma unroll
        for (int q = 0; q < 4; ++q) { const f32x4 vf = *(const LAS f32x4*)(cl + ch + 4 * q), vb = *(const LAS f32x4*)(cl + 1024 + ch + 4 * q);
#pragma unroll
            for (int e = 0; e < 4; ++e) { cf[4 * q + e] = vf[e]; cbk[4 * q + e] = vb[e]; } }
        v4u nx[2][4];
        { const size_t off = (size_t)t0 * DL + ch;
#pragma unroll
          for (int hh = 0; hh < 2; ++hh) { nx[hh][0] = *(const GAS v4u*)(Sb + off + 8 * hh); nx[hh][1] = *(const GAS v4u*)(PF + off + 8 * hh); nx[hh][2] = *(const GAS v4u*)(PB + off + 8 * hh); nx[hh][3] = *(const GAS v4u*)(GATE + off + 8 * hh); } }
        for (int tt = 0; tt < 16; ++tt) {
            v4u cu[2][4];
#pragma unroll
            for (int hh = 0; hh < 2; ++hh)
#pragma unroll
                for (int a4 = 0; a4 < 4; ++a4) cu[hh][a4] = nx[hh][a4];
            if (tt < 15) { const size_t off = (size_t)(t0 + tt + 1) * DL + ch;
#pragma unroll
                for (int hh = 0; hh < 2; ++hh) { nx[hh][0] = *(const GAS v4u*)(Sb + off + 8 * hh); nx[hh][1] = *(const GAS v4u*)(PF + off + 8 * hh); nx[hh][2] = *(const GAS v4u*)(PB + off + 8 * hh); nx[hh][3] = *(const GAS v4u*)(GATE + off + 8 * hh); } }
            float y[16]; float ss = 0.f;
#pragma unroll
            for (int hh = 0; hh < 2; ++hh) {
                const v4u s4 = cu[hh][0], f4 = cu[hh][1], b4 = cu[hh][2], g4 = cu[hh][3];
                const unsigned sw[4] = {s4.x, s4.y, s4.z, s4.w}, fw[4] = {f4.x, f4.y, f4.z, f4.w}, bw[4] = {b4.x, b4.y, b4.z, b4.w}, gw4[4] = {g4.x, g4.y, g4.z, g4.w};
#pragma unroll
                for (int q = 0; q < 4; ++q) { const int i0 = 8 * hh + 2 * q;
                    const float v0 = (bf_lo(sw[q]) + bf_lo(fw[q]) * cf[i0] + bf_lo(bw[q]) * cbk[i0]) * gelu_tanh_f(bf_lo(gw4[q]));
                    const float v1 = (bf_hi(sw[q]) + bf_hi(fw[q]) * cf[i0 + 1] + bf_hi(bw[q]) * cbk[i0 + 1]) * gelu_tanh_f(bf_hi(gw4[q]));
                    y[i0] = v0; y[i0 + 1] = v1; ss += v0 * v0 + v1 * v1; }
            }
            const float r = 1.0f / sqrtf(wave_sum(ss) * (1.0f / DL) + EPS);
            float gn[16];
#pragma unroll
            for (int q = 0; q < 4; ++q) { const f32x4 v = *(const f32x4*)(gl + ch + 4 * q);
#pragma unroll
                for (int e = 0; e < 4; ++e) gn[4 * q + e] = v[e]; }
            const float r8 = r * YMIX_SCALE; v4u o0;
            o0.x = pk4_fp8(y[0] * r8 * gn[0], y[1] * r8 * gn[1], y[2] * r8 * gn[2], y[3] * r8 * gn[3]); o0.y = pk4_fp8(y[4] * r8 * gn[4], y[5] * r8 * gn[5], y[6] * r8 * gn[6], y[7] * r8 * gn[7]);
            o0.z = pk4_fp8(y[8] * r8 * gn[8], y[9] * r8 * gn[9], y[10] * r8 * gn[10], y[11] * r8 * gn[11]); o0.w = pk4_fp8(y[12] * r8 * gn[12], y[13] * r8 * gn[13], y[14] * r8 * gn[14], y[15] * r8 * gn[15]);
            *(GAS v4u*)((unsigned char*)YMIX + (size_t)(t0 + tt) * D + ch) = o0;
        }
    }
}

__device__ __forceinline__ void p5b_four(const Args& A, LAS unsigned char* lds, int lane, int wave, int vcu, int G) {
    const int gw = vcu * NWAVES + wave, NGW = G * NWAVES;
    const float* misc = (const float*)(A.ws + WS_MISC); const bf16* AB = (const bf16*)(A.ws + WS_AB); const bf16* FOUR = (const bf16*)(A.ws + WS_FOUR);
    bf16* YMIX = (bf16*)(A.ws + WS_YMIX); const float* gf = A.in[15];
    const int g = lane >> 3, jl = lane & 7, nbl = (lane & ~7) | ((lane + 1) & 7);
    float gf0[8], gf1[8];
#pragma unroll
    for (int q = 0; q < 2; ++q) { const f32x4 v0 = *(const f32x4*)(gf + g * 128 + 8 * jl + 4 * q), v1 = *(const f32x4*)(gf + g * 128 + 8 * (15 - jl) + 4 * q);
#pragma unroll
        for (int e = 0; e < 4; ++e) { gf0[4 * q + e] = v0[e]; gf1[4 * q + e] = v1[e]; } }
    auto unpack = [&](const v4u a, float* o) { o[0] = bf_lo(a.x); o[1] = bf_hi(a.x); o[2] = bf_lo(a.y); o[3] = bf_hi(a.y); o[4] = bf_lo(a.z); o[5] = bf_hi(a.z); o[6] = bf_lo(a.w); o[7] = bf_hi(a.w); };
    auto put = [&](int t, const float* c0, float nb, const float* c1, float r) {
        const float r8 = r * YMIX_SCALE; v2u o0, o1;
        o0.x = pk4_fp8(c0[0] * r8 * gf0[0], c0[1] * r8 * gf0[1], c0[2] * r8 * gf0[2], c0[3] * r8 * gf0[3]); o0.y = pk4_fp8(c0[4] * r8 * gf0[4], c0[5] * r8 * gf0[5], c0[6] * r8 * gf0[6], c0[7] * r8 * gf0[7]);
        o1.x = pk4_fp8(nb * r8 * gf1[0], c1[7] * r8 * gf1[1], c1[6] * r8 * gf1[2], c1[5] * r8 * gf1[3]); o1.y = pk4_fp8(c1[4] * r8 * gf1[4], c1[3] * r8 * gf1[5], c1[2] * r8 * gf1[6], c1[1] * r8 * gf1[7]);
        unsigned char* dst = (unsigned char*)YMIX + (size_t)t * D + DL + g * 128;
        *(GAS v2u*)(dst + 8 * jl) = o0; *(GAS v2u*)(dst + 8 * (15 - jl)) = o1; };
    for (int it0 = gw * 8; it0 < NB * 2048; it0 += NGW * 8) {
        const int b = it0 >> 11, kp0 = it0 & 2047;
        float wv[8]; unpack(*(const GAS v4u*)(FOUR + ((size_t)b * SEQ + 2048) * DF + g * 128 + jl * 8), wv);
        v4u ra[8], rb[8]; float nq[8];
#pragma unroll
        for (int j = 0; j < 8; ++j) { const bf16* row = AB + ((size_t)b * 2048 + kp0 + j) * 1024 + g * 64 + jl * 8;
            ra[j] = *(const GAS v4u*)row; rb[j] = *(const GAS v4u*)(row + 512); nq[j] = misc[MS_NYQ + (size_t)(b * 8 + g) * P64_LD + kp0 + j]; }
#pragma unroll
        for (int j = 0; j < 8; ++j) {
            const int kp = kp0 + j; const float sk = (kp & 1) ? -1.0f : 1.0f;
            float av[8], bv[8], y0[8], y1[8]; unpack(ra[j], av); unpack(rb[j], bv);
            float ss = 0.f;
#pragma unroll
            for (int i = 0; i < 8; ++i) { const float a = av[i] + sk * wv[i]; y0[i] = a + bv[i]; y1[i] = a - bv[i]; }
            if (jl == 0) { y0[0] = av[0] + sk * wv[0]; y1[0] = nq[j]; }
#pragma unroll
            for (int i = 0; i < 8; ++i) ss += y0[i] * y0[i] + y1[i] * y1[i];
            const float r = 1.0f / sqrtf(wave_sum(ss) * (1.0f / DF) + EPS);
            put(b * SEQ + kp, y0, __shfl(y1[0], nbl), y1, r);
            if (kp >= 1) {
                const float e2 = (jl == 0) ? y1[0] : y0[0];
                if (jl != 0) y0[0] = y1[0];
                float m0[8]; m0[0] = y0[0];
#pragma unroll
                for (int i = 1; i < 8; ++i) m0[i] = y1[i];
                put(b * SEQ + SEQ - kp, m0, __shfl(e2, nbl), y0, r);
            }
        }
        if (kp0 == 0) {
            float av[8];
#pragma unroll
            for (int i = 0; i < 8; ++i) av[i] = wv[i];
#pragma unroll 8
            for (int nb = 0; nb < 32; ++nb) { const float* p = misc + MS_ALT + ((size_t)b * 32 + nb) * 512 + g * 64 + jl * 8; const f32x4 p0 = *(const f32x4*)p, p1 = *(const f32x4*)(p + 4);
                av[0] += p0[0]; av[1] += p0[1]; av[2] += p0[2]; av[3] += p0[3]; av[4] += p1[0]; av[5] += p1[1]; av[6] += p1[2]; av[7] += p1[3]; }
            float y1[8];
#pragma unroll
            for (int i = 0; i < 8; ++i) y1[i] = av[i];
            if (jl == 0) y1[0] = misc[MS_NYQ + (size_t)(b * 8 + g) * P64_LD + 2048];
            float ss = 0.f;
#pragma unroll
            for (int i = 0; i < 8; ++i) ss += av[i] * av[i] + y1[i] * y1[i];
            const float r = 1.0f / sqrtf(wave_sum(ss) * (1.0f / DF) + EPS);
            put(b * SEQ + 2048, av, __shfl(y1[0], nbl), y1, r);
        }
    }
}
}
namespace mk {
struct SchedTiles {      static constexpr bool DSTPF = false;
    const char* Abase; const char* Bbase; int nM, nN, G, c; unsigned lda_b, ldb_b;
    __device__ __forceinline__ bool next(int i, pg8::Unit& u) {
        const int L = i * G + c; if (L >= nM * nN) return false;
        int pm, pn; tile_order(L, nM, nN, pm, pn);
        u.pm = pm; u.pn = pn; u.aux0 = 0; u.aux1 = 0; u.nt = 0; u.a = Abase + (size_t)pm * 256 * lda_b; u.b = Bbase + (size_t)pn * 256 * ldb_b; return true;
    }
};
struct EpiBf16 {
    static constexpr int NST = 16;
    static __device__ __forceinline__ int a_row(int h, int R) { return 128 * h + R; }
    bf16* O; int ldc;
    __device__ __forceinline__ void operator()(f32x4 (&acc)[2][2][4][2], const pg8::Unit& u, int wr, int wc, int fr, int fq, LAS unsigned char*) const {
        const int row0 = u.pm * 256 + wr * 64 + fr, col0 = u.pn * 256 + wc * 32 + 8 * fq;
#pragma unroll
        for (int ai = 0; ai < 2; ++ai)
#pragma unroll
            for (int m = 0; m < 4; ++m) { const unsigned off = ((unsigned)(row0 + ai * 128 + m * 16) * (unsigned)ldc + col0) * 2u;
#pragma unroll
                for (int bj = 0; bj < 2; ++bj) { const f32x4 v0 = acc[ai][bj][m][0], v1 = acc[ai][bj][m][1];
                    v4u w; w.x = cvt_pk_bf16(v0[0], v0[1]); w.y = cvt_pk_bf16(v0[2], v0[3]); w.z = cvt_pk_bf16(v1[0], v1[1]); w.w = cvt_pk_bf16(v1[2], v1[3]);
                    *(GAS v4u*)((GAS char*)O + off + bj * 256) = w; } }
    }
};

constexpr int P8_BPITCH = 264;
template <int PART = 3>
__device__ __forceinline__ void p8_ln_router(const Args& A, LAS unsigned char* lds, int tid, int lane, int wave, int vcu, int G) {
    const float* mod = (const float*)(A.ws + WS_MOD); const bf16* MIX = (const bf16*)(A.ws + WS_MIX);
    bf16* H2LO = (bf16*)(A.ws + WS_H2LO); unsigned* H2F8 = (unsigned*)(A.ws + WS_H2F8); const bf16* WR = (const bf16*)(A.ws + WS_WR);
    int* cnt = (int*)(A.ws + WS_CTL) + CW_CNT; int* rt_tok = (int*)(A.ws + WS_ROUTE + RT_TOK); int* rt_dst = (int*)(A.ws + WS_ROUTE + RT_DST); float* rt_w = (float*)(A.ws + WS_ROUTE + RT_W);
    LAS bf16* bl = (LAS bf16*)lds;
    LAS float* lg = (LAS float*)(lds + 2 * 64 * P8_BPITCH * 2) + wave * (16 * 65);
    { const int gw = vcu * NWAVES + wave, NGW = G * NWAVES;
      for (int i = gw * 64 + lane; i < T; i += NGW * 64) { const int s = i / TS, tl = i % TS; rt_tok[((size_t)s * NEX + NE) * TS + tl] = tl; rt_dst[((size_t)s * NEX + NE) * TS + tl] = tl * 9 + 8; } }
    for (int tb = vcu; tb < T / 128; tb += G) {
        const int t0 = tb * 128 + wave * 16;
        LAS f32x4* pv = (LAS f32x4*)lds;
        {   const int b = (tb * 128) / SEQ; __syncthreads();
            const f32x4* s0 = (const f32x4*)(mod + (size_t)b * MODW + 2 * D); const f32x4* s1 = (const f32x4*)A.in[17]; const f32x4* s2 = (const f32x4*)A.in[18];
            const f32x4* s3 = (const f32x4*)(mod + (size_t)b * MODW + 3 * D); const f32x4* s4 = (const f32x4*)(mod + (size_t)b * MODW + 4 * D);
            pv[tid] = s0[tid]; pv[512 + tid] = s1[tid]; pv[1024 + tid] = s2[tid]; pv[1536 + tid] = s3[tid]; pv[2048 + tid] = s4[tid];
            __syncthreads(); }
        f32x4 lacc[4]; const int arow = lane & 15, akq = lane >> 4;
        if (PART & 1)
        for (int i = 0; i < 16; i += 2) {
            asm volatile("" ::: "memory");
            const int t = t0 + i;
            const GAS f32x4* xr = (const GAS f32x4*)(A.in[0] + (size_t)t * D) + lane; const GAS v2u* mr = (const GAS v2u*)(MIX + (size_t)t * D) + lane;
            const LAS f32x4* g1 = pv + lane;
            f32x4 v[8], u[8]; float s = 0.f, q = 0.f;
#pragma unroll
            for (int j = 0; j < 8; ++j) { const f32x4 xv = __builtin_nontemporal_load(xr + 64 * j), xw = __builtin_nontemporal_load(xr + 64 * j + 512), gv = g1[64 * j]; const v2u mv = __builtin_nontemporal_load(mr + 64 * j), mw = __builtin_nontemporal_load(mr + 64 * j + 512);
                v[j] = xv * ALPHA + gv * (f32x4){bf_lo(mv.x), bf_hi(mv.x), bf_lo(mv.y), bf_hi(mv.y)}; s += (v[j].x + v[j].y) + (v[j].z + v[j].w);
                u[j] = xw * ALPHA + gv * (f32x4){bf_lo(mw.x), bf_hi(mw.x), bf_lo(mw.y), bf_hi(mw.y)}; q += (u[j].x + u[j].y) + (u[j].z + u[j].w); }
            float mean = wave_sum(s) * (1.f / D), meanu = wave_sum(q) * (1.f / D), s2 = 0.f, q2 = 0.f;
#pragma unroll
            for (int j = 0; j < 8; ++j) { v[j] = v[j] - mean; u[j] = u[j] - meanu; s2 += (v[j].x * v[j].x + v[j].y * v[j].y) + (v[j].z * v[j].z + v[j].w * v[j].w); q2 += (u[j].x * u[j].x + u[j].y * u[j].y) + (u[j].z * u[j].z + u[j].w * u[j].w); }
            float rstd = 1.f / sqrtf(wave_sum(s2) * (1.f / D) + EPS), rstdu = 1.f / sqrtf(wave_sum(q2) * (1.f / D) + EPS);
            const LAS f32x4* lg1 = pv + 512 + lane; const LAS f32x4* lb1 = pv + 1024 + lane; GAS v2u* xo = (GAS v2u*)(A.out + (size_t)t * D) + lane;
            s = 0.f; q = 0.f;
#pragma unroll
            for (int j = 0; j < 8; ++j) { const f32x4 lg = lg1[64 * j], lb = lb1[64 * j]; v[j] = v[j] * rstd * lg + lb; u[j] = u[j] * rstdu * lg + lb; { v2u o; o.x = pk2(v[j].x, v[j].y); o.y = pk2(v[j].z, v[j].w); xo[64 * j] = o; o.x = pk2(u[j].x, u[j].y); o.y = pk2(u[j].z, u[j].w); xo[64 * j + 1024] = o; }
                s += (v[j].x + v[j].y) + (v[j].z + v[j].w); q += (u[j].x + u[j].y) + (u[j].z + u[j].w); }
            mean = wave_sum(s) * (1.f / D); meanu = wave_sum(q) * (1.f / D); s2 = 0.f; q2 = 0.f;
#pragma unroll
            for (int j = 0; j < 8; ++j) { v[j] = v[j] - mean; u[j] = u[j] - meanu; s2 += (v[j].x * v[j].x + v[j].y * v[j].y) + (v[j].z * v[j].z + v[j].w * v[j].w); q2 += (u[j].x * u[j].x + u[j].y * u[j].y) + (u[j].z * u[j].z + u[j].w * u[j].w); }
            rstd = 1.f / sqrtf(wave_sum(s2) * (1.f / D) + EPS); rstdu = 1.f / sqrtf(wave_sum(q2) * (1.f / D) + EPS);
            const LAS f32x4* sh2 = pv + 1536 + lane; const LAS f32x4* sc2 = pv + 2048 + lane;
#pragma unroll
            for (int tt = 0; tt < 2; ++tt) {
                GAS v2u* ol = (GAS v2u*)(H2LO + (size_t)(t + tt) * D) + lane; GAS unsigned* o8 = (GAS unsigned*)(H2F8 + (size_t)(t + tt) * (D / 4)) + lane;
#pragma unroll
                for (int j = 0; j < 8; ++j) { const f32x4 y = (tt ? u[j] * rstdu : v[j] * rstd) * (sc2[64 * j] + 1.0f) + sh2[64 * j];
                    const unsigned p8 = pk4_fp8(y.x, y.y, y.z, y.w); o8[64 * j] = p8; const f32x4 yq = fp8x4_to_f32(p8);
                    v2u o; o.x = pk2(y.x - yq.x, y.y - yq.y); o.y = pk2(y.z - yq.z, y.w - yq.w); ol[64 * j] = o; }
            }
        }
        VM_WAIT();
        if (!(PART & 2)) continue;
#pragma unroll
        for (int n = 0; n < 4; ++n) lacc[n] = (f32x4){0.f, 0.f, 0.f, 0.f};
        v4u wreg[8]; v2u araw[2][8]; bf16x8 areg[2][8];
        auto ldw = [&](int kc) {
#pragma unroll
            for (int q = 0; q < 8; ++q) { const int p = q * NTHR + tid, rowi = p >> 5, piece = p & 31; wreg[q] = *(const GAS v4u*)(WR + (size_t)rowi * D + kc * 256 + piece * 8); } };
        auto lda = [&](int kc, int buf) {
#pragma unroll
            for (int ks = 0; ks < 8; ++ks) { const size_t aoff = (size_t)(t0 + arow) * D + kc * 256 + ks * 32 + akq * 8;
                araw[buf][ks] = *(const GAS v2u*)((const unsigned char*)H2F8 + aoff); areg[buf][ks] = *(const GAS bf16x8*)(H2LO + aoff); } };
        ldw(0); lda(0, 0);
#pragma unroll
        for (int kc = 0; kc < 8; ++kc) {
            __syncthreads();
#pragma unroll
            for (int q = 0; q < 8; ++q) { const int p = q * NTHR + tid, rowi = p >> 5, piece = p & 31; *(LAS v4u*)(bl + rowi * P8_BPITCH + piece * 8) = wreg[q]; }
            __syncthreads();
            if (kc + 1 < 8) { ldw(kc + 1); lda(kc + 1, (kc + 1) & 1); }
#pragma unroll
            for (int ks = 0; ks < 8; ++ks) {
                const bf16x8 al = areg[kc & 1][ks]; bf16x8 ah;
                {   const v2u q = araw[kc & 1][ks]; v4u hb; hb.x = fp8x2_to_bf16x2(q.x, false); hb.y = fp8x2_to_bf16x2(q.x, true); hb.z = fp8x2_to_bf16x2(q.y, false); hb.w = fp8x2_to_bf16x2(q.y, true);
                    ah = __builtin_bit_cast(bf16x8, hb); }
#pragma unroll
                for (int n = 0; n < 4; ++n) {
                    const bf16x8 bh = *(const LAS bf16x8*)(bl + (n * 16 + arow) * P8_BPITCH + ks * 32 + akq * 8);
                    const bf16x8 blo = *(const LAS bf16x8*)(bl + (64 + n * 16 + arow) * P8_BPITCH + ks * 32 + akq * 8);
                    lacc[n] = __builtin_amdgcn_mfma_f32_16x16x32_bf16(ah, bh, lacc[n], 0, 0, 0);
                    lacc[n] = __builtin_amdgcn_mfma_f32_16x16x32_bf16(al, bh, lacc[n], 0, 0, 0);
                    lacc[n] = __builtin_amdgcn_mfma_f32_16x16x32_bf16(ah, blo, lacc[n], 0, 0, 0);
                }
            }
        }
#pragma unroll
        for (int n = 0; n < 4; ++n)
#pragma unroll
            for (int r = 0; r < 4; ++r) lg[(4 * akq + r) * 65 + 16 * n + arow] = lacc[n][r];
        LDS_WAIT(); asm volatile("" ::: "memory");
        const float rb = A.in[20][lane];
        unsigned cmask = 0u;
#pragma unroll 4
        for (int i = 0; i < 16; ++i) {
            const float z = lg[i * 65 + lane]; const float sc = 1.0f / (1.0f + expf(-z)); const float sel = sc + rb;
            const float m1 = group8_max(sel);
            const unsigned long long eq = __ballot(sel == m1); const unsigned grp = (unsigned)(eq >> (lane & ~7)) & 0xffu; const int first = __builtin_ctz(grp | 0x100u);
            const float m2 = group8_max(((lane & 7) == first) ? -1e30f : sel);
            const float gs = m1 + m2; const int g = lane >> 3;
            int grank = 0;
#pragma unroll
            for (int qq = 0; qq < 8; ++qq) { const float o = __builtin_bit_cast(float, __builtin_amdgcn_readlane(__builtin_bit_cast(int, gs), qq * 8)); grank += (o > gs || (o == gs && qq < g)) ? 1 : 0; }
            const bool allowed = grank < 4;
            const float msel = allowed ? sel : -1e30f;
            int kb = __builtin_bit_cast(int, msel); kb ^= (kb >> 31) & 0x7fffffff; const int key = (kb & ~63) | (63 - lane);
            int rank = 0;
#pragma unroll
            for (int qq = 0; qq < 64; ++qq) { const int o = __builtin_amdgcn_readlane(key, qq); rank += (o > key) ? 1 : 0; }
            const bool chosen = allowed && rank < 8;
            const float wsum = wave_sum(chosen ? sc : 0.f);
            cmask |= (chosen ? 1u : 0u) << i;
            lg[i * 65 + lane] = sc; if (lane == 0) lg[i * 65 + 64] = 2.5f / (wsum + 1e-20f);
        }
        {   const int sl = t0 / TS, ncho = __builtin_popcount(cmask);
            int base = 0; if (ncho) base = atomicAdd(&cnt[sl * 64 + lane], ncho);
            for (int i = 0; i < 16; ++i) {
                const bool chosen = (cmask >> i) & 1u; const unsigned long long cm = __ballot(chosen);
                if (chosen) {
                    const int t = t0 + i, tl = t % TS, j = __builtin_popcountll(cm & ((1ull << lane) - 1ull)), pos = base + __builtin_popcount(cmask & ((1u << i) - 1u));
                    rt_tok[((size_t)sl * NEX + lane) * TS + pos] = tl; rt_dst[((size_t)sl * NEX + lane) * TS + pos] = tl * 9 + j;
                    rt_w[(size_t)t * 8 + j] = lg[i * 65 + lane] * lg[i * 65 + 64];
                }
            }
        }
    }
}

struct MoeTab { LAS int* ucum; LAS int* segoff; LAS int* cnt; LAS int* idbuf; LAS int* myexp; };
__device__ __forceinline__ MoeTab moe_tab(LAS unsigned char* lds) { MoeTab m; m.ucum = (LAS int*)(lds + SCR_OFF); m.segoff = m.ucum + 72; m.cnt = m.segoff + 72; m.idbuf = m.cnt + 72; m.myexp = m.idbuf + 768; return m; }
__device__ __forceinline__ void moe_tables(const Args& A, LAS unsigned char* lds, int s, int ctiles, int tid, int G, int c) {
    MoeTab m = moe_tab(lds); const int* cnt = (const int*)(A.ws + WS_CTL) + CW_CNT + s * 64;
    __syncthreads();
    if (tid < 64) m.cnt[tid] = __hip_atomic_load(cnt + tid, RLX_AGENT);
    if (tid == 64) m.cnt[64] = TS;
    __syncthreads();
    if (tid == 0) { int u = 0, r = 0; for (int e = 0; e < NEX; ++e) { m.ucum[e] = u; m.segoff[e] = r; const int tl = (m.cnt[e] + 255) >> 8; u += tl * ctiles; r += tl * 256; } m.ucum[NEX] = u; }
    __syncthreads();
    if (tid < 256) { const int L = tid * G + c; int e = -1; if (L < m.ucum[NEX]) { e = 0; for (int q = 1; q < NEX; ++q) e += (m.ucum[q] <= L) ? 1 : 0; } m.myexp[tid] = e; }
    __syncthreads();
}
template <bool DSTPF_> struct SchedMoe {
    static constexpr bool DSTPF = DSTPF_;
    const int* dsts;
    MoeTab tb; const char* Abase; const char* Bbase; const int* lists; int G, c, ctiles; unsigned a_pitch, bexp_bytes, btile_bytes; bool gather;
    __device__ __forceinline__ bool next(int i, pg8::Unit& u) {
        if (i >= 256) return false; const int e = tb.myexp[i]; if (e < 0) return false; const int L = i * G + c;
        const int r = L - tb.ucum[e], rt = r / ctiles, ct = r % ctiles;
        u.pm = rt; u.pn = ct | ((i % 3) << 8); u.aux0 = e; u.aux1 = tb.segoff[e] + rt * 256; u.nt = 0;
        u.a = gather ? Abase : Abase + (size_t)u.aux1 * a_pitch; u.b = Bbase + (size_t)e * bexp_bytes + (size_t)ct * btile_bytes; return true;
    }
    __device__ __forceinline__ unsigned row_off_global(const pg8::Unit& u, int row) const {
        const int n = tb.cnt[u.aux0]; int idx = u.pm * 256 + row; idx = idx < n ? idx : n - 1;
        return (unsigned)lists[(size_t)u.aux0 * TS + idx] * a_pitch;
    }
    __device__ __forceinline__ void prefetch_rows(const pg8::Unit& u, int ui, LAS unsigned char* lds, int wid, int lane) const {
        if (wid < 4) { const int n = tb.cnt[u.aux0]; int idx = u.pm * 256 + wid * 64 + lane; idx = idx < n ? idx : n - 1;
            __builtin_amdgcn_global_load_lds((const unsigned*)(lists + (size_t)u.aux0 * TS + idx), (LAS unsigned*)(tb.idbuf + (ui & 1) * 256 + wid * 64), 4, 0, 0); }
    }
    __device__ __forceinline__ void prefetch_dst(const pg8::Unit& u, int ui, int wid, int lane) const {
        if (wid < 4) { const int n = tb.cnt[u.aux0]; int idx = u.pm * 256 + wid * 64 + lane; idx = idx < n ? idx : n - 1;
            __builtin_amdgcn_global_load_lds((const unsigned*)(dsts + (size_t)u.aux0 * TS + idx), (LAS unsigned*)(tb.idbuf + (ui % 3) * 256 + wid * 64), 4, 0, 0); }
    }
    __device__ __forceinline__ unsigned row_off_lds(int ui, int row, LAS unsigned char*) const { return (unsigned)tb.idbuf[(ui & 1) * 256 + row] * a_pitch; }
};
struct EpiGU {
#if defined(GU_DRY)
    static constexpr int NST = 0;
#else
    static constexpr int NST = 8;
#endif
    static __device__ __forceinline__ int a_row(int h, int R) { return 128 * h + R; }
    unsigned char* ACT; bool dry;
    __device__ __forceinline__ void operator()(f32x4 (&acc)[2][2][4][2], const pg8::Unit& u, int wr, int wc, int fr, int fq, LAS unsigned char*) const {
        if (dry) { float s = 0.f;
#pragma unroll
            for (int ai = 0; ai < 2; ++ai)
#pragma unroll
                for (int bj = 0; bj < 2; ++bj)
#pragma unroll
                    for (int m = 0; m < 4; ++m)
#pragma unroll
                        for (int n2 = 0; n2 < 2; ++n2) s += acc[ai][bj][m][n2][0] + acc[ai][bj][m][n2][1] + acc[ai][bj][m][n2][2] + acc[ai][bj][m][n2][3];
            if (s == 1.2345e-30f) ACT[0] = 0; return; }
        const int row0 = u.aux1 + wr * 64 + fr, col0 = (u.pn & 255) * 128 + wc * 32 + 8 * fq;
#pragma unroll
        for (int ai = 0; ai < 2; ++ai)
#pragma unroll
            for (int m = 0; m < 4; ++m) { const unsigned off = (unsigned)(row0 + ai * 128 + m * 16) * DE + col0;
                f32x4 a0, a1;
#pragma unroll
                for (int e = 0; e < 4; ++e) { a0[e] = silu_f(acc[ai][0][m][0][e]) * acc[ai][1][m][0][e]; a1[e] = silu_f(acc[ai][0][m][1][e]) * acc[ai][1][m][1][e]; }
                v2u w; w.x = pk4_fp8(a0[0], a0[1], a0[2], a0[3]); w.y = pk4_fp8(a1[0], a1[1], a1[2], a1[3]);
                *(GAS v2u*)((GAS char*)ACT + off) = w; }
    }
};
struct EpiDN {
#if defined(DN_DRY)
    static constexpr int NST = 0;
#else
    static constexpr int NST = 8;
#endif
    static __device__ __forceinline__ int a_row(int h, int R) { return 128 * h + R; }
    unsigned char* OUTTOK; LAS int* idbuf; LAS int* cnt; bool dry;
    __device__ __forceinline__ void operator()(f32x4 (&acc)[2][2][4][2], const pg8::Unit& u, int wr, int wc, int fr, int fq, LAS unsigned char*) const {
        if (dry) { float s = 0.f;
#pragma unroll
            for (int ai = 0; ai < 2; ++ai)
#pragma unroll
                for (int bj = 0; bj < 2; ++bj)
#pragma unroll
                    for (int m = 0; m < 4; ++m)
#pragma unroll
                        for (int n2 = 0; n2 < 2; ++n2) s += acc[ai][bj][m][n2][0] + acc[ai][bj][m][n2][1] + acc[ai][bj][m][n2][2] + acc[ai][bj][m][n2][3];
            if (s == 1.2345e-30f) OUTTOK[0] = 0; return; }
        int tz = threadIdx.x; asm volatile("" : "+v"(tz)); fr = tz & 15; fq = (tz >> 4) & 3;
        const int n = cnt[u.aux0], rl0 = u.pm * 256 + wr * 64 + fr, col0 = (u.pn & 255) * 256 + wc * 64 + 16 * fq;
        const LAS int* dl = idbuf + (u.pn >> 8) * 256 - u.pm * 256;
#pragma unroll
        for (int ai = 0; ai < 2; ++ai)
#pragma unroll
            for (int m = 0; m < 4; ++m) { const int rl = rl0 + ai * 128 + m * 16;
                {
                    const unsigned off = (rl < n) ? (unsigned)dl[rl] * D + col0 : (unsigned)(WS_H2F8 - WS_OUTTOK) + (unsigned)(tz & 511) * 16u;
                    const f32x4 v0 = acc[ai][0][m][0], v1 = acc[ai][0][m][1], v2 = acc[ai][1][m][0], v3 = acc[ai][1][m][1];
                    v4u w; w.x = pk4_fp8(v0[0], v0[1], v0[2], v0[3]); w.y = pk4_fp8(v1[0], v1[1], v1[2], v1[3]); w.z = pk4_fp8(v2[0], v2[1], v2[2], v2[3]); w.w = pk4_fp8(v3[0], v3[1], v3[2], v3[3]);
                    *(GAS v4u*)((GAS char*)OUTTOK + off) = w; } }
    }
};
__device__ __forceinline__ void moe_combine(const Args& A, LAS unsigned char* lds, int s, int tid, int lane, int wave, int vcu, int G, float* wout, float oscale = 1.0f, float oadd = 0.0f, int tmask = 0x7fffffff) {
    const int gw = vcu * NWAVES + wave, NGW = G * NWAVES;
    const float* mod = (const float*)(A.ws + WS_MOD); const unsigned char* OT = A.ws + WS_OUTTOK; const float* rt_w = (const float*)(A.ws + WS_ROUTE + RT_W);
    LAS f32x4* pv = (LAS f32x4*)lds;
    for (int tb = vcu; tb < TS / 128; tb += G) {
      { const int b = (s * TS + tb * 128) / SEQ; __syncthreads();
        pv[tid] = ((const f32x4*)(mod + (size_t)b * MODW + 5 * D))[tid]; pv[512 + tid] = ((const f32x4*)A.in[27])[tid]; pv[1024 + tid] = ((const f32x4*)A.in[28])[tid];
        __syncthreads(); }
      for (int i = 0; i < 16; ++i) {
        asm volatile("" ::: "memory");
        const int tl = tb * 128 + wave * 16 + i, t = s * TS + tl;
        const GAS v4u* xb = (const GAS v4u*)(A.out + (size_t)t * D) + 2 * lane; GAS f32x4* yo = (GAS f32x4*)(wout + (size_t)(t & tmask) * D) + 4 * lane;
        const LAS f32x4* g2 = pv + 4 * lane;
        const GAS v4u* rows = (const GAS v4u*)(OT + (size_t)tl * 9 * D) + lane;
        float w[8];
        { const f32x4 w0 = *(const GAS f32x4*)(rt_w + (size_t)t * 8), w1 = *(const GAS f32x4*)(rt_w + (size_t)t * 8 + 4); w[0] = w0[0]; w[1] = w0[1]; w[2] = w0[2]; w[3] = w0[3]; w[4] = w1[0]; w[5] = w1[1]; w[6] = w1[2]; w[7] = w1[3]; }
        v4u q[9][2];
#pragma unroll
        for (int k = 0; k < 9; ++k)
#pragma unroll
            for (int j = 0; j < 2; ++j) q[k][j] = __builtin_nontemporal_load(rows + k * 128 + 64 * j);
        v4u xq[2][2];
#pragma unroll
        for (int j = 0; j < 2; ++j) { xq[j][0] = xb[128 * j]; xq[j][1] = xb[128 * j + 1]; }
        f32x4 f[8]; float sm = 0.f;
#pragma unroll
        for (int j = 0; j < 2; ++j) {
            f32x4 a[4];
            a[0] = fp8x4_to_f32(q[8][j].x); a[1] = fp8x4_to_f32(q[8][j].y); a[2] = fp8x4_to_f32(q[8][j].z); a[3] = fp8x4_to_f32(q[8][j].w);
#pragma unroll
            for (int k = 0; k < 8; ++k) { a[0] = a[0] + w[k] * fp8x4_to_f32(q[k][j].x); a[1] = a[1] + w[k] * fp8x4_to_f32(q[k][j].y); a[2] = a[2] + w[k] * fp8x4_to_f32(q[k][j].z); a[3] = a[3] + w[k] * fp8x4_to_f32(q[k][j].w); }
#pragma unroll
            for (int i = 0; i < 4; ++i) { const unsigned x0 = (i < 2) ? ((i & 1) ? xq[j][0].z : xq[j][0].x) : ((i & 1) ? xq[j][1].z : xq[j][1].x), x1 = (i < 2) ? ((i & 1) ? xq[j][0].w : xq[j][0].y) : ((i & 1) ? xq[j][1].w : xq[j][1].y);
                const f32x4 y = (f32x4){bf_lo(x0), bf_hi(x0), bf_lo(x1), bf_hi(x1)} * ALPHA + g2[256 * j + i] * (a[i] * 0.0625f); f[4 * j + i] = y; sm += (y.x + y.y) + (y.z + y.w); }
        }
        const float mean = wave_sum(sm) * (1.f / D); float s2 = 0.f;
#pragma unroll
        for (int j = 0; j < 8; ++j) { f[j] = f[j] - mean; s2 += (f[j].x * f[j].x + f[j].y * f[j].y) + (f[j].z * f[j].z + f[j].w * f[j].w); }
        const float rstd = 1.f / sqrtf(wave_sum(s2) * (1.f / D) + EPS);
        const LAS f32x4* lg2 = pv + 512 + 4 * lane; const LAS f32x4* lb2 = pv + 1024 + 4 * lane;
#pragma unroll
        for (int j = 0; j < 2; ++j)
#pragma unroll
            for (int i = 0; i < 4; ++i) {
#if defined(MK_STAMP_A)
                f32x4 o = (f[4 * j + i] * rstd * lg2[256 * j + i] + lb2[256 * j + i]) * oscale; if (t == 0 && lane == 0 && j == 0 && i == 0) o.x += oadd; yo[256 * j + i] = o;
#else
                yo[256 * j + i] = f[4 * j + i] * rstd * lg2[256 * j + i] + lb2[256 * j + i];
#endif
            }
      }
    }
}
}
namespace mk {
#ifndef GU_DRY
#define GU_DRY 0
#endif
#ifndef DN_DRY
#define DN_DRY 0
#endif
#ifndef DBL_MASK
#define DBL_MASK 0
#endif
#define REPS(k) for (int rep_ = 0; rep_ < (((DBL_MASK) >> (k)) & 1) + 1; ++rep_)
#ifndef MK_LAST_PHASE
#define MK_LAST_PHASE 2
#endif
__global__ void __launch_bounds__(NTHR, 2) mk_fwd(Args args) {
    extern __shared__ __attribute__((aligned(16))) unsigned char lds_raw[];
    LAS unsigned char* lds = (LAS unsigned char*)lds_raw;
    volatile LAS unsigned* MISC = (volatile LAS unsigned*)(lds + LDSCTL_OFF);
    const int tid = threadIdx.x, lane = tid & 63, wave = __builtin_amdgcn_readfirstlane(tid >> 6);
    const int G = gridDim.x; const int bx = blockIdx.x; const int vcu = (G % 8 == 0) ? (bx % 8) * (G / 8) + bx / 8 : bx;
    unsigned* ctl = (unsigned*)(args.ws + WS_CTL);
    for (int u = tid; u < (LDS_BYTES - LDSCTL_OFF) / 4; u += NTHR) ((LAS unsigned*)(lds + LDSCTL_OFF))[u] = 0u;
    __syncthreads();
    XcdBarrier bar = xcd_barrier_post(ctl + CW_BAR + args.li * XCD_BAR_WORDS, MISC + 8);
    const int lo = args.ph_lo, hi = args.ph_hi;
    float g_oscale = 1.0f, g_oadd = 0.0f;
#define IN(k) (lo <= (k) && (k) < hi)
#define BOTH(k) (IN(k) && IN((k) + 1))
#ifndef MK_STAMP_OFF
#define MK_STAMP_OFF 0.f
#endif
#ifndef MK_STAMP_BIN
#define MK_STAMP_BIN 20.f
#endif
#if defined(MK_STAMP_A)
#ifndef MK_STAMP_AE
#define MK_STAMP_AE (MK_STAMP_A + 1)
#endif
    volatile unsigned long long* stamps = (volatile unsigned long long*)(ctl + 16384); int nst = 1;
    if (bx == 0 && tid == 0) stamps[0] = __builtin_amdgcn_s_memrealtime();
#define GRID_BAR() do { xcd_barrier(bar); if (bx == 0 && tid == 0) stamps[nst] = __builtin_amdgcn_s_memrealtime(); ++nst; } while (0)
#else
#define GRID_BAR() xcd_barrier(bar)
#endif
#define OPQ() int tq = threadIdx.x; asm volatile("" : "+v"(tq)); const int tidq = tq, laneq = tq & 63

#if defined(MK_SPLIT_P0)
    if (IN(0)) { { OPQ(); p0_adaln(args, lds, tidq, G); } GRID_BAR(); { OPQ(); p0_fold(args, lds, tidq, G); } GRID_BAR(); { OPQ(); p0_weights<1>(args, lds, tidq, laneq, wave, vcu, G); } GRID_BAR();
        { OPQ(); p0_weights<2>(args, lds, tidq, laneq, wave, vcu, G); } GRID_BAR(); { OPQ(); p0_weights<4>(args, lds, tidq, laneq, wave, vcu, G); } if (BOTH(0)) GRID_BAR(); }
#else
    if (IN(0)) { REPS(0) { OPQ(); p0_adaln(args, lds, tidq, G); p0_fold(args, lds, tidq, G); p0_weights(args, lds, tidq, laneq, wave, vcu, G); } if (BOTH(0)) GRID_BAR(); }
#endif
    if (IN(1)) { REPS(1) { OPQ(); p1_hnorm(args, laneq, wave, vcu, G); } if (BOTH(1)) GRID_BAR(); }
    if (IN(2)) { REPS(2) {
        SchedInproj S{(const char*)(args.ws + WS_H), (const char*)(args.ws + WS_WIN), G, bx};
        static_assert(WS_GATE == WS_U + (size_t)TT * DL * 2 && WS_FOUR == WS_GATE + (size_t)T * DL * 2, "U|GATE|FOUR contiguous");
        EpiInproj E{(bf16*)(args.ws + WS_U), (bf16*)(args.ws + WS_UPART)};
        pg8::gemm_phase<EpiInproj, SchedInproj, true, false, true, 0x75757575>(lds, D / 128, D, D, S, E); }
        if (BOTH(2)) GRID_BAR();
    }
#ifndef SKIP_P3
    #if defined(MK_SPLIT_P3)
    if (IN(3)) { { OPQ(); p3_conv(args, laneq, wave, vcu, G); } GRID_BAR(); { OPQ(); p3_fold(args, lds, laneq, wave, vcu, G); } if (BOTH(3)) GRID_BAR(); }
#else
    if (IN(3)) { REPS(3) { OPQ(); p3_conv(args, laneq, wave, vcu, G); p3_fold(args, lds, laneq, wave, vcu, G); } if (BOTH(3)) GRID_BAR(); }
#endif
#endif
    if (IN(4)) { REPS(4) {
#ifndef SKIP_DFT
        { SchedDft S{(const char*)(args.ws + WS_CS), (const char*)(args.ws + WS_PQT), G, vcu}; EpiDft E{(bf16*)(args.ws + WS_AB)};
          pg8::gemm_phase<EpiDft, SchedDft, true, false>(lds, 2048 / 64, 4096, 4096, S, E); }
#endif
#if defined(MK_SPLIT_P4)
        GRID_BAR();
#endif
#ifndef SKIP_LRU
        { SchedGates S{(const char*)(args.ws + WS_UC), (const char*)(args.ws + WS_WG4), G, vcu};
          EpiLru E{(const bf16*)(args.ws + WS_UC), args.in[10], args.in[12], (bf16*)(args.ws + WS_S), (bf16*)(args.ws + WS_PF), (bf16*)(args.ws + WS_PB), (float*)(args.ws + WS_MISC)};
          pg8::gemm_phase<EpiLru, SchedGates, false, false>(lds, 256 / 64, DL * 2, 512, S, E); }
#endif
#if !defined(MK_SPLIT_P5)
        { OPQ(); p5a_fix<1>(args, lds, tidq, laneq, wave, vcu, G, G / 2, G - G / 2); }
#endif
        }
        if (BOTH(4)) GRID_BAR();
    }
#ifndef SKIP_P5
#if defined(MK_SPLIT_P5)
    if (IN(5)) { { OPQ(); p5a_fix<1>(args, lds, tidq, laneq, wave, vcu, G); } GRID_BAR(); { OPQ(); p5a_fix<2>(args, lds, tidq, laneq, wave, vcu, G); } if (BOTH(5)) GRID_BAR(); }
#else
    if (IN(5)) { { OPQ(); p5a_fix<2>(args, lds, tidq, laneq, wave, vcu, G); } { OPQ(); p5b_four(args, lds, laneq, wave, vcu, G); } if (BOTH(5)) GRID_BAR(); }
#endif
#if defined(MK_SPLIT_P5)
    if (IN(6)) { REPS(6) { OPQ(); p5b_four(args, lds, laneq, wave, vcu, G); } if (BOTH(6)) GRID_BAR(); }
#endif
#endif
#ifndef SKIP_P7
    if (IN(7)) { REPS(7) {
        SchedTiles S{(const char*)(args.ws + WS_YMIX), (const char*)(args.ws + WS_WOUT), T / 256, D / 256, G, bx, D, D};
        EpiBf16 E{(bf16*)(args.ws + WS_MIX), D};
        pg8::gemm_phase<EpiBf16, SchedTiles, true, false, true, 0x76767676>(lds, D / 128, D, D, S, E); }
        if (BOTH(7)) GRID_BAR();
    }
#endif
#ifndef SKIP_P8
#if defined(MK_SPLIT_P8)
    if (IN(8)) { { OPQ(); p8_ln_router<1>(args, lds, tidq, laneq, wave, vcu, G); } GRID_BAR(); { OPQ(); p8_ln_router<2>(args, lds, tidq, laneq, wave, vcu, G); } if (BOTH(8)) GRID_BAR(); }
#else
    if (IN(8)) { OPQ(); p8_ln_router(args, lds, tidq, laneq, wave, vcu, G); if (BOTH(8)) GRID_BAR(); }
#endif
#endif
#pragma unroll
    for (int s = 0; s < NSLICE; ++s) {
        const int p0 = 9 + 3 * s;
#ifndef SKIP_GU
        if (IN(p0)) { REPS(9) {
            { OPQ(); moe_tables(args, lds, s, 4, tidq, G, vcu); }
            SchedMoe<false> S{nullptr, moe_tab(lds), (const char*)(args.ws + WS_H2F8) + (size_t)s * TS * D, (const char*)(args.ws + WS_WGU), (const int*)(args.ws + WS_ROUTE + RT_TOK) + (size_t)s * NEX * TS, G, vcu, 4, (unsigned)D, 1024u * D, 256u * D, true};
            EpiGU E{args.ws + WS_ACT, (GU_DRY) && rep_ == 0};
            pg8::gemm_phase<EpiGU, SchedMoe<false>, true, true, true, 0x79797979>(lds, D / 128, D, D, S, E); }
            if (BOTH(p0)) GRID_BAR();
        }
#endif
#ifndef SKIP_DN
        if (IN(p0 + 1)) { REPS(10) {
            { OPQ(); moe_tables(args, lds, s, 8, tidq, G, vcu); }
            SchedMoe<true> S{(const int*)(args.ws + WS_ROUTE + RT_DST) + (size_t)s * NEX * TS, moe_tab(lds), (const char*)(args.ws + WS_ACT), (const char*)(args.ws + WS_WD), nullptr, G, vcu, 8, (unsigned)DE, 2048u * DE, 256u * DE, false};
            EpiDN E{args.ws + WS_OUTTOK, moe_tab(lds).idbuf, moe_tab(lds).cnt, (DN_DRY) && rep_ == 0};
            pg8::gemm_phase<EpiDN, SchedMoe<true>, false, false, true, 0x7d7d7d7d>(lds, DE / 128, DE, DE, S, E); }
            if (BOTH(p0 + 1)) GRID_BAR();
        }
#endif
#ifndef SKIP_CB
#if defined(MK_STAMP_A)
        if (IN(p0 + 2)) { xcd_barrier(bar);
            const unsigned long long sa0 = __hip_atomic_load((unsigned long long*)&stamps[MK_STAMP_A], RLX_AGENT), sa1 = __hip_atomic_load((unsigned long long*)&stamps[MK_STAMP_AE], RLX_AGENT);
            const unsigned long long sb0 = __hip_atomic_load((unsigned long long*)&stamps[MK_STAMP_B], RLX_AGENT), sb1 = __hip_atomic_load((unsigned long long*)&stamps[MK_STAMP_B + 1], RLX_AGENT);
            const float ta = floorf(((float)(sa1 - sa0) * 0.01f + (MK_STAMP_OFF)) / (MK_STAMP_BIN)) * (MK_STAMP_BIN), tb = floorf(((float)(sb1 - sb0) * 0.01f + (MK_STAMP_OFF)) / (MK_STAMP_BIN)) * (MK_STAMP_BIN);
            g_oscale = 1.0f + sqrtf(ta * 1e-4f); g_oadd = 1.0f + tb * 0.1f; }
#endif
        if (IN(p0 + 2)) { REPS(11) { OPQ(); moe_combine(args, lds, s, tidq, laneq, wave, vcu, G, (((DBL_MASK >> 11) & 1) && rep_ == 0) ? (float*)(args.ws + WS_ACT) : args.out, g_oscale, g_oadd, (((DBL_MASK >> 11) & 1) && rep_ == 0) ? 16383 : 0x7fffffff); } if (BOTH(p0 + 2)) GRID_BAR(); }
#endif
    }
#undef IN
#undef BOTH
}
}
static int g_grid = 0;
static void mk_launch(void* const* d_in, void* d_out, void* d_ws, hipStream_t stream, int lo, int hi, int li) {
    if (g_grid == 0) {
        int dev = 0, cus = 0; hipGetDevice(&dev); hipDeviceGetAttribute(&cus, hipDeviceAttributeMultiprocessorCount, dev);
        if (hipFuncSetAttribute((const void*)mk::mk_fwd, hipFuncAttributeMaxDynamicSharedMemorySize, mk::LDS_BYTES) != hipSuccess) { fprintf(stderr, "hipFuncSetAttribute failed\n"); g_grid = -1; return; }
        int per_cu = 0; (void)hipOccupancyMaxActiveBlocksPerMultiprocessor(&per_cu, (const void*)mk::mk_fwd, mk::NTHR, mk::LDS_BYTES); (void)hipGetLastError();
        if (per_cu < 1) fprintf(stderr, "occupancy query says %d\n", per_cu);
        g_grid = cus > 0 ? cus : 256;
    }
    if (g_grid < 0) return;
    mk::Args a{}; for (int i = 0; i < 29; ++i) a.in[i] = (const float*)d_in[i];
    a.out = (float*)d_out; a.ws = (unsigned char*)d_ws; a.ph_lo = lo; a.ph_hi = hi; a.li = li; a.pad = 0;
    hipLaunchKernelGGL(mk::mk_fwd, dim3(g_grid), dim3(mk::NTHR), mk::LDS_BYTES, stream, a);
}
extern "C" void kernel_launch(void* const* d_in, const int* in_sizes, int n_in, void* d_out, int out_size, void* d_ws, size_t ws_size, hipStream_t stream) {
    if (ws_size < mk::WS_END) { fprintf(stderr, "workspace too small\n"); return; }
    (void)hipMemsetAsync((unsigned char*)d_ws + mk::WS_CTL, 0, mk::CTL_ZERO_BYTES, stream);
    constexpr int NPH = 9 + 3 * mk::NSLICE;
#if MK_SPLIT
    for (int p = 0; p < NPH; ++p) mk_launch(d_in, d_out, d_ws, stream, p, p + 1, 0);
#else
    mk_launch(d_in, d_out, d_ws, stream, 0, NPH, 0);
#endif
}
```
